# Optimizing an MI355X kernel written in HIP

```python
import math
import jax, jax.numpy as jnp
from jax import lax
import numpy as np

D_MODEL = 4096
BATCH = 1
SEQ = 8192
DEPTH = 1

ATTN_HEADS = 32
ATTN_HEAD_DIM = 128
ATTN_WIDTH = ATTN_HEADS * ATTN_HEAD_DIM
Q_LORA_RANK = 1024
KV_LORA_RANK = 512
IDX_HEADS = 32
IDX_HEAD_DIM = 64
TOPK_MAX = 256
Q_BLOCK = 128
MLSTM_HEADS = 8
MLSTM_QK_DIM = (D_MODEL // 2) // MLSTM_HEADS
MLSTM_V_DIM = D_MODEL // MLSTM_HEADS
MLSTM_QK_WIDTH = MLSTM_HEADS * MLSTM_QK_DIM
MLSTM_WIDTH = MLSTM_HEADS * MLSTM_V_DIM
MLSTM_CHUNK = 64
CONV_WIDTH = 4
GATE_SOFTCAP = 15.0
DEEPNORM_ALPHA = (2.0 * DEPTH) ** 0.25
DEEPNORM_BETA = (8.0 * DEPTH) ** -0.25
NORM_EPS = 1e-6
IN_WIDTHS = (Q_LORA_RANK, KV_LORA_RANK, IDX_HEAD_DIM, IDX_HEADS, ATTN_WIDTH, 2 * MLSTM_QK_WIDTH, MLSTM_WIDTH, MLSTM_WIDTH, MLSTM_HEADS, MLSTM_HEADS, MLSTM_WIDTH, D_MODEL, D_MODEL)
IN_TOTAL = sum(IN_WIDTHS)
FGATE_OFFSET = sum(IN_WIDTHS[:9])

kernel_name = 'dsa_mlstm_gated_hybrid_deepnorm_adaln'


def rms_norm(x, g):
    xf = x.astype(jnp.float32)
    y = xf * lax.rsqrt(jnp.mean(xf * xf, axis=-1, keepdims=True) + NORM_EPS)
    return (y * g).astype(x.dtype)


def layer_norm(x, g, b):
    xf = x.astype(jnp.float32)
    mu = jnp.mean(xf, axis=-1, keepdims=True)
    var = jnp.mean(jnp.square(xf - mu), axis=-1, keepdims=True)
    return ((xf - mu) * lax.rsqrt(var + NORM_EPS) * g + b).astype(x.dtype)


def softcap(x):
    return GATE_SOFTCAP * jnp.tanh(x / GATE_SOFTCAP)


def alibi_slopes(n_heads):
    return jnp.exp2(-8.0 * jnp.arange(1, n_heads + 1, dtype=jnp.float32) / n_heads)


def causal_depthwise_conv(x, w, b):
    width = w.shape[0]
    seq = x.shape[1]
    xp = jnp.pad(x, ((0, 0), (width - 1, 0), (0, 0)))
    y = b
    for j in range(width):
        y = y + xp[:, j:j + seq] * w[j]
    return y


def dsa_attention(q, q_idx, w_idx, k_idx, c_kv, w_uk, w_uv):
    bsz, seq = q.shape[0], q.shape[1]
    n_sel = min(TOPK_MAX, seq // 4)
    n_blocks = seq // Q_BLOCK
    slopes = alibi_slopes(ATTN_HEADS)
    key_pos = jnp.arange(seq, dtype=jnp.int32)
    scale = ATTN_HEAD_DIM ** -0.5

    def to_blocks(a):
        return a.reshape(bsz, n_blocks, Q_BLOCK, *a.shape[2:]).swapaxes(0, 1)

    def block_fn(args):
        blk, q_b, qi_b, wi_b = args
        q_pos = blk * Q_BLOCK + jnp.arange(Q_BLOCK, dtype=jnp.int32)
        rel = jnp.einsum('bqhd,bsd->bqhs', qi_b, k_idx)
        score = jnp.einsum('bqhs,bqh->bqs', jax.nn.relu(rel), wi_b).astype(jnp.float32)
        score = jnp.where(key_pos[None, :] <= q_pos[:, None], score, -jnp.inf)
        _, idx = lax.top_k(score, n_sel)
        kv_sel = jax.vmap(lambda kv, i: kv[i])(c_kv, idx)
        q_abs = jnp.einsum('bqhd,hdr->bqhr', q_b, w_uk)
        logits = jnp.einsum('bqhr,bqkr->bhqk', q_abs, kv_sel).astype(jnp.float32) * scale
        dist = (q_pos[None, :, None] - idx).astype(jnp.float32)
        logits = logits - slopes[:, None, None] * dist[:, None]
        valid = (idx <= q_pos[None, :, None])[:, None]
        logits = jnp.where(valid, logits, -jnp.inf)
        p = jax.nn.softmax(logits, axis=-1).astype(c_kv.dtype)
        o_lat = jnp.einsum('bhqk,bqkr->bqhr', p, kv_sel)
        o = jnp.einsum('bqhr,hrd->bqhd', o_lat, w_uv)
        return o.reshape(bsz, Q_BLOCK, ATTN_WIDTH)

    out = lax.map(block_fn, (jnp.arange(n_blocks, dtype=jnp.int32), to_blocks(q), to_blocks(q_idx), to_blocks(w_idx)))
    return out.swapaxes(0, 1).reshape(bsz, seq, ATTN_WIDTH)


def mlstm_chunkwise(q, k, v, ig, fg):
    bsz, seq, nh, dk = q.shape
    dv = v.shape[-1]
    L = MLSTM_CHUNK
    nc = seq // L
    logf = jax.nn.log_sigmoid(fg)

    def chunk4(a):
        return a.reshape(bsz, nc, L, nh, a.shape[-1]).transpose(1, 0, 3, 2, 4)

    def chunk3(a):
        return a.reshape(bsz, nc, L, nh).transpose(1, 0, 3, 2)

    causal = jnp.tril(jnp.ones((L, L), dtype=bool))

    def step(carry, xs):
        C, n, m = carry
        qc, kc, vc, ic, fc = xs
        b = jnp.cumsum(fc, axis=-1)
        dmat = jnp.where(causal, b[..., :, None] - b[..., None, :] + ic[..., None, :], -jnp.inf)
        m_inter = b + m[..., None]
        m_t = jnp.maximum(m_inter, jnp.max(dmat, axis=-1))
        s = jnp.einsum('bhjd,bhsd->bhjs', qc, kc) * jnp.exp(dmat - m_t[..., None])
        inter = jnp.exp(m_inter - m_t)
        num = jnp.einsum('bhjs,bhsv->bhjv', s, vc) + inter[..., None] * jnp.einsum('bhjd,bhdv->bhjv', qc, C)
        den = jnp.sum(s, axis=-1) + inter * jnp.einsum('bhjd,bhd->bhj', qc, n)
        h = num / jnp.maximum(jnp.abs(den), jnp.exp(-m_t))[..., None]
        g = b[..., -1]
        m_new = m_t[..., -1]
        wgt = jnp.exp(g[..., None] - b + ic - m_new[..., None])
        decay = jnp.exp(g + m - m_new)
        wk = wgt[..., None] * kc
        C_new = decay[..., None, None] * C + jnp.einsum('bhsd,bhsv->bhdv', wk, vc)
        n_new = decay[..., None] * n + jnp.sum(wk, axis=2)
        return (C_new, n_new, m_new), h

    init = (jnp.zeros((bsz, nh, dk, dv), jnp.float32), jnp.zeros((bsz, nh, dk), jnp.float32), jnp.zeros((bsz, nh), jnp.float32))
    _, h = lax.scan(step, init, (chunk4(q), chunk4(k), chunk4(v), chunk3(ig), chunk3(logf)))
    return h.transpose(1, 0, 3, 2, 4).reshape(bsz, seq, nh, dv)


def hybrid_layer(x, c, w_ada, b_ada, w_in, b_in, g_q, g_kv, w_uq, w_iq, w_uk, w_uv, g_kidx, b_kidx, conv_w, conv_b, g_mh, w_attn_out, w_mlstm_out, w_out, ln_g, ln_b):
    bsz, seq, _ = x.shape
    mod = jax.nn.silu(c) @ w_ada + b_ada
    shift, scale, gate = jnp.split(mod, 3, axis=-1)
    u = x * (1.0 + scale[:, None]) + shift[:, None]
    proj = u @ w_in + b_in
    split_points = np.cumsum(IN_WIDTHS)[:-1].tolist()
    (q_lat, kv_lat, k_idx, w_idx, z_attn, qk_m, v_m, o_m, i_m, f_m, z_m, gate_attn, gate_mlstm) = jnp.split(proj, split_points, axis=-1)

    c_q = rms_norm(q_lat, g_q)
    q = (c_q @ w_uq).reshape(bsz, seq, ATTN_HEADS, ATTN_HEAD_DIM)
    q_idx = (c_q @ w_iq).reshape(bsz, seq, IDX_HEADS, IDX_HEAD_DIM)
    c_kv = rms_norm(kv_lat, g_kv)
    k_idx = layer_norm(k_idx, g_kidx, b_kidx)
    w_idx = w_idx * (IDX_HEADS ** -0.5 * IDX_HEAD_DIM ** -0.5)
    o_attn = dsa_attention(q, q_idx, w_idx, k_idx, c_kv, w_uk, w_uv)
    y_attn = (o_attn * jax.nn.silu(z_attn)) @ w_attn_out

    qk_m = jax.nn.silu(causal_depthwise_conv(qk_m, conv_w, conv_b))
    q_m, k_m = jnp.split(qk_m, 2, axis=-1)
    q_m = q_m.reshape(bsz, seq, MLSTM_HEADS, MLSTM_QK_DIM).astype(jnp.float32)
    k_m = k_m.reshape(bsz, seq, MLSTM_HEADS, MLSTM_QK_DIM).astype(jnp.float32) * (MLSTM_QK_DIM ** -0.5)
    v_m = v_m.reshape(bsz, seq, MLSTM_HEADS, MLSTM_V_DIM).astype(jnp.float32)
    ig = softcap(i_m.astype(jnp.float32))
    fg = softcap(f_m.astype(jnp.float32))
    h = mlstm_chunkwise(q_m, k_m, v_m, ig, fg)
    h = rms_norm(h, g_mh).reshape(bsz, seq, MLSTM_WIDTH).astype(x.dtype)
    h = h * jax.nn.sigmoid(o_m)
    y_mlstm = (h * jax.nn.silu(z_m)) @ w_mlstm_out

    merged = jax.nn.sigmoid(gate_attn) * y_attn + jax.nn.sigmoid(gate_mlstm) * y_mlstm
    out = merged @ w_out
    return layer_norm(DEEPNORM_ALPHA * x + gate[:, None] * out, ln_g, ln_b)


def setup_inputs(seed: int = 0) -> dict:
    key = jax.random.key(seed)
    ks = jax.random.split(key, 24)

    def nrm(k, shape, std):
        return jax.random.normal(k, shape, jnp.float32) * std

    beta = DEEPNORM_BETA
    x = nrm(ks[0], (BATCH, SEQ, D_MODEL), 1.0)
    c = nrm(ks[1], (BATCH, D_MODEL), 1.0)
    w_ada = nrm(ks[2], (DEPTH, D_MODEL, 3 * D_MODEL), 0.5 * D_MODEL ** -0.5)
    b_ada = nrm(ks[3], (DEPTH, 3 * D_MODEL), 0.02).at[:, 2 * D_MODEL:].add(1.0)
    w_in = nrm(ks[4], (DEPTH, D_MODEL, IN_TOTAL), D_MODEL ** -0.5)
    b_in = nrm(ks[5], (DEPTH, IN_TOTAL), 0.01).at[:, FGATE_OFFSET:FGATE_OFFSET + MLSTM_HEADS].add(jnp.linspace(3.0, 6.0, MLSTM_HEADS))
    g_q = 1.0 + nrm(ks[6], (DEPTH, Q_LORA_RANK), 0.01)
    g_kv = 1.0 + nrm(ks[7], (DEPTH, KV_LORA_RANK), 0.01)
    w_uq = nrm(ks[8], (DEPTH, Q_LORA_RANK, ATTN_WIDTH), Q_LORA_RANK ** -0.5)
    w_iq = nrm(ks[9], (DEPTH, Q_LORA_RANK, IDX_HEADS * IDX_HEAD_DIM), Q_LORA_RANK ** -0.5)
    w_uk = nrm(ks[10], (DEPTH, ATTN_HEADS, ATTN_HEAD_DIM, KV_LORA_RANK), KV_LORA_RANK ** -0.5)
    w_uv = nrm(ks[11], (DEPTH, ATTN_HEADS, KV_LORA_RANK, ATTN_HEAD_DIM), beta * KV_LORA_RANK ** -0.5)
    g_kidx = 1.0 + nrm(ks[12], (DEPTH, IDX_HEAD_DIM), 0.01)
    b_kidx = nrm(ks[13], (DEPTH, IDX_HEAD_DIM), 0.01)
    conv_w = nrm(ks[14], (DEPTH, CONV_WIDTH, 2 * MLSTM_QK_WIDTH), CONV_WIDTH ** -0.5)
    conv_b = nrm(ks[15], (DEPTH, 2 * MLSTM_QK_WIDTH), 0.01)
    g_mh = 1.0 + nrm(ks[16], (DEPTH, MLSTM_HEADS, MLSTM_V_DIM), 0.01)
    w_attn_out = nrm(ks[17], (DEPTH, ATTN_WIDTH, D_MODEL), beta * ATTN_WIDTH ** -0.5)
    w_mlstm_out = nrm(ks[18], (DEPTH, MLSTM_WIDTH, D_MODEL), beta * MLSTM_WIDTH ** -0.5)
    w_out = nrm(ks[19], (DEPTH, D_MODEL, D_MODEL), beta * D_MODEL ** -0.5)
    ln_g = 1.0 + nrm(ks[20], (DEPTH, D_MODEL), 0.01)
    ln_b = nrm(ks[21], (DEPTH, D_MODEL), 0.01)
    return {'x': x, 'c': c, 'w_ada': w_ada, 'b_ada': b_ada, 'w_in': w_in, 'b_in': b_in, 'g_q': g_q, 'g_kv': g_kv, 'w_uq': w_uq, 'w_iq': w_iq, 'w_uk': w_uk, 'w_uv': w_uv, 'g_kidx': g_kidx, 'b_kidx': b_kidx, 'conv_w': conv_w, 'conv_b': conv_b, 'g_mh': g_mh, 'w_attn_out': w_attn_out, 'w_mlstm_out': w_mlstm_out, 'w_out': w_out, 'ln_g': ln_g, 'ln_b': ln_b}


def reference(x, c, w_ada, b_ada, w_in, b_in, g_q, g_kv, w_uq, w_iq, w_uk, w_uv, g_kidx, b_kidx, conv_w, conv_b, g_mh, w_attn_out, w_mlstm_out, w_out, ln_g, ln_b):
    for layer in range(DEPTH):
        x = hybrid_layer(x, c, w_ada[layer], b_ada[layer], w_in[layer], b_in[layer], g_q[layer], g_kv[layer], w_uq[layer], w_iq[layer], w_uk[layer], w_uv[layer], g_kidx[layer], b_kidx[layer], conv_w[layer], conv_b[layer], g_mh[layer], w_attn_out[layer], w_mlstm_out[layer], w_out[layer], ln_g[layer], ln_b[layer])
    return x
```

```cpp
#include <hip/hip_runtime.h>
#include <cstdio>
#include <cstdint>
constexpr int T_SEQ = 8192, DM = 4096;
constexpr int NSRC = 30320;
constexpr int NP = 30464;
constexpr int NQA = 18432;
constexpr int NHEAD = 32, KVR = 512, QLR = 1024, IDXD = 64, TOPK = 256;
constexpr int MH = 8, MDK = 256, MDV = 512, MCH = 64;
constexpr int PC_QLAT = 0, PC_KV = 1024, PC_MISC = 1536, PC_ZA = 1792, PC_QK = 5888, PC_V = 9984, PC_O = 14080, PC_ZM = 18176, PC_GA = 22272, PC_GM = 26368;
constexpr float NORM_EPS = 1e-6f;
constexpr float DN_ALPHA = 1.189207115002721f;
constexpr float SOFTCAP = 15.0f;

constexpr size_t MiB = 1u << 20;
constexpr size_t WS_CTL = 0, CTL_ZERO_BYTES = 1 * MiB;
constexpr size_t WS_MOD = 1 * MiB;
constexpr size_t WS_WQT = 2 * MiB;
constexpr size_t WS_WUVT = 38 * MiB;
constexpr size_t WS_WAOT = 46 * MiB, WS_WMOT = 78 * MiB, WS_WOT = 110 * MiB;
constexpr size_t WS_CQ = 142 * MiB;
constexpr size_t WS_CKV = 158 * MiB;
constexpr size_t WS_KI = 166 * MiB;
constexpr size_t WS_WI = 167 * MiB;
constexpr size_t WS_IG = 168 * MiB;
constexpr size_t WS_LF = 168 * MiB + 256 * 1024;
constexpr size_t WS_DEN = 168 * MiB + 512 * 1024;
constexpr size_t WS_MISC = 169 * MiB;
constexpr size_t WS_QM = 177 * MiB, WS_KM = 209 * MiB;
constexpr size_t WS_OG = 241 * MiB;
constexpr size_t WS_MERGED = 305 * MiB;
constexpr size_t WS_CQ8 = 337 * MiB;
constexpr size_t WS_WIQT = 18 * MiB;
constexpr size_t WS_WINT = 369 * MiB;
constexpr size_t WS_WINT8 = 385 * MiB;
constexpr size_t WS_U8 = 503 * MiB;
constexpr size_t WS_U = 607 * MiB;
constexpr size_t WS_SC = 369 * MiB;
constexpr size_t WS_P = 671 * MiB;
constexpr size_t WS_QA = 1147 * MiB;
constexpr size_t WS_HNUM = 1709 * MiB;
constexpr size_t WS_HG = 1275 * MiB;
constexpr size_t WS_TMP = 1339 * MiB;
constexpr size_t WS_OLAT = 1435 * MiB;
constexpr size_t WS_IDX = 1691 * MiB;
constexpr size_t WS_CNT = 1699 * MiB;
constexpr size_t WS_SP = 1700 * MiB;
constexpr size_t WS_GATES = 1708 * MiB;
constexpr size_t WS_END = 1837 * MiB;
static_assert(WS_WINT + (size_t)NP * 4096 * 2 <= WS_U && WS_U + (size_t)T_SEQ * 4096 * 2 <= WS_P && WS_SC + (size_t)T_SEQ * T_SEQ * 4 <= WS_P, "ws map 1");
static_assert(WS_P + (size_t)T_SEQ * NP * 2 <= WS_QA && WS_QA + (size_t)T_SEQ * NQA * 2 <= WS_OLAT && WS_TMP + (size_t)T_SEQ * 4096 * 2 <= WS_OLAT, "ws map 2");
static_assert(WS_WQT + (size_t)NQA * 1024 * 2 <= WS_WUVT, "ws map 3");
namespace pg8 {
#define PG8_LAS __attribute__((address_space(3)))
typedef unsigned short bf16_t;
typedef short bf16x8 __attribute__((ext_vector_type(8)));
typedef float f32x4 __attribute__((ext_vector_type(4)));
typedef unsigned u32x4 __attribute__((ext_vector_type(4)));
typedef int v4i_t __attribute__((ext_vector_type(4)));
typedef int v8i_t __attribute__((ext_vector_type(8)));
constexpr int BM = 256, BK = 64, HALF = 128, HTB = HALF * BK * 2  , STAGE_BYTES = 8 * HTB, NXCD = 8, WGM = 8;

__host__ __device__ __forceinline__ int lds_byte(int r, int c) { const int st = (r >> 4) * 2 + (c >> 5), rr = r & 15, cc = c & 31, ob = rr * 64 + cc * 2; return st * 1024 + (ob ^ (((ob >> 9) & 1) << 5)); }
__host__ __device__ __forceinline__ void stage_rc(int b, int& R, int& C) { const int st = b / 1024, sb = b % 1024, swz = sb ^ (((sb >> 9) & 1) << 5); R = (st >> 1) * 16 + swz / 64; C = (st & 1) * 32 + (swz % 64) / 2; }
__host__ __device__ __forceinline__ int perm32(int rho) { const int n = rho >> 4, i = rho & 15; return 8 * (i >> 2) + 4 * n + (i & 3); }

struct Unit { int pm, pn; };
struct Gemm { const bf16_t* A; const bf16_t* Bt; int M, N, K; int lda, ldb; long a_pn_off; unsigned wscale = 0x7F7F7F7Fu, ascale = 0x7F7F7F7Fu; };

struct StaticOrder {
    int nM, nN, nwg, G, c;
    __host__ __device__ void init(int M, int N, int G_, int c_) { nM = M / BM; nN = N / BM; nwg = nM * nN; G = G_; c = c_; }
    __host__ __device__ bool next(int i, Unit& u) const {
        const long L = (long)i * G + c; if (L >= nwg) return false;
        int wgid = (int)L; { const int q = nwg / NXCD, r = nwg % NXCD, xcd = wgid % NXCD, off = wgid / NXCD; wgid = (xcd < r ? xcd * (q + 1) : r * (q + 1) + (xcd - r) * q) + off; }
        const int nig = WGM * nN, gid = wgid / nig, fm = gid * WGM, gsz = (nM - fm) < WGM ? (nM - fm) : WGM;
        u.pm = fm + ((wgid % nig) % gsz); u.pn = (wgid % nig) / gsz; return true;
    }
    __device__ __forceinline__ void a_ready(const Unit&) const {}
    __device__ __forceinline__ void done(const Unit&) const {}
};

typedef float f32x2_t __attribute__((ext_vector_type(2)));
typedef __bf16 bf16x2_t __attribute__((ext_vector_type(2)));
__device__ __forceinline__ unsigned cvt_pk_bf16(float lo, float hi) { const f32x2_t v = {lo, hi}; const bf16x2_t b = __builtin_convertvector(v, bf16x2_t); return __builtin_bit_cast(unsigned, b); }
__device__ __forceinline__ float bf_lo(unsigned w) { return __uint_as_float(w << 16); }
__device__ __forceinline__ float bf_hi(unsigned w) { return __uint_as_float(w & 0xffff0000u); }
__device__ __forceinline__ float sigmoid_f(float x) { return __builtin_amdgcn_rcpf(1.0f + __expf(-x)); }
__device__ __forceinline__ float silu_f(float x) { return x * sigmoid_f(x); }
__device__ __forceinline__ u32x4 pack8(const f32x4& v0, const f32x4& v1) { u32x4 w; w.x = cvt_pk_bf16(v0[0], v0[1]); w.y = cvt_pk_bf16(v0[2], v0[3]); w.z = cvt_pk_bf16(v1[0], v1[1]); w.w = cvt_pk_bf16(v1[2], v1[3]); return w; }
__device__ __forceinline__ void unpack8(const u32x4& w, f32x4& v0, f32x4& v1) { v0 = (f32x4){bf_lo(w.x), bf_hi(w.x), bf_lo(w.y), bf_hi(w.y)}; v1 = (f32x4){bf_lo(w.z), bf_hi(w.z), bf_lo(w.w), bf_hi(w.w)}; }

typedef unsigned u32x2 __attribute__((ext_vector_type(2)));
__device__ __forceinline__ float clamp448(float x) { return fminf(fmaxf(x, -448.f), 448.f); }
__device__ __forceinline__ u32x2 pack_fp8x8(const float (&x)[8]) {
    int p0 = __builtin_amdgcn_cvt_pk_fp8_f32(clamp448(x[0]), clamp448(x[1]), 0, false); p0 = __builtin_amdgcn_cvt_pk_fp8_f32(clamp448(x[2]), clamp448(x[3]), p0, true);
    int p1 = __builtin_amdgcn_cvt_pk_fp8_f32(clamp448(x[4]), clamp448(x[5]), 0, false); p1 = __builtin_amdgcn_cvt_pk_fp8_f32(clamp448(x[6]), clamp448(x[7]), p1, true);
    return (u32x2){(unsigned)p0, (unsigned)p1};
}
struct EpiProj {
    static constexpr bool PERM = true, AFTER_DRAIN = false;
    bf16_t* P; float* MISC; const float* bias; int tile0;
    __device__ __forceinline__ void operator()(const f32x4 (&acc)[2][2][4][2], const Unit& u, int wr, int wc, int fr, int fq) const {
        const int tile = u.pn + tile0;
        int mode;
        if (tile < 6) mode = 0; else if (tile == 6) mode = 3; else if (tile < 23) mode = 1; else if (tile < 55) mode = 0; else if (tile < 71) mode = 2; else if (tile < 87) mode = 1; else mode = 2;
        const int cin = wc * 32 + 8 * fq, col0 = tile * BM + cin;
        const __amdgpu_buffer_rsrc_t rP = __builtin_amdgcn_make_buffer_rsrc((void*)P, 0, 0x7fffffff, 0x00020000), rM = __builtin_amdgcn_make_buffer_rsrc((void*)MISC, 0, 8192 * 256 * 4, 0x00020000);
        const unsigned voffP = (unsigned)(wr * 64 + fr) * (unsigned)(NP * 2) + (unsigned)cin * 2u, voffM = (unsigned)(wr * 64 + fr) * 1024u + (unsigned)cin * 4u;
        const int sP = u.pm * BM * (NP * 2) + tile * (BM * 2), sM = u.pm * BM * 1024;
        f32x4 bv[2][2];
#pragma unroll
        for (int bj = 0; bj < 2; ++bj)
#pragma unroll
            for (int n = 0; n < 2; ++n) bv[bj][n] = *(const f32x4*)(bias + col0 + bj * HALF + 4 * n);
#pragma unroll
        for (int ai = 0; ai < 2; ++ai)
#pragma unroll
            for (int m = 0; m < 4; ++m) { const int rloc = ai * HALF + m * 16;
#pragma unroll
                for (int bj = 0; bj < 2; ++bj) { f32x4 v0 = acc[ai][bj][m][0] + bv[bj][0], v1 = acc[ai][bj][m][1] + bv[bj][1];
                    if (mode == 3) { __builtin_amdgcn_raw_buffer_store_b128(__builtin_bit_cast(u32x4, v0), rM, voffM, sM + rloc * 1024 + bj * 512, 0); __builtin_amdgcn_raw_buffer_store_b128(__builtin_bit_cast(u32x4, v1), rM, voffM, sM + rloc * 1024 + bj * 512 + 16, 0); }
                    else {
                        if (mode == 1) {
#pragma unroll
                            for (int j = 0; j < 4; ++j) { v0[j] = silu_f(v0[j]); v1[j] = silu_f(v1[j]); } }
                        else if (mode == 2) {
#pragma unroll
                            for (int j = 0; j < 4; ++j) { v0[j] = sigmoid_f(v0[j]); v1[j] = sigmoid_f(v1[j]); } }
                        __builtin_amdgcn_raw_buffer_store_b128(pack8(v0, v1), rP, voffP, sP + rloc * (NP * 2) + bj * 256, 0); } } }
    }
};
struct EpiPlain {
    static constexpr bool PERM = true, AFTER_DRAIN = false;
    bf16_t* O; int ldc;
    __device__ __forceinline__ void operator()(const f32x4 (&acc)[2][2][4][2], const Unit& u, int wr, int wc, int fr, int fq) const {
        const int row0 = u.pm * BM + wr * 64 + fr, col0 = u.pn * BM + wc * 32 + 8 * fq;
#pragma unroll
        for (int ai = 0; ai < 2; ++ai)
#pragma unroll
            for (int m = 0; m < 4; ++m) { bf16_t* rowp = O + (size_t)(row0 + ai * HALF + m * 16) * ldc + col0;
#pragma unroll
                for (int bj = 0; bj < 2; ++bj) *(u32x4*)(rowp + bj * HALF) = pack8(acc[ai][bj][m][0], acc[ai][bj][m][1]); }
    }
};
template <int MODE, bool OUT8> struct EpiGate {
    static constexpr bool PERM = true, AFTER_DRAIN = false;
    void* O; int ldc; const bf16_t* G; int ldg; const bf16_t* Tm; float oscale;
    __device__ __forceinline__ void operator()(const f32x4 (&acc)[2][2][4][2], const Unit& u, int wr, int wc, int fr, int fq) const {
        const int row0 = u.pm * BM + wr * 64 + fr, col0 = u.pn * BM + wc * 32 + 8 * fq;
#pragma unroll
        for (int ai = 0; ai < 2; ++ai)
#pragma unroll
            for (int m = 0; m < 4; ++m) { const size_t row = (size_t)(row0 + ai * HALF + m * 16);
#pragma unroll
                for (int bj = 0; bj < 2; ++bj) {
                    const u32x4 gw = *(const u32x4*)(G + row * ldg + col0 + bj * HALF); f32x4 g0, g1; unpack8(gw, g0, g1);
                    f32x4 v0 = acc[ai][bj][m][0] * g0, v1 = acc[ai][bj][m][1] * g1;
                    if (MODE == 1) { const u32x4 tw = *(const u32x4*)(Tm + row * ldc + col0 + bj * HALF); f32x4 t0, t1; unpack8(tw, t0, t1); v0 += t0; v1 += t1; }
                    if (OUT8) { const float x[8] = {v0[0] * oscale, v0[1] * oscale, v0[2] * oscale, v0[3] * oscale, v1[0] * oscale, v1[1] * oscale, v1[2] * oscale, v1[3] * oscale};
                        *(u32x2*)((unsigned char*)O + row * ldc + col0 + bj * HALF) = pack_fp8x8(x); }
                    else *(u32x4*)((bf16_t*)O + row * ldc + col0 + bj * HALF) = pack8(v0, v1); } }
    }
};
struct EpiOut {
    static constexpr bool PERM = false, AFTER_DRAIN = false;
    bf16_t* Y; const float* X; const float* gate; float alpha;
    __device__ __forceinline__ void operator()(const f32x4 (&acc)[2][2][4][2], const Unit& u, int wr, int wc, int fr, int fq) const {
        const int row0 = u.pm * BM + wr * 64 + fr, col0 = u.pn * BM + wc * 32 + 4 * fq;
        f32x4 gv[2][2];
#pragma unroll
        for (int bj = 0; bj < 2; ++bj)
#pragma unroll
            for (int n = 0; n < 2; ++n) gv[bj][n] = *(const f32x4*)(gate + col0 + bj * HALF + n * 16);
#pragma unroll
        for (int ai = 0; ai < 2; ++ai)
#pragma unroll
            for (int m = 0; m < 4; ++m) { const size_t off = (size_t)(row0 + ai * HALF + m * 16) * DM + col0;
#pragma unroll
                for (int bj = 0; bj < 2; ++bj)
#pragma unroll
                    for (int n = 0; n < 2; ++n) { const f32x4 xv = *(const f32x4*)(X + off + bj * HALF + n * 16); const f32x4 y = xv * alpha + gv[bj][n] * acc[ai][bj][m][n];
                        u32x2 o; o.x = cvt_pk_bf16(y[0], y[1]); o.y = cvt_pk_bf16(y[2], y[3]); *(u32x2*)(Y + off + bj * HALF + n * 16) = o; } }
    }
};

template <class Epi, class Sched, bool ALIGN_EPI = false, bool SP2 = false, bool FP8 = false>
__device__ __forceinline__ void gemm_phase(PG8_LAS unsigned char* lds, const Gemm g, const Sched& S, const Epi& E) {
    int tid = threadIdx.x; asm volatile("" : "+v"(tid));
    const int wid = __builtin_amdgcn_readfirstlane(tid >> 6), lane = tid & 63, wr = wid >> 2, wc = wid & 3, fr = lane & 15, fq = lane >> 4;
    const int K = g.K, nt = K / BK;
    unsigned voffA[2], voffB[2];
#pragma unroll
    for (int i = 0; i < 2; ++i) { int R, C; stage_rc(tid * 16 + i * 8192, R, C); const int Rb = Epi::PERM ? ((R & ~31) + perm32(R & 31)) : R;
        voffA[i] = (unsigned)(R * g.lda + C) * 2u; voffB[i] = (unsigned)(Rb * g.ldb + C) * 2u; }
    const size_t kstep = (size_t)(BK * 2);
    const size_t hstepA = (size_t)HALF * g.lda * 2, hstepB = (size_t)HALF * g.ldb * 2;
    const size_t tstepA = 2 * hstepA, tstepB = 2 * hstepB, pnA = (size_t)g.a_pn_off * 2;
    const unsigned ldsw = (unsigned)wid * 1024u;
    const int aoff = lds_byte(wr * 64 + fr, fq * 8), boff = lds_byte(wc * 32 + fr, fq * 8);
#define PG8_SA(b, h) (((b) * 2 + (h)) * HTB)
#define PG8_SB(b, h) ((4 + (b) * 2 + (h)) * HTB)
#define PG8_STAGE(bufoff, gbase, voff) do { _Pragma("unroll") for (int _i = 0; _i < 2; ++_i) \
        __builtin_amdgcn_global_load_lds((const unsigned*)((const char*)(gbase) + (voff)[_i]), (PG8_LAS unsigned*)(lds + (bufoff) + ldsw + _i * 8192), 16, 0, 0); } while (0)
#define PG8_LDA(dst, b, h) do { _Pragma("unroll") for (int m = 0; m < 4; ++m) { \
        const bf16x8 _l0 = *(const PG8_LAS bf16x8*)(lds + PG8_SA(b, h) + aoff + m * 2048), _l1 = *(const PG8_LAS bf16x8*)(lds + PG8_SA(b, h) + aoff + m * 2048 + 1024); \
        if constexpr (FP8) dst##8[m] = __builtin_shufflevector(__builtin_bit_cast(v4i_t, _l0), __builtin_bit_cast(v4i_t, _l1), 0, 1, 2, 3, 4, 5, 6, 7); else { dst[m][0] = _l0; dst[m][1] = _l1; } } } while (0)
#define PG8_LDB(dst, b, h) do { _Pragma("unroll") for (int n = 0; n < 2; ++n) { \
        const bf16x8 _l0 = *(const PG8_LAS bf16x8*)(lds + PG8_SB(b, h) + boff + n * 2048), _l1 = *(const PG8_LAS bf16x8*)(lds + PG8_SB(b, h) + boff + n * 2048 + 1024); \
        if constexpr (FP8) dst##8[n] = __builtin_shufflevector(__builtin_bit_cast(v4i_t, _l0), __builtin_bit_cast(v4i_t, _l1), 0, 1, 2, 3, 4, 5, 6, 7); else { dst[n][0] = _l0; dst[n][1] = _l1; } } } while (0)
#define PG8_MMA(ai, bj, At, Bt) do { __builtin_amdgcn_s_setprio(1); \
        if constexpr (FP8) { _Pragma("unroll") for (int m = 0; m < 4; ++m) _Pragma("unroll") for (int n = 0; n < 2; ++n) \
            asm volatile("v_mfma_scale_f32_16x16x128_f8f6f4 %0, %1, %2, %0, %3, %4 op_sel_hi:[0,0,0]" : "+v"(acc[ai][bj][m][n]) : "v"(Bt##8[n]), "v"(At##8[m]), "v"(f8_ws), "v"(f8_one)); } \
        else { _Pragma("unroll") for (int m = 0; m < 4; ++m) _Pragma("unroll") for (int n = 0; n < 2; ++n) _Pragma("unroll") for (int k = 0; k < 2; ++k) \
            acc[ai][bj][m][n] = __builtin_amdgcn_mfma_f32_16x16x32_bf16(Bt[n][k], At[m][k], acc[ai][bj][m][n], 0, 0, 0); } \
        __builtin_amdgcn_s_setprio(0); } while (0)
#define PG8_WAIT_V(n) asm volatile("s_waitcnt vmcnt(" #n ")" ::: "memory")
#define PG8_WAIT_L(n) asm volatile("s_waitcnt lgkmcnt(" #n ")" ::: "memory")
#define PG8_BAR __builtin_amdgcn_s_barrier()
#define PG8_SCHED __builtin_amdgcn_sched_barrier(0)
    Unit cur, nxt; int ui = 0;
    if (!S.next(0, cur)) return;
    f32x4 acc[2][2][4][2];
#pragma unroll
    for (int a = 0; a < 2; ++a)
#pragma unroll
        for (int b = 0; b < 2; ++b)
#pragma unroll
            for (int m = 0; m < 4; ++m)
#pragma unroll
                for (int n = 0; n < 2; ++n) acc[a][b][m][n] = (f32x4){0.f, 0.f, 0.f, 0.f};
    const int f8_ws = (int)g.wscale, f8_one = (int)g.ascale;
    bf16x8 At[4][2], B0[2][2], B1[2][2]; v8i_t At8[4], B08[2], B18[2];
    const char* cA = (const char*)g.A + (size_t)cur.pm * tstepA + (size_t)cur.pn * pnA; const char* cB = (const char*)g.Bt + (size_t)cur.pn * tstepB;
    S.a_ready(cur);
    if constexpr (SP2) {
        PG8_STAGE(PG8_SB(0, 0), cB, voffB); PG8_STAGE(PG8_SB(0, 1), cB + hstepB, voffB); PG8_STAGE(PG8_SA(0, 0), cA, voffA); PG8_STAGE(PG8_SA(0, 1), cA + hstepA, voffA);
        if (wr == 1) PG8_BAR;
        PG8_WAIT_V(2); PG8_BAR;
        PG8_STAGE(PG8_SB(1, 0), cB + kstep, voffB); PG8_STAGE(PG8_SA(1, 0), cA + kstep, voffA); PG8_STAGE(PG8_SB(1, 1), cB + hstepB + kstep, voffB);
        PG8_WAIT_V(6); PG8_BAR;
    } else {
        PG8_STAGE(PG8_SB(0, 0), cB, voffB); PG8_STAGE(PG8_SA(0, 0), cA, voffA); PG8_STAGE(PG8_SB(0, 1), cB + hstepB, voffB); PG8_STAGE(PG8_SA(0, 1), cA + hstepA, voffA);
        if (wr == 1) PG8_BAR;
        PG8_WAIT_V(4); PG8_BAR;
        PG8_STAGE(PG8_SB(1, 0), cB + kstep, voffB); PG8_STAGE(PG8_SA(1, 0), cA + kstep, voffA); PG8_STAGE(PG8_SB(1, 1), cB + hstepB + kstep, voffB);
        PG8_WAIT_V(6); PG8_BAR;
    }
    for (;;) {
        const bool has_next = S.next(ui + 1, nxt);
        const char* nA = has_next ? (const char*)g.A + (size_t)nxt.pm * tstepA + (size_t)nxt.pn * pnA : cA; const char* nB = has_next ? (const char*)g.Bt + (size_t)nxt.pn * tstepB : cB;
        for (int t = 0; t < nt; t += 2) {
            const bool last = (t == nt - 2);
            const char* a1 = cA + (size_t)(t + 1) * kstep;
            const char* a2 = last ? nA : cA + (size_t)(t + 2) * kstep; const char* b2 = last ? nB : cB + (size_t)(t + 2) * kstep;
            const char* a3 = a2 + kstep; const char* b3 = b2 + kstep;
            if (last && has_next) S.a_ready(nxt);
            if constexpr (SP2) {
            PG8_LDB(B0, 0, 0); PG8_LDB(B1, 0, 1); PG8_SCHED; PG8_LDA(At, 0, 0); PG8_STAGE(PG8_SA(1, 1), a1 + hstepA, voffA);
            PG8_WAIT_V(8); PG8_WAIT_L(0); PG8_BAR; PG8_MMA(0, 0, At, B0); PG8_MMA(0, 1, At, B1); PG8_BAR; PG8_SCHED;
            PG8_LDA(At, 0, 1); PG8_STAGE(PG8_SB(0, 0), b2, voffB); PG8_STAGE(PG8_SB(0, 1), b2 + hstepB, voffB); PG8_STAGE(PG8_SA(0, 0), a2, voffA);
            PG8_WAIT_V(8); PG8_WAIT_L(0); PG8_BAR; PG8_MMA(1, 0, At, B0); PG8_MMA(1, 1, At, B1); PG8_BAR; PG8_SCHED;
            PG8_LDB(B0, 1, 0); PG8_LDB(B1, 1, 1); PG8_SCHED; PG8_LDA(At, 1, 0); PG8_STAGE(PG8_SA(0, 1), a2 + hstepA, voffA);
            PG8_WAIT_V(8); PG8_WAIT_L(0); PG8_BAR; PG8_MMA(0, 0, At, B0); PG8_MMA(0, 1, At, B1); PG8_BAR; PG8_SCHED;
            PG8_LDA(At, 1, 1); PG8_STAGE(PG8_SB(1, 0), b3, voffB); PG8_STAGE(PG8_SB(1, 1), b3 + hstepB, voffB); PG8_STAGE(PG8_SA(1, 0), a3, voffA);
            PG8_WAIT_V(8); PG8_WAIT_L(0); PG8_BAR; PG8_MMA(1, 0, At, B0); PG8_MMA(1, 1, At, B1); PG8_BAR; PG8_SCHED;
            } else {
            PG8_LDB(B0, 0, 0); PG8_SCHED; PG8_LDA(At, 0, 0); PG8_STAGE(PG8_SA(1, 1), a1 + hstepA, voffA);
            PG8_WAIT_L(8); PG8_BAR; PG8_WAIT_L(0); PG8_MMA(0, 0, At, B0); PG8_BAR; PG8_SCHED;
            PG8_LDB(B1, 0, 1); PG8_STAGE(PG8_SB(0, 0), b2, voffB);
            PG8_BAR; PG8_WAIT_L(0); PG8_MMA(0, 1, At, B1); PG8_BAR;
            PG8_LDA(At, 0, 1); PG8_STAGE(PG8_SA(0, 0), a2, voffA);
            PG8_BAR; PG8_WAIT_L(0); PG8_MMA(1, 0, At, B0); PG8_BAR; PG8_SCHED;
            PG8_STAGE(PG8_SB(0, 1), b2 + hstepB, voffB);
            PG8_WAIT_V(6); PG8_BAR; PG8_MMA(1, 1, At, B1); PG8_BAR;
            PG8_LDB(B0, 1, 0); PG8_SCHED; PG8_LDA(At, 1, 0); PG8_STAGE(PG8_SA(0, 1), a2 + hstepA, voffA);
            PG8_WAIT_L(8); PG8_BAR; PG8_WAIT_L(0); PG8_MMA(0, 0, At, B0); PG8_BAR; PG8_SCHED;
            PG8_LDB(B1, 1, 1); PG8_STAGE(PG8_SB(1, 0), b3, voffB);
            PG8_BAR; PG8_WAIT_L(0); PG8_MMA(0, 1, At, B1); PG8_BAR;
            PG8_LDA(At, 1, 1); PG8_STAGE(PG8_SA(1, 0), a3, voffA);
            PG8_BAR; PG8_WAIT_L(0); PG8_MMA(1, 0, At, B0); PG8_BAR; PG8_SCHED;
            PG8_STAGE(PG8_SB(1, 1), b3 + hstepB, voffB);
            PG8_WAIT_V(6); PG8_BAR; PG8_MMA(1, 1, At, B1); PG8_BAR;
            }
        }
        if constexpr (ALIGN_EPI) { if (wr == 0) PG8_BAR; }
        if constexpr (!Epi::AFTER_DRAIN) { E(acc, cur, wr, wc, fr, fq); S.done(cur); }
        if (!has_next) break;
#pragma unroll
        for (int a = 0; a < 2; ++a)
#pragma unroll
            for (int b = 0; b < 2; ++b)
#pragma unroll
                for (int m = 0; m < 4; ++m)
#pragma unroll
                    for (int n = 0; n < 2; ++n) acc[a][b][m][n] = (f32x4){0.f, 0.f, 0.f, 0.f};
        cur = nxt; cA = nA; cB = nB; ++ui;
        if constexpr (ALIGN_EPI) { if (wr == 1) PG8_BAR; }
    }
    PG8_WAIT_V(0);
    if constexpr (!ALIGN_EPI) { if (wr == 0) PG8_BAR; }
    PG8_BAR;
    if constexpr (Epi::AFTER_DRAIN) { E.fused(acc, cur, wr, wc, fr, fq, lds, wid, lane); S.done(cur); }
#undef PG8_SA
#undef PG8_SB
#undef PG8_STAGE
#undef PG8_LDA
#undef PG8_LDB
#undef PG8_MMA
#undef PG8_WAIT_V
#undef PG8_WAIT_L
#undef PG8_BAR
#undef PG8_SCHED
}
}
#ifndef PG8_SP2
#define PG8_SP2 true
#endif
#ifndef PG8_ALIGN
#define PG8_ALIGN true
#endif

constexpr int NWAVES = 8;
constexpr int RING_OFF = 0, RING_BYTES = 131072;
constexpr int LDSCTL_OFF = RING_BYTES, MISC_OFF = LDSCTL_OFF + 320;
constexpr int LDS_BYTES = 147456;
static_assert(MISC_OFF + 128 <= LDS_BYTES, "LDS map");

#define GAS __attribute__((address_space(1)))
#define LAS __attribute__((address_space(3)))
typedef unsigned short bf16;
typedef unsigned v4u __attribute__((ext_vector_type(4)));
typedef unsigned v2u __attribute__((ext_vector_type(2)));
typedef float f32x4 __attribute__((ext_vector_type(4)));
typedef float f32x16 __attribute__((ext_vector_type(16)));
typedef short bf16x8 __attribute__((ext_vector_type(8)));
typedef short s16x4 __attribute__((ext_vector_type(4)));
typedef GAS unsigned gu32;
#define RLX_AGENT __ATOMIC_RELAXED, __HIP_MEMORY_SCOPE_AGENT
#define LDS_WAIT() asm volatile("s_waitcnt lgkmcnt(0)" ::: "memory")
#define VM_WAIT() asm volatile("s_waitcnt vmcnt(0)" ::: "memory")
#define LDS_BARRIER() do { asm volatile("s_waitcnt lgkmcnt(0)" ::: "memory"); __builtin_amdgcn_s_barrier(); asm volatile("" ::: "memory"); } while (0)
using pg8::pack_fp8x8; using pg8::clamp448; using pg8::cvt_pk_bf16; using pg8::bf_lo; using pg8::bf_hi; using pg8::sigmoid_f; using pg8::silu_f;
#define FR_DPP(v, ctrl) __builtin_bit_cast(float, __builtin_amdgcn_update_dpp(__builtin_bit_cast(int, (float)(v)), __builtin_bit_cast(int, (float)(v)), (ctrl), 0xf, 0xf, false))
#define FR_LANE(v, k) __builtin_bit_cast(float, __builtin_amdgcn_readlane(__builtin_bit_cast(int, (float)(v)), (k)))
__device__ __forceinline__ float wave_sum(float v) {
    v += FR_DPP(v, 0x128); v += FR_DPP(v, 0x124); v += FR_DPP(v, 0x122); v += FR_DPP(v, 0x121);
    return (FR_LANE(v, 0) + FR_LANE(v, 16)) + (FR_LANE(v, 32) + FR_LANE(v, 48));
}
__device__ __forceinline__ float wave_max(float v) {
    v = fmaxf(v, FR_DPP(v, 0x128)); v = fmaxf(v, FR_DPP(v, 0x124)); v = fmaxf(v, FR_DPP(v, 0x122)); v = fmaxf(v, FR_DPP(v, 0x121));
    return fmaxf(fmaxf(FR_LANE(v, 0), FR_LANE(v, 16)), fmaxf(FR_LANE(v, 32), FR_LANE(v, 48)));
}
#define XB_TMO      128
#define XB_XCNT(j)  (256  + 64 * (j))
#define XB_XSUB(j)  (1280 + 64 * (j))
#define XB_XGEN(j)  (2304 + 64 * (j))
#define XB_TOP      3328
#define XB_TOPGEN   3392
#define XCD_BAR_WORDS 3456
#define XB_SPIN_CAP (1u << 18)

__device__ __forceinline__ unsigned xb_ld(unsigned* p)              { return __hip_atomic_load(p, __ATOMIC_RELAXED, __HIP_MEMORY_SCOPE_AGENT); }
__device__ __forceinline__ unsigned xb_add(unsigned* p, unsigned v) { return __hip_atomic_fetch_add(p, v, __ATOMIC_RELAXED, __HIP_MEMORY_SCOPE_AGENT); }
__device__ __forceinline__ unsigned xb_xcc_id() { return (unsigned)__builtin_amdgcn_s_getreg((3 << 11) | 20) & 0xFu; }
#define XB_SPIN(cond, bar) do { unsigned _sp = 0; while (cond) { __builtin_amdgcn_s_sleep(1); \
    if ((++_sp & 255u) == 0u) { if (xb_ld(&(bar)[XB_TMO])) break; if (_sp > XB_SPIN_CAP) { atomicAdd(&(bar)[XB_TMO], 1u); break; } } } } while (0)

struct XcdBarrier {
    unsigned* bar; unsigned x;
    volatile LAS unsigned* st;
};

__device__ __forceinline__ XcdBarrier xcd_barrier_post(unsigned* bar, volatile LAS unsigned* st) {
    XcdBarrier b; b.bar = bar; b.x = xb_xcc_id(); b.st = st;
    if (threadIdx.x == 0) (void)xb_add(&bar[XB_XCNT(b.x)], 1u);
    return b;
}
__device__ __forceinline__ void xcd_barrier_complete(unsigned* bar, unsigned x, unsigned& nloc, unsigned& nx) {
    const unsigned G = gridDim.x * gridDim.y * gridDim.z;
    unsigned sum, cnt, mine, sp = 0u;
    for (;;) {
        sum = 0u; cnt = 0u; mine = 0u;
#pragma unroll
        for (unsigned j = 0; j < 16; ++j) { const unsigned c = xb_ld(&bar[XB_XCNT(j)]); sum += c; cnt += (c > 0u) ? 1u : 0u; mine = (j == x) ? c : mine; }
        if (sum == G) break;
        __builtin_amdgcn_s_sleep(1);
        if ((++sp & 255u) == 0u) { if (xb_ld(&bar[XB_TMO])) break; if (sp > XB_SPIN_CAP) { atomicAdd(&bar[XB_TMO], 1u); break; } }
    }
    nloc = mine > 0u ? mine : 1u; nx = cnt > 0u ? cnt : 1u;
}

__device__ __forceinline__ void xcd_barrier(const XcdBarrier& b) {
    asm volatile("s_waitcnt vmcnt(0)" ::: "memory");
    __syncthreads();
    if (threadIdx.x == 0) {
        unsigned* bar = b.bar;
        __builtin_amdgcn_s_waitcnt(0);
        unsigned nloc = b.st[0], nx = b.st[1];
        if (nloc == 0u) { xcd_barrier_complete(bar, b.x, nloc, nx); b.st[0] = nloc; b.st[1] = nx; }
        const unsigned old = xb_add(&bar[XB_XSUB(b.x)], 1u);
        const unsigned gen = old / nloc;
        if (old + 1u == (gen + 1u) * nloc) {
            __builtin_amdgcn_fence(__ATOMIC_RELEASE, "agent");
            asm volatile("s_waitcnt vmcnt(0)" ::: "memory");
            const unsigned og = xb_add(&bar[XB_TOP], 1u);
            const unsigned tg = og / nx;
            if (og + 1u == (tg + 1u) * nx) xb_add(&bar[XB_TOPGEN], 1u);
            else XB_SPIN(xb_ld(&bar[XB_TOPGEN]) == tg, bar);
            __builtin_amdgcn_fence(__ATOMIC_ACQUIRE, "agent");
            xb_add(&bar[XB_XGEN(b.x)], 1u);
            asm volatile("s_waitcnt vmcnt(0)" ::: "memory");
        } else {
            XB_SPIN(xb_ld(&bar[XB_XGEN(b.x)]) == gen, bar);
            __builtin_amdgcn_fence(__ATOMIC_ACQUIRE, "agent");
            asm volatile("s_waitcnt vmcnt(0)" ::: "memory");
        }
    }
    __syncthreads();
}
struct Args { const float* in[22]; float* out; unsigned char* ws; int ph_lo, ph_hi, li, pad; };
enum { I_X = 0, I_C, I_WADA, I_BADA, I_WIN, I_BIN, I_GQ, I_GKV, I_WUQ, I_WIQ, I_WUK, I_WUV, I_GKIDX, I_BKIDX, I_CONVW, I_CONVB, I_GMH, I_WAO, I_WMO, I_WOUT, I_LNG, I_LNB };

__device__ __forceinline__ void tr_item(const float* src, int src_ld, int nvalid, bf16* dst, int dst_ld, LAS float* scr, int lane) {
    const int n = lane & 31;
#pragma unroll 8
    for (int i = 0; i < 32; ++i) { const int kk = 2 * i + (lane >> 5); scr[kk * 33 + n] = (n < nvalid) ? src[(size_t)kk * src_ld + n] : 0.f; }
    LDS_WAIT(); asm volatile("" ::: "memory");
    const int c = lane & 7;
#pragma unroll
    for (int j = 0; j < 4; ++j) { const int nn = (lane >> 3) + 8 * j; const LAS float* s = scr + (8 * c) * 33 + nn;
        v4u o; o.x = cvt_pk_bf16(s[0 * 33], s[1 * 33]); o.y = cvt_pk_bf16(s[2 * 33], s[3 * 33]); o.z = cvt_pk_bf16(s[4 * 33], s[5 * 33]); o.w = cvt_pk_bf16(s[6 * 33], s[7 * 33]);
        *(v4u*)(dst + (size_t)nn * dst_ld + 8 * c) = o; }
    LDS_WAIT(); asm volatile("" ::: "memory");
}
__device__ __forceinline__ void tr_item64(const float* src_k0, int src_ld, int srccol, bf16* dst_n0k0, int dst_ld, LAS unsigned char* scr, int lane) {
    f32x4 v[16];
    const float* sp = src_k0 + (size_t)(lane >> 4) * src_ld + (srccol >= 0 ? srccol : 0);
#pragma unroll
    for (int i = 0; i < 16; ++i) v[i] = *(const f32x4*)(sp + (size_t)(4 * i) * src_ld);
    const bool pad = srccol < 0;
#pragma unroll
    for (int i = 0; i < 16; ++i) { v2u o; o.x = cvt_pk_bf16(v[i][0], v[i][1]); o.y = cvt_pk_bf16(v[i][2], v[i][3]); if (pad) { o.x = 0u; o.y = 0u; }
        *(LAS v2u*)(scr + (4 * i + (lane >> 4)) * 136 + (lane & 15) * 8) = o; }
    LDS_WAIT(); asm volatile("" ::: "memory");
    const int g = lane >> 4, q = (lane & 15) >> 2, p = lane & 3;
#pragma unroll
    for (int c = 0; c < 4; ++c)
#pragma unroll
        for (int ks = 0; ks < 2; ++ks) { const LAS unsigned char* p0 = scr + (32 * ks + 8 * g + q) * 136 + (16 * c + 4 * p) * 2;
            const s16x4 a = __builtin_amdgcn_ds_read_tr16_b64_v4i16((LAS s16x4*)p0), b = __builtin_amdgcn_ds_read_tr16_b64_v4i16((LAS s16x4*)(p0 + 4 * 136));
            const bf16x8 o = (bf16x8){a[0], a[1], a[2], a[3], b[0], b[1], b[2], b[3]};
            *(bf16x8*)(dst_n0k0 + (size_t)(16 * c + (lane & 15)) * dst_ld + 32 * ks + 8 * g) = o; }
    LDS_WAIT(); asm volatile("" ::: "memory");
}
__device__ __forceinline__ void tr_item64_f8(const float* src_k0, int src_ld, int srccol, unsigned char* dst_n0k0, int dst_ld, float scale, LAS unsigned char* scr, int lane) {
    f32x4 v[16];
    const float* sp = src_k0 + (size_t)(lane >> 4) * src_ld + (srccol >= 0 ? srccol : 0);
#pragma unroll
    for (int i = 0; i < 16; ++i) v[i] = *(const f32x4*)(sp + (size_t)(4 * i) * src_ld);
    const bool pad = srccol < 0;
#pragma unroll
    for (int i = 0; i < 16; ++i) { v2u o; o.x = cvt_pk_bf16(v[i][0] * scale, v[i][1] * scale); o.y = cvt_pk_bf16(v[i][2] * scale, v[i][3] * scale); if (pad) { o.x = 0u; o.y = 0u; }
        *(LAS v2u*)(scr + (4 * i + (lane >> 4)) * 136 + (lane & 15) * 8) = o; }
    LDS_WAIT(); asm volatile("" ::: "memory");
    const int g = lane >> 4, q = (lane & 15) >> 2, p = lane & 3;
#pragma unroll
    for (int c = 0; c < 4; ++c)
#pragma unroll
        for (int ks = 0; ks < 2; ++ks) { const LAS unsigned char* p0 = scr + (32 * ks + 8 * g + q) * 136 + (16 * c + 4 * p) * 2;
            const s16x4 a = __builtin_amdgcn_ds_read_tr16_b64_v4i16((LAS s16x4*)p0), b = __builtin_amdgcn_ds_read_tr16_b64_v4i16((LAS s16x4*)(p0 + 4 * 136));
            const float x[8] = {bf_lo((unsigned)(unsigned short)a[0]), bf_lo((unsigned)(unsigned short)a[1]), bf_lo((unsigned)(unsigned short)a[2]), bf_lo((unsigned)(unsigned short)a[3]),
                                bf_lo((unsigned)(unsigned short)b[0]), bf_lo((unsigned)(unsigned short)b[1]), bf_lo((unsigned)(unsigned short)b[2]), bf_lo((unsigned)(unsigned short)b[3])};
            *(v2u*)(dst_n0k0 + (size_t)(16 * c + (lane & 15)) * dst_ld + 32 * ks + 8 * g) = pack_fp8x8(x); }
    LDS_WAIT(); asm volatile("" ::: "memory");
}
__device__ __forceinline__ int win_src_col(int nd, int& nvalid) {
    nvalid = 32;
    if (nd < PC_MISC) return nd;
    if (nd < PC_ZA) { const int j = (nd - PC_MISC) >> 5; if (j < 2) return 1536 + 32 * j; if (j == 2) return 1600; if (j == 3) { nvalid = 16; return 18016; } nvalid = 0; return 0; }
    if (nd < PC_ZM) return 1632 + (nd - PC_ZA);
    return 18032 + (nd - PC_ZM);
}
__device__ __forceinline__ int win_src_col1(int nd) {
    if (nd < PC_MISC) return nd;
    if (nd < PC_ZA) { const int j = nd - PC_MISC; if (j < 64) return 1536 + j; if (j < 96) return 1600 + (j - 64); if (j < 112) return 18016 + (j - 96); return -1; }
    if (nd < PC_ZM) return 1632 + (nd - PC_ZA);
    return 18032 + (nd - PC_ZM);
}

constexpr int TRI_IN = 64 * (NP / 64), TRI_IQ = 16 * 32, TRI_UV = 32 * 8 * 2, TRI_SQ = 64 * 64, TRI_N = TRI_IN + TRI_IQ + TRI_UV + 3 * TRI_SQ;
__device__ __forceinline__ void tri_load16(f32x4 (&v)[16], int it, bool& pad, int lane, const float* pWIN, const float* pWIQ, const float* pWUV, const float* pWAO, const float* pWMO, const float* pWOUT) {
    const int lc = (lane & 15) * 4; const float* sp; int ld, col; int r = it;
    if (r < TRI_IN) { const int nb = r >> 6, kb = r & 63; sp = pWIN + (size_t)(kb * 64) * NSRC; ld = NSRC; col = win_src_col1(nb * 64 + lc); }
    else { r -= TRI_IN;
        if (r < TRI_IQ) { const int nb = r >> 4, kb = r & 15; sp = pWIQ + (size_t)(kb * 64) * 2048; ld = 2048; col = nb * 64 + lc; }
        else { r -= TRI_IQ;
            if (r < TRI_UV) { const int h = r >> 4, kb = (r >> 1) & 7, nb = r & 1; sp = pWUV + (size_t)h * 65536 + (size_t)(kb * 64) * 128; ld = 128; col = nb * 64 + lc; }
            else { r -= TRI_UV; const int wsel = r / TRI_SQ; r -= wsel * TRI_SQ; const int nb = r >> 6, kb = r & 63;
                sp = (wsel == 0 ? pWAO : (wsel == 1 ? pWMO : pWOUT)) + (size_t)(kb * 64) * 4096; ld = 4096; col = nb * 64 + lc; } } }
    pad = col < 0;
    const float* q = sp + (size_t)(lane >> 4) * ld + (col >= 0 ? col : 0);
#pragma unroll
    for (int i = 0; i < 16; ++i) v[i] = *(const f32x4*)(q + (size_t)(4 * i) * ld);
}
__device__ __forceinline__ void tri_finish(f32x4 (&v)[16], int it, bool pad, int lane, unsigned char* wsb, LAS unsigned char* scr) {
    int r = it; bool f8 = false; unsigned char* dst; int dld;
    if (r < TRI_IN) { const int nb = r >> 6, kb = r & 63; if (nb < 28) { dst = wsb + WS_WINT + ((size_t)(nb * 64) * 4096 + kb * 64) * 2; dld = 4096; } else { f8 = true; dst = wsb + WS_WINT8 + (size_t)(nb * 64 - 1792) * 4096 + kb * 64; dld = 4096; } }
    else { r -= TRI_IN;
        if (r < TRI_IQ) { const int nb = r >> 4, kb = r & 15; dst = wsb + WS_WIQT + ((size_t)(nb * 64) * 1024 + kb * 64) * 2; dld = 1024; }
        else { r -= TRI_IQ;
            if (r < TRI_UV) { const int h = r >> 4, kb = (r >> 1) & 7, nb = r & 1; dst = wsb + WS_WUVT + ((size_t)(256 * (h >> 1) + 128 * (h & 1) + nb * 64) * 1024 + 512 * (h & 1) + kb * 64) * 2; dld = 1024; }
            else { r -= TRI_UV; const int wsel = r / TRI_SQ; r -= wsel * TRI_SQ; const int nb = r >> 6, kb = r & 63; f8 = true;
                dst = wsb + (wsel == 0 ? WS_WAOT : (wsel == 1 ? WS_WMOT : WS_WOT)) + (size_t)(nb * 64) * 4096 + kb * 64; dld = 4096; } } }
    const float scale = f8 ? 64.0f : 1.0f;
#pragma unroll
    for (int i = 0; i < 16; ++i) { v2u o; o.x = cvt_pk_bf16(v[i][0] * scale, v[i][1] * scale); o.y = cvt_pk_bf16(v[i][2] * scale, v[i][3] * scale); if (pad) { o.x = 0u; o.y = 0u; }
        *(LAS v2u*)(scr + (4 * i + (lane >> 4)) * 136 + (lane & 15) * 8) = o; }
    LDS_WAIT(); asm volatile("" ::: "memory");
    const int g = lane >> 4, q = (lane & 15) >> 2, pp = lane & 3;
#pragma unroll
    for (int c = 0; c < 4; ++c)
#pragma unroll
        for (int ks = 0; ks < 2; ++ks) { const LAS unsigned char* p0 = scr + (32 * ks + 8 * g + q) * 136 + (16 * c + 4 * pp) * 2;
            const s16x4 a = __builtin_amdgcn_ds_read_tr16_b64_v4i16((LAS s16x4*)p0), b = __builtin_amdgcn_ds_read_tr16_b64_v4i16((LAS s16x4*)(p0 + 4 * 136));
            const size_t eo = (size_t)(16 * c + (lane & 15)) * dld + 32 * ks + 8 * g;
            if (f8) { const float x[8] = {bf_lo((unsigned)(unsigned short)a[0]), bf_lo((unsigned)(unsigned short)a[1]), bf_lo((unsigned)(unsigned short)a[2]), bf_lo((unsigned)(unsigned short)a[3]),
                                          bf_lo((unsigned)(unsigned short)b[0]), bf_lo((unsigned)(unsigned short)b[1]), bf_lo((unsigned)(unsigned short)b[2]), bf_lo((unsigned)(unsigned short)b[3])};
                *(v2u*)(dst + eo) = pack_fp8x8(x); }
            else *(bf16x8*)(dst + eo * 2) = (bf16x8){a[0], a[1], a[2], a[3], b[0], b[1], b[2], b[3]}; }
    LDS_WAIT(); asm volatile("" ::: "memory");
}
struct Frame {
    LAS unsigned char* lds; int tid, lane, wave, G, bid;
    const float *p_I_X, *p_I_C, *p_I_WADA, *p_I_BADA, *p_I_WIN, *p_I_BIN, *p_I_GQ, *p_I_GKV, *p_I_WUQ, *p_I_WIQ, *p_I_WUK, *p_I_WUV, *p_I_GKIDX, *p_I_BKIDX, *p_I_CONVW, *p_I_CONVB, *p_I_GMH, *p_I_WAO, *p_I_WMO, *p_I_WOUT, *p_I_LNG, *p_I_LNB;
    float* out; unsigned char* ws;
};

__device__ __forceinline__ void phase0(Frame& F) {
    float* MOD = (float*)(F.ws + WS_MOD); float* BIASP = MOD + 16384;
    {
        LAS float* red = (LAS float*)F.lds;
        LAS float* sc_ = (LAS float*)(F.lds + 8192);
        const float* w_ada = F.p_I_WADA; const float* cvec = F.p_I_C; const float* b_ada = F.p_I_BADA;
        for (int k = F.tid; k < 4096; k += 512) { const float cv = cvec[k]; sc_[k] = cv / (1.0f + __expf(-cv)); }
        __syncthreads();
        for (int cb = F.bid; cb < 256; cb += F.G) {
            if (F.tid < 384) {
                const int kg = F.tid / 12, c4 = F.tid % 12;
                const float* w = w_ada + (size_t)(kg * 128) * 12288 + cb * 48 + c4 * 4; const LAS float* cc = sc_ + kg * 128;
                f32x4 acc = (f32x4){0.f, 0.f, 0.f, 0.f};
#pragma unroll 16
                for (int k = 0; k < 128; ++k) { const f32x4 wv = *(const f32x4*)(w + (size_t)k * 12288); acc += wv * cc[k]; }
                *(LAS f32x4*)(red + kg * 48 + c4 * 4) = acc;
            }
            __syncthreads();
            if (F.tid < 48) { float s = b_ada[cb * 48 + F.tid];
                for (int g = 0; g < 32; ++g) s += red[g * 48 + F.tid];
                MOD[cb * 48 + F.tid] = s; }
            __syncthreads();
        }
    }
    const bool qabs_late = (F.wave & 1) != 0;
    for (int pass = 0; pass < 2; ++pass) {
    if ((pass == 0) != qabs_late)
    {
        const float* w_uq = F.p_I_WUQ; const float* w_uk = F.p_I_WUK; bf16* WQT = (bf16*)(F.ws + WS_WQT);
        const int gw = F.bid * NWAVES + F.wave, NGW = F.G * NWAVES, quad = F.lane >> 4, r16 = F.lane & 15;
        for (int it = gw; it < 2048; it += NGW) {
            const int h = it >> 6, rt = (it >> 1) & 31, kh = it & 1;
            bf16x8 ah[4], al[4];
#pragma unroll
            for (int ks = 0; ks < 4; ++ks) { float x[8]; unsigned hi[4], lo[4];
#pragma unroll
                for (int j = 0; j < 8; ++j) x[j] = w_uk[(size_t)h * 65536 + (size_t)(ks * 32 + quad * 8 + j) * 512 + rt * 16 + r16];
#pragma unroll
                for (int j = 0; j < 4; ++j) { hi[j] = cvt_pk_bf16(x[2 * j], x[2 * j + 1]); lo[j] = cvt_pk_bf16(x[2 * j] - bf_lo(hi[j]), x[2 * j + 1] - bf_hi(hi[j])); }
                ah[ks] = __builtin_bit_cast(bf16x8, (v4u){hi[0], hi[1], hi[2], hi[3]}); al[ks] = __builtin_bit_cast(bf16x8, (v4u){lo[0], lo[1], lo[2], lo[3]}); }
#pragma unroll 2
            for (int nt = 0; nt < 32; ++nt) {
                const float* bp = w_uq + (size_t)(kh * 512 + nt * 16 + r16) * 4096 + h * 128 + quad * 8;
                f32x4 acc = (f32x4){0.f, 0.f, 0.f, 0.f};
#pragma unroll
                for (int ks = 0; ks < 4; ++ks) { const f32x4 b0 = *(const f32x4*)(bp + ks * 32), b1 = *(const f32x4*)(bp + ks * 32 + 4);
                    unsigned hi[4], lo[4];
                    hi[0] = cvt_pk_bf16(b0[0], b0[1]); hi[1] = cvt_pk_bf16(b0[2], b0[3]); hi[2] = cvt_pk_bf16(b1[0], b1[1]); hi[3] = cvt_pk_bf16(b1[2], b1[3]);
                    lo[0] = cvt_pk_bf16(b0[0] - bf_lo(hi[0]), b0[1] - bf_hi(hi[0])); lo[1] = cvt_pk_bf16(b0[2] - bf_lo(hi[1]), b0[3] - bf_hi(hi[1]));
                    lo[2] = cvt_pk_bf16(b1[0] - bf_lo(hi[2]), b1[1] - bf_hi(hi[2])); lo[3] = cvt_pk_bf16(b1[2] - bf_lo(hi[3]), b1[3] - bf_hi(hi[3]));
                    const bf16x8 bh = __builtin_bit_cast(bf16x8, (v4u){hi[0], hi[1], hi[2], hi[3]}), bl = __builtin_bit_cast(bf16x8, (v4u){lo[0], lo[1], lo[2], lo[3]});
                    acc = __builtin_amdgcn_mfma_f32_16x16x32_bf16(ah[ks], bh, acc, 0, 0, 0);
                    acc = __builtin_amdgcn_mfma_f32_16x16x32_bf16(ah[ks], bl, acc, 0, 0, 0);
                    acc = __builtin_amdgcn_mfma_f32_16x16x32_bf16(al[ks], bh, acc, 0, 0, 0); }
#pragma unroll
                for (int i = 0; i < 4; ++i) ((unsigned char*)WQT)[(size_t)(h * 512 + rt * 16 + quad * 4 + i) * 1024 + kh * 512 + nt * 16 + r16] = (unsigned char)(__builtin_amdgcn_cvt_pk_fp8_f32(clamp448(acc[i] * 64.0f), 0.f, 0, false) & 0xff);
            }
        }
    }
    if (pass == 0)
    {
        LAS unsigned char* scr = F.lds + F.wave * 16384;
        const int gw = F.bid * NWAVES + F.wave, NGW = F.G * NWAVES, lane = F.lane;
        bf16* WUVT = (bf16*)(F.ws + WS_WUVT);
        const float* const pWIN = F.p_I_WIN; const float* const pWIQ = F.p_I_WIQ; const float* const pWUV = F.p_I_WUV; const float* const pWAO = F.p_I_WAO; const float* const pWMO = F.p_I_WMO; const float* const pWOUT = F.p_I_WOUT;
        unsigned char* const wsb = F.ws;
        f32x4 vA[16], vB[16]; bool padA = false, padB = false;
        int it = gw;
        if (it < TRI_N) tri_load16(vA, it, padA, lane, pWIN, pWIQ, pWUV, pWAO, pWMO, pWOUT);
        for (; it < TRI_N; it += 2 * NGW) {
            if (it + NGW < TRI_N) tri_load16(vB, it + NGW, padB, lane, pWIN, pWIQ, pWUV, pWAO, pWMO, pWOUT);
            tri_finish(vA, it, padA, lane, wsb, scr);
            if (it + 2 * NGW < TRI_N) tri_load16(vA, it + 2 * NGW, padA, lane, pWIN, pWIQ, pWUV, pWAO, pWMO, pWOUT);
            if (it + NGW < TRI_N) tri_finish(vB, it + NGW, padB, lane, wsb, scr);
        }
        for (int n = gw; n < 4096; n += NGW) { const int hsel = (n >> 7) & 1; *(v4u*)(WUVT + (size_t)n * 1024 + 512 * (1 - hsel) + F.lane * 8) = (v4u){0u, 0u, 0u, 0u}; }
        const float* b_in = F.p_I_BIN;
        for (int n = gw * 64 + F.lane; n < NP; n += NGW * 64) { const int s = win_src_col1(n); BIASP[n] = s >= 0 ? b_in[s] : 0.f; }
    }
    }
}

__device__ __forceinline__ void phase1(Frame& F) {
    const float* MOD = (const float*)(F.ws + WS_MOD); const float* x = F.p_I_X; bf16* U = (bf16*)(F.ws + WS_U);
    const size_t nvec = (size_t)T_SEQ * DM / 8;
    const int col = F.tid * 8;
    const f32x4 sh0 = *(const f32x4*)(MOD + col), sh1 = *(const f32x4*)(MOD + col + 4), sc0 = *(const f32x4*)(MOD + 4096 + col) + 1.0f, sc1 = *(const f32x4*)(MOD + 4096 + col + 4) + 1.0f;
#pragma unroll 4
    for (size_t i = (size_t)F.bid * 512 + F.tid; i < nvec; i += (size_t)F.G * 512) {
        const f32x4 x0 = *(const f32x4*)(x + i * 8), x1 = *(const f32x4*)(x + i * 8 + 4);
        const f32x4 u0 = x0 * sc0 + sh0, u1 = x1 * sc1 + sh1;
        *(v4u*)(U + i * 8) = pg8::pack8(u0, u1);
        { const float xx[8] = {u0[0], u0[1], u0[2], u0[3], u1[0], u1[1], u1[2], u1[3]}; *(v2u*)(F.ws + WS_U8 + i * 8) = pack_fp8x8(xx); }
    }
}

__device__ __forceinline__ void phase3(Frame& F) {
    const bf16* P = (const bf16*)(F.ws + WS_P); const float* MISC = (const float*)(F.ws + WS_MISC);
    bf16* CQ = (bf16*)(F.ws + WS_CQ); bf16* CKV = (bf16*)(F.ws + WS_CKV); bf16* KI = (bf16*)(F.ws + WS_KI); float* WI = (float*)(F.ws + WS_WI);
    float* IG = (float*)(F.ws + WS_IG); float* LF = (float*)(F.ws + WS_LF); bf16* QM = (bf16*)(F.ws + WS_QM); bf16* KM = (bf16*)(F.ws + WS_KM);
    const float* g_q = F.p_I_GQ; const float* g_kv = F.p_I_GKV; const float* g_kidx = F.p_I_GKIDX; const float* b_kidx = F.p_I_BKIDX;
    const float* conv_w = F.p_I_CONVW; const float* conv_b = F.p_I_CONVB;
    const int gw = F.bid * NWAVES + F.wave, NGW = F.G * NWAVES, lane = F.lane;
    f32x4 gq_[4]; const f32x4 gkv0 = *(const f32x4*)(g_kv + lane * 8), gkv1 = *(const f32x4*)(g_kv + lane * 8 + 4); const float gki = g_kidx[lane], bki = b_kidx[lane];
#pragma unroll
    for (int j = 0; j < 2; ++j) { gq_[2 * j] = *(const f32x4*)(g_q + j * 512 + lane * 8); gq_[2 * j + 1] = *(const f32x4*)(g_q + j * 512 + lane * 8 + 4); }
    for (int t = gw; t < T_SEQ; t += NGW) {
        const bf16* prow = P + (size_t)t * NP;
        { f32x4 a[4]; float ss = 0.f;
#pragma unroll
          for (int j = 0; j < 2; ++j) { const v4u w = *(const v4u*)(prow + PC_QLAT + j * 512 + lane * 8); pg8::unpack8(w, a[2 * j], a[2 * j + 1]); }
#pragma unroll
          for (int j = 0; j < 4; ++j) ss += (a[j][0] * a[j][0] + a[j][1] * a[j][1]) + (a[j][2] * a[j][2] + a[j][3] * a[j][3]);
          const float rstd = rsqrtf(wave_sum(ss) * (1.0f / 1024.0f) + NORM_EPS);
#pragma unroll
          for (int j = 0; j < 2; ++j) { const int c = j * 512 + lane * 8; const f32x4 g0 = gq_[2 * j], g1 = gq_[2 * j + 1];
              const f32x4 y0 = a[2 * j] * rstd * g0, y1 = a[2 * j + 1] * rstd * g1;
              *(v4u*)(CQ + (size_t)t * 1024 + c) = pg8::pack8(y0, y1);
              { const float x[8] = {y0[0], y0[1], y0[2], y0[3], y1[0], y1[1], y1[2], y1[3]}; *(v2u*)(F.ws + WS_CQ8 + (size_t)t * 1024 + c) = pack_fp8x8(x); } } }
        { f32x4 a0, a1; const v4u w = *(const v4u*)(prow + PC_KV + lane * 8); pg8::unpack8(w, a0, a1);
          const float ss = (a0[0] * a0[0] + a0[1] * a0[1]) + (a0[2] * a0[2] + a0[3] * a0[3]) + (a1[0] * a1[0] + a1[1] * a1[1]) + (a1[2] * a1[2] + a1[3] * a1[3]);
          const float rstd = rsqrtf(wave_sum(ss) * (1.0f / 512.0f) + NORM_EPS);
          *(v4u*)(CKV + (size_t)t * 512 + lane * 8) = pg8::pack8(a0 * rstd * gkv0, a1 * rstd * gkv1); }
        { const float* mrow = MISC + (size_t)t * 256;
          const float kv = mrow[lane]; const float mu = wave_sum(kv) * (1.0f / 64.0f); const float dlt = kv - mu; const float var = wave_sum(dlt * dlt) * (1.0f / 64.0f);
          const float y = dlt * rsqrtf(var + NORM_EPS) * gki + bki;
          KI[(size_t)t * 64 + lane] = (bf16)(cvt_pk_bf16(y, 0.f) & 0xffffu);
          if (lane < 32) WI[(size_t)t * 32 + lane] = mrow[64 + lane] * 0.022097086912079608f;
          if (lane < 16) { const float gpre = mrow[96 + lane]; const float sc = SOFTCAP * tanhf(gpre * (1.0f / SOFTCAP));
              if (lane < 8) IG[(size_t)t * 8 + lane] = sc;
              else { const float ls = fminf(sc, 0.f) - log1pf(__expf(-fabsf(sc))); LF[(size_t)t * 8 + lane - 8] = ls; } } }
    }
    for (int it = gw; it < 8 * (T_SEQ / 32); it += NGW) {
        const int j = it & 7, t0 = (it >> 3) * 32, c = j * 512 + lane * 8;
        f32x4 w0[4], w1[4];
#pragma unroll
        for (int w = 0; w < 4; ++w) { w0[w] = *(const f32x4*)(conv_w + w * 4096 + c); w1[w] = *(const f32x4*)(conv_w + w * 4096 + c + 4); }
        const f32x4 b0 = *(const f32x4*)(conv_b + c), b1 = *(const f32x4*)(conv_b + c + 4);
        v4u rows[35];
#pragma unroll
        for (int r = 0; r < 35; ++r) { const int tt = t0 - 3 + r; rows[r] = (tt >= 0) ? *(const v4u*)(P + (size_t)tt * NP + PC_QK + c) : (v4u){0u, 0u, 0u, 0u}; }
#pragma unroll
        for (int r = 0; r < 32; ++r) { f32x4 s0 = b0, s1 = b1;
#pragma unroll
            for (int w = 0; w < 4; ++w) { f32x4 a0, a1; pg8::unpack8(rows[r + w], a0, a1); s0 += a0 * w0[w]; s1 += a1 * w1[w]; }
#pragma unroll
            for (int e = 0; e < 4; ++e) { s0[e] = silu_f(s0[e]); s1[e] = silu_f(s1[e]); }
            if (c < 2048) *(v4u*)(QM + (size_t)(t0 + r) * 2048 + c) = pg8::pack8(s0, s1);
            else *(v4u*)(KM + (size_t)(t0 + r) * 2048 + (c - 2048)) = pg8::pack8(s0 * 0.0625f, s1 * 0.0625f); }
    }
}

__device__ __forceinline__ void phase5(Frame& F) {
    const bf16* QA = (const bf16*)(F.ws + WS_QA); const bf16* KI = (const bf16*)(F.ws + WS_KI); const float* WI = (const float*)(F.ws + WS_WI); float* SC = (float*)(F.ws + WS_SC);
    const int gw = F.bid * NWAVES + F.wave, NGW = F.G * NWAVES, lane = F.lane, r = lane & 31, h = lane >> 5;
    for (int qi = gw; qi < T_SEQ; qi += NGW) {
        const int grp = qi / NGW, j = qi % NGW; int t;
        if (NGW * 4 == T_SEQ) t = (grp == 0) ? j : (grp == 1) ? (T_SEQ / 2 - 1 - j) : (grp == 2) ? (T_SEQ / 2 + j) : (T_SEQ - 1 - j); else t = qi;
        bf16x8 a[4]; float wv[16];
#pragma unroll
        for (int ks = 0; ks < 4; ++ks) a[ks] = *(const bf16x8*)(QA + (size_t)t * NQA + 16384 + r * 64 + ks * 16 + h * 8);
#pragma unroll
        for (int i = 0; i < 16; ++i) wv[i] = WI[(size_t)t * 32 + (i & 3) + 8 * (i >> 2) + 4 * h];
        const int nkb = t / 32 + 1;
        for (int kb = 0; kb < nkb; ++kb) {
            const bf16* kp = KI + (size_t)(kb * 32 + r) * 64 + h * 8;
            f32x16 acc;
#pragma unroll
            for (int i = 0; i < 16; ++i) acc[i] = 0.f;
#pragma unroll
            for (int ks = 0; ks < 4; ++ks) { const bf16x8 b = *(const bf16x8*)(kp + ks * 16); acc = __builtin_amdgcn_mfma_f32_32x32x16_bf16(a[ks], b, acc, 0, 0, 0); }
            float s = 0.f;
#pragma unroll
            for (int i = 0; i < 16; ++i) s += wv[i] * fmaxf(acc[i], 0.f);
            s += __shfl_xor(s, 32);
            if (lane < 32) SC[(size_t)t * T_SEQ + kb * 32 + lane] = s;
        }
    }
}

__device__ __forceinline__ unsigned f2key(float f) { const unsigned u = __float_as_uint(f); return (u & 0x80000000u) ? ~u : (u | 0x80000000u); }
__device__ __forceinline__ int select_topk(Frame& F, const float* row, int n, LAS unsigned* w, LAS int* idx) {
    LAS unsigned* hist = w; LAS unsigned* bmg = w + 256; LAS unsigned* bme = w + 512; LAS unsigned* scan = w + 768; LAS unsigned* ctl = w + 800;
    const int tid = F.tid;
    if (n <= TOPK) { if (tid < TOPK) idx[tid] = tid < n ? tid : 0; __syncthreads(); return n; }
    unsigned prefix = 0u, mask = 0u, kth = TOPK;
#pragma unroll 1
    for (int pass = 0; pass < 4; ++pass) {
        const int shift = 24 - 8 * pass;
        if (tid < 256) hist[tid] = 0u;
        __syncthreads();
        for (int i = tid; i < n; i += 512) { const unsigned k = f2key(row[i]); if ((k & mask) == prefix) __hip_atomic_fetch_add(&hist[(k >> shift) & 255u], 1u, __ATOMIC_RELAXED, __HIP_MEMORY_SCOPE_WORKGROUP); }
        __syncthreads();
        if (tid < 256) { unsigned above = 0u; for (int b = tid + 1; b < 256; ++b) above += hist[b];
            const unsigned mine = hist[tid]; if (above < kth && kth <= above + mine) { ctl[0] = (unsigned)tid; ctl[1] = kth - above; } }
        __syncthreads();
        prefix |= ctl[0] << shift; mask |= 0xffu << shift; kth = ctl[1];
        __syncthreads();
    }
    if (tid < 256) { bmg[tid] = 0u; bme[tid] = 0u; }
    __syncthreads();
    for (int i = tid; i < n; i += 512) { const unsigned k = f2key(row[i]); if (k > prefix) __hip_atomic_fetch_or(&bmg[i >> 5], 1u << (i & 31), __ATOMIC_RELAXED, __HIP_MEMORY_SCOPE_WORKGROUP); else if (k == prefix) __hip_atomic_fetch_or(&bme[i >> 5], 1u << (i & 31), __ATOMIC_RELAXED, __HIP_MEMORY_SCOPE_WORKGROUP); }
    __syncthreads();
    unsigned word = 0u, excl = 0u;
    if (tid < 256) {
        word = bme[tid]; const unsigned ce = __popc(word); unsigned incl = ce;
#pragma unroll
        for (int o = 1; o < 64; o <<= 1) { const unsigned v = __shfl_up(incl, o); if (F.lane >= o) incl += v; }
        if (F.lane == 63) scan[F.wave] = incl;
        excl = incl - ce;
    }
    __syncthreads();
    if (tid < 256) {
        unsigned rnk = excl; for (int wv = 0; wv < F.wave; ++wv) rnk += scan[wv];
        unsigned e = word, keep = 0u;
        while (e) { const unsigned b = e & (0u - e); if (rnk < kth) keep |= b; ++rnk; e ^= b; }
        word = bmg[tid] | keep;
        const unsigned cw = __popc(word); unsigned incl = cw;
#pragma unroll
        for (int o = 1; o < 64; o <<= 1) { const unsigned v = __shfl_up(incl, o); if (F.lane >= o) incl += v; }
        if (F.lane == 63) scan[16 + F.wave] = incl;
        excl = incl - cw;
    }
    __syncthreads();
    if (tid < 256) {
        unsigned pos = excl; for (int wv = 0; wv < F.wave; ++wv) pos += scan[16 + wv];
        unsigned e = word;
        while (e) { const int b = __ffs(e) - 1; if (pos < (unsigned)TOPK) idx[pos] = tid * 32 + b; ++pos; e &= e - 1u; }
    }
    __syncthreads();
    return TOPK;
}

__device__ __forceinline__ void phase6_simple(Frame& F) {
    const bf16* QA = (const bf16*)(F.ws + WS_QA); const bf16* CKV = (const bf16*)(F.ws + WS_CKV); const float* SC = (const float*)(F.ws + WS_SC); bf16* OLAT = (bf16*)(F.ws + WS_OLAT);
    LAS float* qab = (LAS float*)F.lds;
    LAS float* pl = (LAS float*)(F.lds + 65536);
    LAS int* idx = (LAS int*)(F.lds + 98304);
    LAS unsigned* selw = (LAS unsigned*)(F.lds + 98304 + 1024);
    const int tid = F.tid;
    for (int qn = F.bid; qn < T_SEQ; qn += F.G) {
        const int rnd = qn / F.G; const int t = (rnd & 1) ? (T_SEQ - 1 - (rnd >> 1) * F.G - F.bid) : ((rnd >> 1) * F.G + F.bid);
        const int cnt = select_topk(F, SC + (size_t)t * T_SEQ, t + 1, selw, idx);
        { const bf16* qrow = QA + (size_t)t * NQA;
#pragma unroll
          for (int i = 0; i < 4; ++i) { const int e = (tid + 512 * i) * 8; const v4u w = *(const v4u*)(qrow + e); f32x4 a0, a1; pg8::unpack8(w, a0, a1); *(LAS f32x4*)(qab + e) = a0; *(LAS f32x4*)(qab + e + 4) = a1; } }
        __syncthreads();
        { const int kk = tid & 255, hg = tid >> 8; const int key = idx[kk]; const bool valid = kk < cnt;
          float acc[16];
#pragma unroll
          for (int j = 0; j < 16; ++j) acc[j] = 0.f;
          const bf16* krow = CKV + (size_t)key * 512;
          for (int r8 = 0; r8 < 64; ++r8) { const v4u w = *(const v4u*)(krow + r8 * 8); f32x4 k0, k1; pg8::unpack8(w, k0, k1);
#pragma unroll
              for (int j = 0; j < 16; ++j) { const LAS float* qp = qab + (hg * 16 + j) * 512 + r8 * 8; const f32x4 q0 = *(const LAS f32x4*)qp, q1 = *(const LAS f32x4*)(qp + 4);
                  acc[j] += (q0[0] * k0[0] + q0[1] * k0[1]) + (q0[2] * k0[2] + q0[3] * k0[3]) + (q1[0] * k1[0] + q1[1] * k1[1]) + (q1[2] * k1[2] + q1[3] * k1[3]); } }
          const float dist = (float)(t - key);
#pragma unroll
          for (int j = 0; j < 16; ++j) { const int hh = hg * 16 + j; const float slope = exp2f(-8.0f * (float)(hh + 1) / 32.0f);
              pl[kk * 32 + hh] = valid ? (acc[j] * 0.08838834764831845f - slope * dist) : -INFINITY; } }
        __syncthreads();
        { for (int hq = 0; hq < 4; ++hq) { const int hh = F.wave * 4 + hq; float v[4]; float mx = -INFINITY;
#pragma unroll
              for (int i = 0; i < 4; ++i) { v[i] = pl[(F.lane + 64 * i) * 32 + hh]; mx = fmaxf(mx, v[i]); }
              mx = wave_max(mx); float sm = 0.f;
#pragma unroll
              for (int i = 0; i < 4; ++i) { v[i] = __expf(v[i] - mx); sm += v[i]; }
              sm = wave_sum(sm); const float inv = 1.0f / sm;
#pragma unroll
              for (int i = 0; i < 4; ++i) { const float p = v[i] * inv; pl[(F.lane + 64 * i) * 32 + hh] = bf_lo(cvt_pk_bf16(p, 0.f)); } } }
        __syncthreads();
        { float o[32];
#pragma unroll
          for (int j = 0; j < 32; ++j) o[j] = 0.f;
          for (int k = 0; k < cnt; ++k) { const float v = bf_lo((unsigned)CKV[(size_t)idx[k] * 512 + tid]);
#pragma unroll
              for (int q = 0; q < 8; ++q) { const f32x4 p4 = *(const LAS f32x4*)(pl + k * 32 + q * 4); o[q * 4 + 0] += p4[0] * v; o[q * 4 + 1] += p4[1] * v; o[q * 4 + 2] += p4[2] * v; o[q * 4 + 3] += p4[3] * v; } }
          bf16* orow = OLAT + (size_t)t * 16384 + tid;
#pragma unroll
          for (int j = 0; j < 32; ++j) orow[j * 512] = (bf16)(cvt_pk_bf16(o[j], 0.f) & 0xffffu); }
        __syncthreads();
    }
}

__device__ __forceinline__ void phase8_simple(Frame& F) {
    const bf16* QM = (const bf16*)(F.ws + WS_QM); const bf16* KM = (const bf16*)(F.ws + WS_KM); const bf16* P = (const bf16*)(F.ws + WS_P);
    const float* IG = (const float*)(F.ws + WS_IG); const float* LF = (const float*)(F.ws + WS_LF); float* HNUM = (float*)(F.ws + WS_HNUM); float* DEN = (float*)(F.ws + WS_DEN);
    LAS bf16* qs = (LAS bf16*)F.lds;
    LAS bf16* ks = (LAS bf16*)(F.lds + 32768);
    LAS float* vs = (LAS float*)(F.lds + 65536);
    LAS float* gs = (LAS float*)(F.lds + 65536 + 4096);
    LAS float* red = (LAS float*)(F.lds + 65536 + 8192);
    const int tid = F.tid, c = tid & 15, dg = tid >> 4;
    for (int blk = F.bid; blk < 256; blk += F.G) {
        const int h = blk >> 5, c0 = (blk & 31) * 16;
        float C[8], nn[8]; float m = 0.f;
#pragma unroll
        for (int j = 0; j < 8; ++j) { C[j] = 0.f; nn[j] = 0.f; }
        for (int ch = 0; ch < T_SEQ / 64; ++ch) {
            const int t0 = ch * 64;
            __syncthreads();
#pragma unroll
            for (int i = 0; i < 4; ++i) { const int e = tid + 512 * i, rr = e >> 5, cc = (e & 31) * 8;
                *(LAS v4u*)(qs + rr * 256 + cc) = *(const v4u*)(QM + (size_t)(t0 + rr) * 2048 + h * 256 + cc);
                *(LAS v4u*)(ks + rr * 256 + cc) = *(const v4u*)(KM + (size_t)(t0 + rr) * 2048 + h * 256 + cc); }
#pragma unroll
            for (int i = 0; i < 2; ++i) { const int e = tid + 512 * i, rr = e >> 4, cc = e & 15; vs[e] = bf_lo((unsigned)P[(size_t)(t0 + rr) * NP + PC_V + h * 512 + c0 + cc]); }
            if (tid < 64) { gs[tid * 2] = IG[(size_t)(t0 + tid) * 8 + h]; gs[tid * 2 + 1] = LF[(size_t)(t0 + tid) * 8 + h]; }
            __syncthreads();
            for (int s = 0; s < 64; ++s) {
                const float ig = gs[s * 2], lf = gs[s * 2 + 1];
                const float mn = fmaxf(lf + m, ig); const float fa = __expf(lf + m - mn), ia = __expf(ig - mn); m = mn;
                const v4u qw = *(const LAS v4u*)(qs + s * 256 + dg * 8), kw = *(const LAS v4u*)(ks + s * 256 + dg * 8);
                f32x4 q0, q1, k0, k1; pg8::unpack8(qw, q0, q1); pg8::unpack8(kw, k0, k1);
                const float kk[8] = {k0[0], k0[1], k0[2], k0[3], k1[0], k1[1], k1[2], k1[3]}; const float qq[8] = {q0[0], q0[1], q0[2], q0[3], q1[0], q1[1], q1[2], q1[3]};
                const float vv = vs[s * 16 + c] * ia; float pn = 0.f, pq = 0.f;
#pragma unroll
                for (int j = 0; j < 8; ++j) { C[j] = fa * C[j] + kk[j] * vv; nn[j] = fa * nn[j] + ia * kk[j]; pn += C[j] * qq[j]; pq += nn[j] * qq[j]; }
                pn += __shfl_xor(pn, 16); pn += __shfl_xor(pn, 32); pq += __shfl_xor(pq, 16); pq += __shfl_xor(pq, 32);
                LAS float* rb = red + (s & 1) * 160;
                if (F.lane < 16) { rb[F.wave * 20 + c] = pn; if (c == 0) rb[F.wave * 20 + 16] = pq; }
                __syncthreads();
                if (tid < 17) { float sm = 0.f;
#pragma unroll
                    for (int wv = 0; wv < 8; ++wv) sm += rb[wv * 20 + tid];
                    if (tid < 16) HNUM[(size_t)(t0 + s) * 4096 + h * 512 + c0 + tid] = sm;
                    else if (c0 == 0) DEN[(size_t)(t0 + s) * 8 + h] = fmaxf(fabsf(sm), __expf(-m)); }
            }
        }
    }
}

__device__ __forceinline__ void phase9(Frame& F) {
    const float* HNUM = (const float*)(F.ws + WS_HNUM); const float* DEN = (const float*)(F.ws + WS_DEN); const bf16* P = (const bf16*)(F.ws + WS_P); bf16* HG = (bf16*)(F.ws + WS_HG);
    const float* g_mh = F.p_I_GMH;
    const int gw = F.bid * NWAVES + F.wave, NGW = F.G * NWAVES, lane = F.lane;
    const int h = gw & 7;
    const f32x4 g0 = *(const f32x4*)(g_mh + h * 512 + lane * 8), g1 = *(const f32x4*)(g_mh + h * 512 + lane * 8 + 4);
#pragma unroll 4
    for (int it = gw; it < T_SEQ * MH; it += NGW) {
        const int t = it >> 3; const size_t off = (size_t)t * 4096 + h * 512 + lane * 8;
        const f32x4 a0 = *(const f32x4*)(HNUM + off), a1 = *(const f32x4*)(HNUM + off + 4);
        const float ss = wave_sum((a0[0] * a0[0] + a0[1] * a0[1]) + (a0[2] * a0[2] + a0[3] * a0[3]) + (a1[0] * a1[0] + a1[1] * a1[1]) + (a1[2] * a1[2] + a1[3] * a1[3]));
        const float d = DEN[(size_t)t * 8 + h];
        const float sc = rsqrtf(ss * (1.0f / 512.0f) + NORM_EPS * d * d);
        f32x4 o0, o1, z0, z1; pg8::unpack8(*(const v4u*)(P + (size_t)t * NP + PC_O + h * 512 + lane * 8), o0, o1); pg8::unpack8(*(const v4u*)(P + (size_t)t * NP + PC_ZM + h * 512 + lane * 8), z0, z1);
        { const f32x4 r0 = a0 * sc * g0 * o0 * z0 * 4.0f, r1 = a1 * sc * g1 * o1 * z1 * 4.0f; const float x[8] = {r0[0], r0[1], r0[2], r0[3], r1[0], r1[1], r1[2], r1[3]};
          *(v2u*)((unsigned char*)HG + off) = pack_fp8x8(x); }
    }
}

__device__ __forceinline__ void phase12(Frame& F) {
    const float* ln_g = F.p_I_LNG; const float* ln_b = F.p_I_LNB; const bf16* Y = (const bf16*)(F.ws + WS_TMP);
    const int gw = F.bid * NWAVES + F.wave, NGW = F.G * NWAVES, lane = F.lane;
    f32x4 gg[16], bb[16];
#pragma unroll
    for (int j = 0; j < 16; ++j) { const int c = (j >> 1) * 512 + lane * 8 + (j & 1) * 4; gg[j] = *(const f32x4*)(ln_g + c); bb[j] = *(const f32x4*)(ln_b + c); }
    for (int t = gw; t < T_SEQ; t += NGW) {
        const bf16* yrow = Y + (size_t)t * DM; float* row = F.out + (size_t)t * DM; f32x4 v[16]; float s = 0.f;
#pragma unroll
        for (int j = 0; j < 8; ++j) { pg8::unpack8(*(const v4u*)(yrow + j * 512 + lane * 8), v[2 * j], v[2 * j + 1]); }
#pragma unroll
        for (int j = 0; j < 16; ++j) s += (v[j][0] + v[j][1]) + (v[j][2] + v[j][3]);
        const float mu = wave_sum(s) * (1.0f / 4096.0f); float q = 0.f;
#pragma unroll
        for (int j = 0; j < 16; ++j) { v[j] = v[j] - mu; q += (v[j][0] * v[j][0] + v[j][1] * v[j][1]) + (v[j][2] * v[j][2] + v[j][3] * v[j][3]); }
        const float rstd = rsqrtf(wave_sum(q) * (1.0f / 4096.0f) + NORM_EPS);
#pragma unroll
        for (int j = 0; j < 16; ++j) { const int c = (j >> 1) * 512 + lane * 8 + (j & 1) * 4; *(f32x4*)(row + c) = v[j] * rstd * gg[j] + bb[j]; }
    }
}
__device__ __forceinline__ bf16x8 tr_pair(const LAS unsigned char* p0, const LAS unsigned char* p1) {
    const s16x4 a = __builtin_amdgcn_ds_read_tr16_b64_v4i16((LAS s16x4*)p0), b = __builtin_amdgcn_ds_read_tr16_b64_v4i16((LAS s16x4*)p1);
    return (bf16x8){a[0], a[1], a[2], a[3], b[0], b[1], b[2], b[3]};
}
#define P8_DPP(old, src, ctrl, rmask) __builtin_bit_cast(float, __builtin_amdgcn_update_dpp(__builtin_bit_cast(int, (float)(old)), __builtin_bit_cast(int, (float)(src)), (ctrl), (rmask), 0xf, false))
__device__ __forceinline__ float wave_scan_add(float v) {
    v += P8_DPP(0.f, v, 0x111, 0xf); v += P8_DPP(0.f, v, 0x112, 0xf); v += P8_DPP(0.f, v, 0x114, 0xf); v += P8_DPP(0.f, v, 0x118, 0xf);
    v += P8_DPP(0.f, v, 0x142, 0xa); v += P8_DPP(0.f, v, 0x143, 0xc); return v;
}
__device__ __forceinline__ float wave_scan_max(float v) {
    const float e = -INFINITY;
    v = fmaxf(v, P8_DPP(e, v, 0x111, 0xf)); v = fmaxf(v, P8_DPP(e, v, 0x112, 0xf)); v = fmaxf(v, P8_DPP(e, v, 0x114, 0xf)); v = fmaxf(v, P8_DPP(e, v, 0x118, 0xf));
    v = fmaxf(v, P8_DPP(e, v, 0x142, 0xa)); v = fmaxf(v, P8_DPP(e, v, 0x143, 0xc)); return v;
}
#define P8_DPPI(old, src, ctrl, rmask) __builtin_amdgcn_update_dpp((int)(old), (int)(src), (ctrl), (rmask), 0xf, false)
__device__ __forceinline__ unsigned wave_scan_add_u32(unsigned v) {
    v += (unsigned)P8_DPPI(0, v, 0x111, 0xf); v += (unsigned)P8_DPPI(0, v, 0x112, 0xf); v += (unsigned)P8_DPPI(0, v, 0x114, 0xf); v += (unsigned)P8_DPPI(0, v, 0x118, 0xf);
    v += (unsigned)P8_DPPI(0, v, 0x142, 0xa); v += (unsigned)P8_DPPI(0, v, 0x143, 0xc); return v;
}
__device__ __forceinline__ unsigned lane63_u32(unsigned v) { return (unsigned)__builtin_amdgcn_readlane((int)v, 63); }
__device__ __forceinline__ float row16_allmax(float v) {
    v = fmaxf(v, P8_DPP(v, v, 0x128, 0xf)); v = fmaxf(v, P8_DPP(v, v, 0x124, 0xf)); v = fmaxf(v, P8_DPP(v, v, 0x122, 0xf)); v = fmaxf(v, P8_DPP(v, v, 0x121, 0xf)); return v;
}
__device__ __forceinline__ float row16_allsum(float v) {
    v += P8_DPP(v, v, 0x128, 0xf); v += P8_DPP(v, v, 0x124, 0xf); v += P8_DPP(v, v, 0x122, 0xf); v += P8_DPP(v, v, 0x121, 0xf); return v;
}
__device__ __forceinline__ float xor32_allsum(float v) {
    float a = v, b = v;
    asm volatile("s_nop 1\n\tv_permlane32_swap_b32 %0, %1" : "+v"(a), "+v"(b));
    return a + b;
}
__device__ __forceinline__ void p8_gates(float ig, float lf, float& m_prev, LAS float* GA, int l) {
    const float b = wave_scan_add(lf);
    const float a = ig - b; const float cm = wave_scan_max(a);
    const float M = fmaxf(m_prev, cm);
    const float M63 = __builtin_bit_cast(float, __builtin_amdgcn_readlane(__builtin_bit_cast(int, M), 63)), g = __builtin_bit_cast(float, __builtin_amdgcn_readlane(__builtin_bit_cast(int, b), 63));
    GA[l] = a; GA[64 + l] = M; GA[128 + l] = __expf(m_prev - M); GA[192 + l] = __expf(-(b + M)); GA[256 + l] = __expf(a - M63);
    if (l == 0) GA[320] = __expf(m_prev - M63);
    m_prev = g + M63;
}
template <int VAR> __device__ __forceinline__ void phase8_fast(Frame& F) {
    const bf16* QM = (const bf16*)(F.ws + WS_QM); const bf16* KM = (const bf16*)(F.ws + WS_KM); const bf16* P = (const bf16*)(F.ws + WS_P);
    const float* IG = (const float*)(F.ws + WS_IG); const float* LF = (const float*)(F.ws + WS_LF); float* HNUM = (float*)(F.ws + (VAR ? WS_SC : WS_HNUM)); float* DEN = (float*)(F.ws + (VAR ? WS_SC + 192 * MiB : WS_DEN));
    constexpr int QRS = 528, SRS = 144;
    constexpr int O_QS = 0, O_KS = 33792, O_VS = 67584, O_VW = 69632, O_VS1 = 71680, O_VW1 = 73728, O_SS = 75776, O_CT0 = 84992, O_CT1 = 93440, O_GA = 101888, O_HQX = 104960;
    constexpr int GW = 4;
    LAS unsigned char* L = F.lds;
    const int tid = F.tid, w = F.wave, l = F.lane, quad = l >> 4, r16 = l & 15;
    for (int blk = F.bid; blk < 256; blk += F.G) {
        const int h = blk >> 5, c0 = (blk & 31) * 16; const int nt = (c0 == 0) ? 2 : 1;
        LDS_BARRIER();
        for (int i = tid; i < (2 * 8448) / 4; i += 512) ((LAS unsigned*)(L + O_CT0))[i] = 0u;
        for (int i = tid; i < 512; i += 512) { ((LAS unsigned*)(L + O_VS1))[i] = ((i & 7) == 0) ? 0x00003F80u : 0u; ((LAS unsigned*)(L + O_VW1))[i] = 0u; }
        f32x4 Cst[2][2];
#pragma unroll
        for (int a = 0; a < 2; ++a)
#pragma unroll
            for (int b = 0; b < 2; ++b) Cst[a][b] = (f32x4){0.f, 0.f, 0.f, 0.f};
        float m_prev = 0.f;
        const unsigned voff = (unsigned)((tid >> 5) * 4096 + (tid & 31) * 16), voffv = (unsigned)((tid >> 1) * (NP * 2) + (tid & 1) * 16);
        v4u pq[4], pk[4], pv = (v4u){0u, 0u, 0u, 0u}; float pgi = 0.f, pgf = 0.f;
        const __amdgpu_buffer_rsrc_t rQ = __builtin_amdgcn_make_buffer_rsrc((void*)(QM + h * 256), 0, T_SEQ * 4096, 0x00020000), rK = __builtin_amdgcn_make_buffer_rsrc((void*)(KM + h * 256), 0, T_SEQ * 4096, 0x00020000),
                                     rV = __builtin_amdgcn_make_buffer_rsrc((void*)(P + PC_V + h * 512 + c0), 0, (int)((size_t)T_SEQ * NP * 2 - (size_t)(PC_V + h * 512 + c0) * 2), 0x00020000);
        const __amdgpu_buffer_rsrc_t rH = __builtin_amdgcn_make_buffer_rsrc((void*)(HNUM + h * 512 + c0), 0, T_SEQ * 16384, 0x00020000), rD = __builtin_amdgcn_make_buffer_rsrc((void*)(DEN + h), 0, T_SEQ * 32, 0x00020000);
        const unsigned hoff = (unsigned)((((w & 3) * 16 + quad * 4) * 4096 + r16) * 4), doff = (unsigned)(((w & 3) * 16 + quad * 4) * 32);
#pragma unroll
        for (int i = 0; i < 4; ++i) { pq[i] = __builtin_bit_cast(v4u, __builtin_amdgcn_raw_buffer_load_b128(rQ, voff, i * 65536, 0)); pk[i] = __builtin_bit_cast(v4u, __builtin_amdgcn_raw_buffer_load_b128(rK, voff, i * 65536, 0)); }
        if (tid < 128) pv = __builtin_bit_cast(v4u, __builtin_amdgcn_raw_buffer_load_b128(rV, voffv, 0, 0));
        if (w == GW) { pgi = IG[(size_t)l * 8 + h]; pgf = LF[(size_t)l * 8 + h]; }
        if (w == GW) p8_gates(pgi, pgf, m_prev, (LAS float*)(L + O_GA), l);
        for (int ch = 0; ch < T_SEQ / 64; ++ch) {
          {
            const int t0 = ch * 64; const int s2 = ch & 1;
            LAS float* GA = (LAS float*)(L + O_GA + s2 * 1536);
#pragma unroll
            for (int i = 0; i < 4; ++i) { const int e = tid + 512 * i, rr = e >> 5, cc = e & 31; *(LAS v4u*)(L + O_QS + rr * QRS + cc * 16) = pq[i]; *(LAS v4u*)(L + O_KS + rr * QRS + cc * 16) = pk[i]; }
            if (tid < 128) *(LAS v4u*)(L + O_VS + (tid >> 1) * 32 + (tid & 1) * 16) = pv;
            LDS_BARRIER();
            if (VAR != 1 && ch + 1 < T_SEQ / 64) { const int t1 = t0 + 64;
#pragma unroll
                for (int i = 0; i < 4; ++i) { pq[i] = __builtin_bit_cast(v4u, __builtin_amdgcn_raw_buffer_load_b128(rQ, voff, t1 * 4096 + i * 65536, 0)); pk[i] = __builtin_bit_cast(v4u, __builtin_amdgcn_raw_buffer_load_b128(rK, voff, t1 * 4096 + i * 65536, 0)); }
                if (tid < 128) pv = __builtin_bit_cast(v4u, __builtin_amdgcn_raw_buffer_load_b128(rV, voffv, t1 * (NP * 2), 0));
                if (w == GW) { pgi = IG[(size_t)(t1 + l) * 8 + h]; pgf = LF[(size_t)(t1 + l) * 8 + h]; } }
            const int jt = w & 3, sp = w >> 2, j0 = jt * 16;
            if (tid < 128) { const int rr = tid >> 1; const float wg = GA[256 + rr]; const v4u vv = *(const LAS v4u*)(L + O_VS + rr * 32 + (tid & 1) * 16); f32x4 x0, x1; pg8::unpack8(vv, x0, x1);
                *(LAS v4u*)(L + O_VW + rr * 32 + (tid & 1) * 16) = pg8::pack8(x0 * wg, x1 * wg); }
            if (nt == 2 && tid >= 128 && tid < 192) { const int rr = tid - 128; *(LAS unsigned short*)(L + O_VW1 + rr * 32) = (unsigned short)(cvt_pk_bf16(GA[256 + rr], 0.f) & 0xffffu); }
            f32x4 sacc[2], hq[2];
            sacc[0] = (f32x4){0.f, 0.f, 0.f, 0.f}; sacc[1] = sacc[0]; hq[0] = sacc[0]; hq[1] = sacc[0];
#pragma unroll
            for (int kh = 0; kh < 2; ++kh) {
                bf16x8 aq[4], bk[2][4], bc[2][4];
#pragma unroll
                for (int k4 = 0; k4 < 4; ++k4) aq[k4] = *(const LAS bf16x8*)(L + O_QS + (j0 + r16) * QRS + ((kh * 4 + k4) * 32 + quad * 8) * 2);
#pragma unroll
                for (int si = 0; si < 2; ++si) { const int st = 2 * sp + si;
                    if (st <= jt) {
#pragma unroll
                        for (int k4 = 0; k4 < 4; ++k4) bk[si][k4] = *(const LAS bf16x8*)(L + O_KS + (st * 16 + r16) * QRS + ((kh * 4 + k4) * 32 + quad * 8) * 2); } }
                if (kh == sp) {
#pragma unroll
                    for (int k4 = 0; k4 < 4; ++k4) { bc[0][k4] = *(const LAS bf16x8*)(L + O_CT0 + r16 * QRS + ((kh * 4 + k4) * 32 + quad * 8) * 2);
                        if (nt == 2) bc[1][k4] = *(const LAS bf16x8*)(L + O_CT1 + r16 * QRS + ((kh * 4 + k4) * 32 + quad * 8) * 2); } }
                __builtin_amdgcn_sched_barrier(0);
#pragma unroll
                for (int k4 = 0; k4 < 4; ++k4) {
#pragma unroll
                    for (int si = 0; si < 2; ++si) { if (2 * sp + si <= jt) sacc[si] = __builtin_amdgcn_mfma_f32_16x16x32_bf16(aq[k4], bk[si][k4], sacc[si], 0, 0, 0); }
                    if (kh == sp) { hq[0] = __builtin_amdgcn_mfma_f32_16x16x32_bf16(aq[k4], bc[0][k4], hq[0], 0, 0, 0);
                        if (nt == 2) hq[1] = __builtin_amdgcn_mfma_f32_16x16x32_bf16(aq[k4], bc[1][k4], hq[1], 0, 0, 0); } }
                __builtin_amdgcn_sched_barrier(0);
            }
#pragma unroll
            for (int si = 0; si < 2; ++si) { const int st = 2 * sp + si, s0 = st * 16; f32x4 acc = sacc[si];
                if (st <= jt) { const int s = s0 + r16; const float as = GA[s];
#pragma unroll
                    for (int i = 0; i < 4; ++i) { const int j = j0 + quad * 4 + i; acc[i] = (s <= j) ? acc[i] * __expf(as - GA[64 + j]) : 0.f; } }
#pragma unroll
                for (int i = 0; i < 4; ++i) { const int j = j0 + quad * 4 + i; *(LAS unsigned short*)(L + O_SS + j * SRS + (s0 + r16) * 2) = (unsigned short)(cvt_pk_bf16(acc[i], 0.f) & 0xffffu); } }
            if (sp == 1) { *(LAS f32x4*)(L + O_HQX + ((jt * 2 + 0) * 64 + l) * 16) = hq[0]; if (nt == 2) *(LAS f32x4*)(L + O_HQX + ((jt * 2 + 1) * 64 + l) * 16) = hq[1]; }
            LDS_BARRIER();
            bf16x8 ak[2][2], bvw[2][2];
#pragma unroll
            for (int dt = 0; dt < 2; ++dt)
#pragma unroll
                for (int kk = 0; kk < 2; ++kk) { const LAS unsigned char* p0 = L + O_KS + (kk * 32 + 8 * quad + (r16 >> 2)) * QRS + ((2 * w + dt) * 16 + 4 * (r16 & 3)) * 2; ak[dt][kk] = tr_pair(p0, p0 + 4 * QRS); }
#pragma unroll
            for (int n = 0; n < 2; ++n) { if (n < nt) {
#pragma unroll
                for (int kk = 0; kk < 2; ++kk) { const LAS unsigned char* p0 = L + (n ? O_VW1 : O_VW) + (kk * 32 + 8 * quad + (r16 >> 2)) * 32 + (r16 & 3) * 8; bvw[n][kk] = tr_pair(p0, p0 + 4 * 32); } } }
            if (w < 4) {
                bf16x8 as2[2], bv[2][2]; f32x4 hx[2];
#pragma unroll
                for (int kk = 0; kk < 2; ++kk) as2[kk] = *(const LAS bf16x8*)(L + O_SS + (j0 + r16) * SRS + (kk * 32 + quad * 8) * 2);
#pragma unroll
                for (int n = 0; n < 2; ++n) { if (n < nt) { hx[n] = *(const LAS f32x4*)(L + O_HQX + ((jt * 2 + n) * 64 + l) * 16);
#pragma unroll
                    for (int kk = 0; kk < 2; ++kk) { const LAS unsigned char* p0 = L + (n ? O_VS1 : O_VS) + (kk * 32 + 8 * quad + (r16 >> 2)) * 32 + (r16 & 3) * 8; bv[n][kk] = tr_pair(p0, p0 + 4 * 32); } } }
#pragma unroll
                for (int n = 0; n < 2; ++n) { if (n < nt) {
                    f32x4 x = hq[n] + hx[n];
#pragma unroll
                    for (int i = 0; i < 4; ++i) x[i] *= GA[128 + j0 + quad * 4 + i];
#pragma unroll
                    for (int kk = 0; kk < 2; ++kk) x = __builtin_amdgcn_mfma_f32_16x16x32_bf16(as2[kk], bv[n][kk], x, 0, 0, 0);
                    if (n == 0) {
#pragma unroll
                        for (int i = 0; i < 4; ++i) __builtin_amdgcn_raw_buffer_store_b32(__float_as_uint(x[i]), rH, hoff, (t0 + i) * 16384, 0); }
                    else if (r16 == 0) {
#pragma unroll
                        for (int i = 0; i < 4; ++i) { const int j = j0 + quad * 4 + i; __builtin_amdgcn_raw_buffer_store_b32(__float_as_uint(fmaxf(fabsf(x[i]), GA[192 + j])), rD, doff, (t0 + i) * 32, 0); } } } }
            }
            { const float decay = GA[320];
#pragma unroll
              for (int dt = 0; dt < 2; ++dt) { const int d0 = (2 * w + dt) * 16;
#pragma unroll
                  for (int n = 0; n < 2; ++n) { if (n < nt) {
                      f32x4 c = Cst[dt][n] * decay;
#pragma unroll
                      for (int kk = 0; kk < 2; ++kk) c = __builtin_amdgcn_mfma_f32_16x16x32_bf16(ak[dt][kk], bvw[n][kk], c, 0, 0, 0);
                      Cst[dt][n] = c;
                      v2u o; o.x = cvt_pk_bf16(c[0], c[1]); o.y = cvt_pk_bf16(c[2], c[3]);
                      *(LAS v2u*)(L + (n ? O_CT1 : O_CT0) + r16 * QRS + (d0 + quad * 4) * 2) = o; } } } }
            if (w == GW && ch + 1 < T_SEQ / 64) p8_gates(pgi, pgf, m_prev, (LAS float*)(L + O_GA + (1 - s2) * 1536), l);
            LDS_BARRIER();
          }
        }
    }
}
__device__ __forceinline__ void mlstm_pre_item(Frame& F, int item) {
    const bf16* QM = (const bf16*)(F.ws + WS_QM); const bf16* KM = (const bf16*)(F.ws + WS_KM); const float* IG = (const float*)(F.ws + WS_IG); const float* LF = (const float*)(F.ws + WS_LF);
    bf16* SP = (bf16*)(F.ws + WS_SP); float* GAb = (float*)(F.ws + WS_GATES); float* GBb = GAb + 8 * T_SEQ; float* GCb = GBb + 8 * T_SEQ;
    LAS float* sc = (LAS float*)(F.lds + F.wave * 16384);
    const int h = item >> 7, ch = item & 127, t0 = ch * 64, l = F.lane, quad = l >> 4, r16 = l & 15;
    const float b = wave_scan_add(LF[(size_t)(t0 + l) * 8 + h]);
    const float a = IG[(size_t)(t0 + l) * 8 + h] - b; const float cm = wave_scan_max(a);
    GAb[(size_t)h * T_SEQ + t0 + l] = a; GBb[(size_t)h * T_SEQ + t0 + l] = b; GCb[(size_t)h * T_SEQ + t0 + l] = cm;
    sc[l] = a; sc[64 + l] = cm;
    LDS_WAIT(); asm volatile("" ::: "memory");
    bf16* sp = SP + (size_t)item * 4096;
#pragma unroll 1
    for (int jt = 0; jt < 4; ++jt) {
        bf16x8 aq[8];
#pragma unroll
        for (int kk = 0; kk < 8; ++kk) aq[kk] = *(const bf16x8*)(QM + (size_t)(t0 + jt * 16 + r16) * 2048 + h * 256 + kk * 32 + quad * 8);
#pragma unroll 1
        for (int st = 0; st < 4; ++st) {
            f32x4 acc = (f32x4){0.f, 0.f, 0.f, 0.f};
            if (st <= jt) {
                bf16x8 bk[8];
#pragma unroll
                for (int kk = 0; kk < 8; ++kk) bk[kk] = *(const bf16x8*)(KM + (size_t)(t0 + st * 16 + r16) * 2048 + h * 256 + kk * 32 + quad * 8);
#pragma unroll
                for (int kk = 0; kk < 8; ++kk) acc = __builtin_amdgcn_mfma_f32_16x16x32_bf16(aq[kk], bk[kk], acc, 0, 0, 0);
                const int s = st * 16 + r16; const float as = sc[s];
#pragma unroll
                for (int i = 0; i < 4; ++i) { const int j = jt * 16 + quad * 4 + i; acc[i] = (s <= j) ? acc[i] * __expf(as - sc[64 + j]) : 0.f; }
            }
#pragma unroll
            for (int i = 0; i < 4; ++i) sp[(jt * 16 + quad * 4 + i) * 64 + st * 16 + r16] = (bf16)(cvt_pk_bf16(acc[i], 0.f) & 0xffffu);
        }
    }
}

template <int VAR> __device__ __forceinline__ void phase8_v2(Frame& F) {
    const bf16* QM = (const bf16*)(F.ws + WS_QM); const bf16* KM = (const bf16*)(F.ws + WS_KM); const bf16* P = (const bf16*)(F.ws + WS_P); const bf16* SP = (const bf16*)(F.ws + WS_SP);
    const float* GAb = (const float*)(F.ws + WS_GATES); const float* GBb = GAb + 8 * T_SEQ; const float* GCb = GBb + 8 * T_SEQ;
    float* HNUM = (float*)(F.ws + (VAR ? WS_SC : WS_HNUM)); float* DEN = (float*)(F.ws + (VAR ? WS_SC + 192 * MiB : WS_DEN));
    constexpr int QRS = 528;
    constexpr int O_KS = 0, O_VS = 33792  , O_VW = 37888, O_VS1 = 39936, O_VW1 = 41984, O_CT = 44032  , O_HQX = 77824  , O_QS = 94208;
    LAS unsigned char* L = F.lds;
    const int tid = F.tid, w = F.wave, l = F.lane, quad = l >> 4, r16 = l & 15;
    const int jt = w & 3, sp_ = w >> 2, j0 = jt * 16;
    for (int blk = F.bid; blk < 256; blk += F.G) {
        const int h = blk >> 5, c0 = (blk & 31) * 16; const int nt = (c0 == 0) ? 2 : 1;
        LDS_BARRIER();
        for (int i = tid; i < (4 * 8448) / 4; i += 512) ((LAS unsigned*)(L + O_CT))[i] = 0u;
        for (int i = tid; i < 512; i += 512) { ((LAS unsigned*)(L + O_VS1))[i] = ((i & 7) == 0) ? 0x00003F80u : 0u; ((LAS unsigned*)(L + O_VW1))[i] = 0u; }
        f32x4 Cst[2][2];
#pragma unroll
        for (int a = 0; a < 2; ++a)
#pragma unroll
            for (int b = 0; b < 2; ++b) Cst[a][b] = (f32x4){0.f, 0.f, 0.f, 0.f};
        float m_prev = 0.f;
        const __amdgpu_buffer_rsrc_t rK = __builtin_amdgcn_make_buffer_rsrc((void*)(KM + h * 256), 0, T_SEQ * 4096, 0x00020000), rQ = __builtin_amdgcn_make_buffer_rsrc((void*)(QM + h * 256), 0, T_SEQ * 4096, 0x00020000),
                                     rV = __builtin_amdgcn_make_buffer_rsrc((void*)(P + PC_V + h * 512 + c0), 0, (int)((size_t)T_SEQ * NP * 2 - (size_t)(PC_V + h * 512 + c0) * 2), 0x00020000),
                                     rS = __builtin_amdgcn_make_buffer_rsrc((void*)(SP + (size_t)h * 128 * 4096), 0, 128 * 8192, 0x00020000),
                                     rH = __builtin_amdgcn_make_buffer_rsrc((void*)(HNUM + h * 512 + c0), 0, T_SEQ * 16384, 0x00020000), rD = __builtin_amdgcn_make_buffer_rsrc((void*)(DEN + h), 0, T_SEQ * 32, 0x00020000);
        const unsigned voffk = (unsigned)((tid >> 5) * 4096 + (tid & 31) * 16), voffv = (unsigned)((tid >> 1) * (NP * 2) + (tid & 1) * 16);
        const unsigned voffq = (unsigned)((j0 + r16) * 4096 + (sp_ * 128 + quad * 8) * 2), voffs = (unsigned)((j0 + r16) * 128 + quad * 16);
        const unsigned hoff = (unsigned)(((j0 + quad * 4) * 4096 + r16) * 4), doff = (unsigned)((j0 + quad * 4) * 32);
        const float* ga = GAb + (size_t)h * T_SEQ; const float* gb = GBb + (size_t)h * T_SEQ; const float* gc = GCb + (size_t)h * T_SEQ;
        const int vrow = (tid < 128) ? (tid >> 1) : ((tid - 128) & 63);
        v4u pk[2][4], pv[2]; bf16x8 pq[2][4], ps[2][2]; f32x4 pcm[2], pb[2]; float pa[2], pg[2], pamax[2];
#pragma unroll
        for (int z = 0; z < 2; ++z) { pv[z] = (v4u){0u, 0u, 0u, 0u}; pcm[z] = (f32x4){0.f, 0.f, 0.f, 0.f}; pb[z] = pcm[z]; ps[z][0] = (bf16x8){0, 0, 0, 0, 0, 0, 0, 0}; ps[z][1] = ps[z][0]; }
#define P8V2_FETCH(Z, T1) do { \
            _Pragma("unroll") for (int i = 0; i < 4; ++i) pk[Z][i] = __builtin_bit_cast(v4u, __builtin_amdgcn_raw_buffer_load_b128(rK, voffk, (T1) * 4096 + i * 65536, 0)); \
            if (tid < 128) pv[Z] = __builtin_bit_cast(v4u, __builtin_amdgcn_raw_buffer_load_b128(rV, voffv, (T1) * (NP * 2), 0)); \
            _Pragma("unroll") for (int i = 0; i < 4; ++i) pq[Z][i] = __builtin_bit_cast(bf16x8, __builtin_amdgcn_raw_buffer_load_b128(rQ, voffk, (T1) * 4096 + i * 65536, 0)); \
            if (w < 4) { _Pragma("unroll") for (int kk = 0; kk < 2; ++kk) ps[Z][kk] = __builtin_bit_cast(bf16x8, __builtin_amdgcn_raw_buffer_load_b128(rS, voffs, ((T1) >> 6) * 8192 + kk * 64, 0)); \
                pcm[Z] = *(const f32x4*)(gc + (T1) + j0 + quad * 4); pb[Z] = *(const f32x4*)(gb + (T1) + j0 + quad * 4); } \
            pa[Z] = ga[(T1) + vrow]; pg[Z] = gb[(T1) + 63]; pamax[Z] = gc[(T1) + 63]; } while (0)
        P8V2_FETCH(0, 0); P8V2_FETCH(1, 64);
        for (int ch2 = 0; ch2 < T_SEQ / 64; ch2 += 2) {
#pragma unroll
          for (int z = 0; z < 2; ++z) {
            const int ch = ch2 + z, t0 = ch * 64, cur = z, nxt = z ^ 1;
            const float M63 = fmaxf(m_prev, pamax[z]), decay = __expf(m_prev - M63), wg = __expf(pa[z] - M63);
            float rj[4], inj[4], enj[4];
#pragma unroll
            for (int i = 0; i < 4; ++i) { const float Mj = fmaxf(m_prev, pcm[z][i]); rj[i] = __expf(pcm[z][i] - Mj); inj[i] = __expf(m_prev - Mj); enj[i] = __expf(-(pb[z][i] + Mj)); }
            m_prev = pg[z] + M63;
#pragma unroll
            for (int i = 0; i < 4; ++i) { const int e = tid + 512 * i, rr = e >> 5, cc = e & 31; *(LAS v4u*)(L + O_KS + rr * QRS + cc * 16) = pk[z][i]; *(LAS bf16x8*)(L + O_QS + rr * QRS + cc * 16) = pq[z][i]; }
            if (tid < 128) { *(LAS v4u*)(L + O_VS + cur * 2048 + (tid >> 1) * 32 + (tid & 1) * 16) = pv[z]; f32x4 x0, x1; pg8::unpack8(pv[z], x0, x1); *(LAS v4u*)(L + O_VW + (tid >> 1) * 32 + (tid & 1) * 16) = pg8::pack8(x0 * wg, x1 * wg); }
            else if (nt == 2 && tid < 192) *(LAS unsigned short*)(L + O_VW1 + (tid - 128) * 32) = (unsigned short)(cvt_pk_bf16(wg, 0.f) & 0xffffu);
            bf16x8 aq[4], as2[2];
            as2[0] = ps[z][0]; as2[1] = ps[z][1];
            LDS_BARRIER();
#pragma unroll
            for (int k4 = 0; k4 < 4; ++k4) aq[k4] = *(const LAS bf16x8*)(L + O_QS + (j0 + r16) * QRS + ((sp_ * 4 + k4) * 32 + quad * 8) * 2);
            if (VAR != 1 && ch + 2 < T_SEQ / 64) P8V2_FETCH(z, t0 + 128);
            f32x4 hq[2];
            hq[0] = (f32x4){0.f, 0.f, 0.f, 0.f}; hq[1] = hq[0];
            { bf16x8 bc[2][4];
#pragma unroll
              for (int k4 = 0; k4 < 4; ++k4) { bc[0][k4] = *(const LAS bf16x8*)(L + O_CT + (cur * 2 + 0) * 8448 + r16 * QRS + ((sp_ * 4 + k4) * 32 + quad * 8) * 2);
                  if (nt == 2) bc[1][k4] = *(const LAS bf16x8*)(L + O_CT + (cur * 2 + 1) * 8448 + r16 * QRS + ((sp_ * 4 + k4) * 32 + quad * 8) * 2); }
#pragma unroll
              for (int k4 = 0; k4 < 4; ++k4) { hq[0] = __builtin_amdgcn_mfma_f32_16x16x32_bf16(aq[k4], bc[0][k4], hq[0], 0, 0, 0);
                  if (nt == 2) hq[1] = __builtin_amdgcn_mfma_f32_16x16x32_bf16(aq[k4], bc[1][k4], hq[1], 0, 0, 0); } }
            if (sp_ == 1) { *(LAS f32x4*)(L + O_HQX + cur * 8192 + ((jt * 2 + 0) * 64 + l) * 16) = hq[0]; if (nt == 2) *(LAS f32x4*)(L + O_HQX + cur * 8192 + ((jt * 2 + 1) * 64 + l) * 16) = hq[1]; }
            { bf16x8 ak[2][2], bvw[2][2];
#pragma unroll
              for (int dt = 0; dt < 2; ++dt)
#pragma unroll
                  for (int kk = 0; kk < 2; ++kk) { const LAS unsigned char* p0 = L + O_KS + (kk * 32 + 8 * quad + (r16 >> 2)) * QRS + ((2 * w + dt) * 16 + 4 * (r16 & 3)) * 2; ak[dt][kk] = tr_pair(p0, p0 + 4 * QRS); }
#pragma unroll
              for (int n = 0; n < 2; ++n) { if (n < nt) {
#pragma unroll
                  for (int kk = 0; kk < 2; ++kk) { const LAS unsigned char* p0 = L + (n ? O_VW1 : O_VW) + (kk * 32 + 8 * quad + (r16 >> 2)) * 32 + (r16 & 3) * 8; bvw[n][kk] = tr_pair(p0, p0 + 4 * 32); } } }
#pragma unroll
              for (int dt = 0; dt < 2; ++dt) { const int d0 = (2 * w + dt) * 16;
#pragma unroll
                  for (int n = 0; n < 2; ++n) { if (n < nt) {
                      f32x4 c = Cst[dt][n] * decay;
#pragma unroll
                      for (int kk = 0; kk < 2; ++kk) c = __builtin_amdgcn_mfma_f32_16x16x32_bf16(ak[dt][kk], bvw[n][kk], c, 0, 0, 0);
                      Cst[dt][n] = c;
                      v2u o; o.x = cvt_pk_bf16(c[0], c[1]); o.y = cvt_pk_bf16(c[2], c[3]);
                      *(LAS v2u*)(L + O_CT + (nxt * 2 + n) * 8448 + r16 * QRS + (d0 + quad * 4) * 2) = o; } } } }
            LDS_BARRIER();
            if (w < 4) {
#pragma unroll
                for (int n = 0; n < 2; ++n) { if (n < nt) {
                    const f32x4 hx = *(const LAS f32x4*)(L + O_HQX + cur * 8192 + ((jt * 2 + n) * 64 + l) * 16);
                    f32x4 x = (f32x4){0.f, 0.f, 0.f, 0.f};
                    const LAS unsigned char* vb = n ? (L + O_VS1) : (L + O_VS + cur * 2048);
#pragma unroll
                    for (int kk = 0; kk < 2; ++kk) { const LAS unsigned char* p0 = vb + (kk * 32 + 8 * quad + (r16 >> 2)) * 32 + (r16 & 3) * 8; x = __builtin_amdgcn_mfma_f32_16x16x32_bf16(as2[kk], tr_pair(p0, p0 + 4 * 32), x, 0, 0, 0); }
#pragma unroll
                    for (int i = 0; i < 4; ++i) x[i] = x[i] * rj[i] + inj[i] * (hq[n][i] + hx[i]);
                    if (n == 0) {
#pragma unroll
                        for (int i = 0; i < 4; ++i) __builtin_amdgcn_raw_buffer_store_b32(__float_as_uint(x[i]), rH, hoff, (t0 + i) * 16384, 0); }
                    else if (r16 == 0) {
#pragma unroll
                        for (int i = 0; i < 4; ++i) __builtin_amdgcn_raw_buffer_store_b32(__float_as_uint(fmaxf(fabsf(x[i]), enj[i])), rD, doff, (t0 + i) * 32, 0); } } }
            }
          }
        }
#undef P8V2_FETCH
    }
}
__device__ __forceinline__ void phase8_v3(Frame& F, int blk) {
    const bf16* QM = (const bf16*)(F.ws + WS_QM); const bf16* KM = (const bf16*)(F.ws + WS_KM); const bf16* P = (const bf16*)(F.ws + WS_P); const bf16* SP = (const bf16*)(F.ws + WS_SP);
    const float* GAb = (const float*)(F.ws + WS_GATES); const float* GBb = GAb + 8 * T_SEQ; const float* GCb = GBb + 8 * T_SEQ;
    float* HNUM = (float*)(F.ws + WS_HNUM); float* DEN = (float*)(F.ws + WS_DEN);
    constexpr int QRS = 528;
    constexpr int O_KS = 0, O_VS = 33792  , O_VW = 41984  , O_VS1 = 46080  , O_VW1 = 48128  , O_CT = 50176  , O_HQX = 100864  ;
    static_assert(O_HQX + 2 * 12288 <= RING_BYTES, "mLSTM v3 LDS map");
    LAS unsigned char* L = F.lds;
    const int tid = F.tid, w = F.wave, l = F.lane, quad = l >> 4, r16 = l & 15;
    const int jt = w & 3, sp_ = w >> 2, j0 = jt * 16;
    const int h = blk >> 4, c0 = (blk & 15) * 32; const int nt = (c0 == 0) ? 3 : 2;
    LDS_BARRIER();
    for (int i = tid; i < (6 * 8448) / 4; i += 512) ((LAS unsigned*)(L + O_CT))[i] = 0u;
    { const int i = tid; ((LAS unsigned*)(L + O_VS1))[i] = ((i & 7) == 0) ? 0x00003F80u : 0u; ((LAS unsigned*)(L + O_VW1))[i] = 0u; }
    f32x4 Cst[2][3];
#pragma unroll
    for (int a = 0; a < 2; ++a)
#pragma unroll
        for (int b = 0; b < 3; ++b) Cst[a][b] = (f32x4){0.f, 0.f, 0.f, 0.f};
    float m_prev = 0.f;
    const __amdgpu_buffer_rsrc_t rK = __builtin_amdgcn_make_buffer_rsrc((void*)(KM + h * 256), 0, T_SEQ * 4096, 0x00020000), rQ = __builtin_amdgcn_make_buffer_rsrc((void*)(QM + h * 256), 0, T_SEQ * 4096, 0x00020000),
                                 rV = __builtin_amdgcn_make_buffer_rsrc((void*)(P + PC_V + h * 512 + c0), 0, (int)((size_t)T_SEQ * NP * 2 - (size_t)(PC_V + h * 512 + c0) * 2), 0x00020000),
                                 rS = __builtin_amdgcn_make_buffer_rsrc((void*)(SP + (size_t)h * 128 * 4096), 0, 128 * 8192, 0x00020000),
                                 rH = __builtin_amdgcn_make_buffer_rsrc((void*)(HNUM + h * 512 + c0), 0, T_SEQ * 16384, 0x00020000), rD = __builtin_amdgcn_make_buffer_rsrc((void*)(DEN + h), 0, T_SEQ * 32, 0x00020000);
    const unsigned voffk = (unsigned)((tid >> 5) * 4096 + (tid & 31) * 16), voffv = (unsigned)((tid >> 2) * (NP * 2) + (tid & 3) * 16);
    const unsigned voffq = (unsigned)((j0 + r16) * 4096 + (sp_ * 128 + quad * 8) * 2), voffs = (unsigned)((j0 + r16) * 128 + quad * 16);
    const unsigned hoff = (unsigned)(((j0 + quad * 4) * 4096 + r16) * 4), doff = (unsigned)((j0 + quad * 4) * 32);
    const float* ga = GAb + (size_t)h * T_SEQ; const float* gb = GBb + (size_t)h * T_SEQ; const float* gc = GCb + (size_t)h * T_SEQ;
    const int vrow = (tid < 256) ? (tid >> 2) : ((tid - 256) & 63);
    v4u pk[4], pv = (v4u){0u, 0u, 0u, 0u}; bf16x8 pq[4], ps[2]; f32x4 pcm = (f32x4){0.f, 0.f, 0.f, 0.f}, pb = pcm; float pa = 0.f, pg = 0.f, pamax = 0.f;
    ps[0] = (bf16x8){0, 0, 0, 0, 0, 0, 0, 0}; ps[1] = ps[0];
#define P8V3_FETCH(T1) do { \
        _Pragma("unroll") for (int i = 0; i < 4; ++i) pk[i] = __builtin_bit_cast(v4u, __builtin_amdgcn_raw_buffer_load_b128(rK, voffk, (T1) * 4096 + i * 65536, 0)); \
        if (tid < 256) pv = __builtin_bit_cast(v4u, __builtin_amdgcn_raw_buffer_load_b128(rV, voffv, (T1) * (NP * 2), 0)); \
        _Pragma("unroll") for (int k4 = 0; k4 < 4; ++k4) pq[k4] = __builtin_bit_cast(bf16x8, __builtin_amdgcn_raw_buffer_load_b128(rQ, voffq, (T1) * 4096 + k4 * 64, 0)); \
        if (w < 4) { _Pragma("unroll") for (int kk = 0; kk < 2; ++kk) ps[kk] = __builtin_bit_cast(bf16x8, __builtin_amdgcn_raw_buffer_load_b128(rS, voffs, ((T1) >> 6) * 8192 + kk * 64, 0)); \
            pcm = *(const f32x4*)(gc + (T1) + j0 + quad * 4); pb = *(const f32x4*)(gb + (T1) + j0 + quad * 4); } \
        pa = ga[(T1) + vrow]; pg = gb[(T1) + 63]; pamax = gc[(T1) + 63]; } while (0)
    P8V3_FETCH(0);
    for (int ch = 0; ch < T_SEQ / 64; ++ch) {
        const int t0 = ch * 64, cur = ch & 1, nxt = cur ^ 1;
        const float M63 = fmaxf(m_prev, pamax), decay = __expf(m_prev - M63), wg = __expf(pa - M63);
        float rj[4], inj[4], enj[4];
#pragma unroll
        for (int i = 0; i < 4; ++i) { rj[i] = 1.f; inj[i] = 1.f; enj[i] = 1.f; }
        if (w < 4) {
#pragma unroll
            for (int i = 0; i < 4; ++i) { const float Mj = fmaxf(m_prev, pcm[i]); rj[i] = __expf(pcm[i] - Mj); inj[i] = __expf(m_prev - Mj); if (nt == 3) enj[i] = __expf(-(pb[i] + Mj)); } }
        m_prev = pg + M63;
#pragma unroll
        for (int i = 0; i < 4; ++i) { const int e = tid + 512 * i, rr = e >> 5, cc = e & 31; *(LAS v4u*)(L + O_KS + rr * QRS + cc * 16) = pk[i]; }
        if (tid < 256) { *(LAS v4u*)(L + O_VS + cur * 4096 + (tid >> 2) * 64 + (tid & 3) * 16) = pv; f32x4 x0, x1; pg8::unpack8(pv, x0, x1); *(LAS v4u*)(L + O_VW + (tid >> 2) * 64 + (tid & 3) * 16) = pg8::pack8(x0 * wg, x1 * wg); }
        else if (nt == 3 && tid < 320) *(LAS unsigned short*)(L + O_VW1 + (tid - 256) * 32) = (unsigned short)(cvt_pk_bf16(wg, 0.f) & 0xffffu);
        bf16x8 aq[4], as2[2];
#pragma unroll
        for (int k4 = 0; k4 < 4; ++k4) aq[k4] = pq[k4];
        as2[0] = ps[0]; as2[1] = ps[1];
        LDS_BARRIER();
        if (ch + 1 < T_SEQ / 64) P8V3_FETCH(t0 + 64);
        f32x4 hq[3];
        hq[0] = (f32x4){0.f, 0.f, 0.f, 0.f}; hq[1] = hq[0]; hq[2] = hq[0];
#pragma unroll
        for (int n = 0; n < 3; ++n) { if (n < nt) { bf16x8 bc[4];
#pragma unroll
            for (int k4 = 0; k4 < 4; ++k4) bc[k4] = *(const LAS bf16x8*)(L + O_CT + (cur * 3 + n) * 8448 + r16 * QRS + ((sp_ * 4 + k4) * 32 + quad * 8) * 2);
#pragma unroll
            for (int k4 = 0; k4 < 4; ++k4) hq[n] = __builtin_amdgcn_mfma_f32_16x16x32_bf16(aq[k4], bc[k4], hq[n], 0, 0, 0);
            if (sp_ == 1) *(LAS f32x4*)(L + O_HQX + cur * 12288 + ((jt * 3 + n) * 64 + l) * 16) = hq[n]; } }
        { bf16x8 ak[2][2];
#pragma unroll
          for (int dt = 0; dt < 2; ++dt)
#pragma unroll
              for (int kk = 0; kk < 2; ++kk) { const LAS unsigned char* p0 = L + O_KS + (kk * 32 + 8 * quad + (r16 >> 2)) * QRS + ((2 * w + dt) * 16 + 4 * (r16 & 3)) * 2; ak[dt][kk] = tr_pair(p0, p0 + 4 * QRS); }
#pragma unroll
          for (int n = 0; n < 3; ++n) { if (n < nt) { bf16x8 bvw[2];
#pragma unroll
              for (int kk = 0; kk < 2; ++kk) { const LAS unsigned char* p0 = (n == 2) ? (L + O_VW1 + (kk * 32 + 8 * quad + (r16 >> 2)) * 32 + (r16 & 3) * 8) : (L + O_VW + (kk * 32 + 8 * quad + (r16 >> 2)) * 64 + (n * 16 + 4 * (r16 & 3)) * 2);
                  bvw[kk] = tr_pair(p0, p0 + 4 * ((n == 2) ? 32 : 64)); }
#pragma unroll
              for (int dt = 0; dt < 2; ++dt) { const int d0 = (2 * w + dt) * 16;
                  f32x4 c = Cst[dt][n] * decay;
#pragma unroll
                  for (int kk = 0; kk < 2; ++kk) c = __builtin_amdgcn_mfma_f32_16x16x32_bf16(ak[dt][kk], bvw[kk], c, 0, 0, 0);
                  Cst[dt][n] = c;
                  v2u o; o.x = cvt_pk_bf16(c[0], c[1]); o.y = cvt_pk_bf16(c[2], c[3]);
                  *(LAS v2u*)(L + O_CT + (nxt * 3 + n) * 8448 + r16 * QRS + (d0 + quad * 4) * 2) = o; } } } }
        LDS_BARRIER();
        if (w < 4) {
#pragma unroll
            for (int n = 0; n < 3; ++n) { if (n < nt) {
                const f32x4 hx = *(const LAS f32x4*)(L + O_HQX + cur * 12288 + ((jt * 3 + n) * 64 + l) * 16);
                f32x4 x = (f32x4){0.f, 0.f, 0.f, 0.f};
#pragma unroll
                for (int kk = 0; kk < 2; ++kk) { const LAS unsigned char* p0 = (n == 2) ? (L + O_VS1 + (kk * 32 + 8 * quad + (r16 >> 2)) * 32 + (r16 & 3) * 8) : (L + O_VS + cur * 4096 + (kk * 32 + 8 * quad + (r16 >> 2)) * 64 + (n * 16 + 4 * (r16 & 3)) * 2);
                    x = __builtin_amdgcn_mfma_f32_16x16x32_bf16(as2[kk], tr_pair(p0, p0 + 4 * ((n == 2) ? 32 : 64)), x, 0, 0, 0); }
#pragma unroll
                for (int i = 0; i < 4; ++i) x[i] = x[i] * rj[i] + inj[i] * (hq[n][i] + hx[i]);
                if (n < 2) {
#pragma unroll
                    for (int i = 0; i < 4; ++i) __builtin_amdgcn_raw_buffer_store_b32(__float_as_uint(x[i]), rH, hoff, (t0 + i) * 16384 + n * 64, 0); }
                else if (r16 == 0) {
#pragma unroll
                    for (int i = 0; i < 4; ++i) __builtin_amdgcn_raw_buffer_store_b32(__float_as_uint(fmaxf(fabsf(x[i]), enj[i])), rD, doff, (t0 + i) * 32, 0); } } }
        }
    }
#undef P8V3_FETCH
    LDS_BARRIER();
}
__device__ __forceinline__ void phase8_v4(Frame& F, int blk) {
    const bf16* QM = (const bf16*)(F.ws + WS_QM); const bf16* KM = (const bf16*)(F.ws + WS_KM); const bf16* P = (const bf16*)(F.ws + WS_P); const bf16* SP = (const bf16*)(F.ws + WS_SP);
    const float* GAb = (const float*)(F.ws + WS_GATES); const float* GBb = GAb + 8 * T_SEQ; const float* GCb = GBb + 8 * T_SEQ;
    float* HNUM = (float*)(F.ws + WS_HNUM); float* DEN = (float*)(F.ws + WS_DEN);
    constexpr int QRS = 528, VRS = 144, NTM = 5;
    constexpr int O_KS = 0, O_VS = 33792  , O_VW = O_VS + 2 * 64 * VRS, O_VS1 = O_VW + 64 * VRS  , O_VW1 = O_VS1 + 2048  , O_CT = O_VW1 + 2048  , O_HQX = O_CT + NTM * 8448  ;
    static_assert(O_HQX + 4 * NTM * 1024 <= RING_BYTES, "mLSTM v4 LDS map");
    LAS unsigned char* L = F.lds;
    const int tid = F.tid, w = F.wave, l = F.lane, quad = l >> 4, r16 = l & 15;
    const int jt = w & 3, sp_ = w >> 2, j0 = jt * 16;
    const int h = blk >> 3, c0 = (blk & 7) * 64; const int nt = (c0 == 0) ? 5 : 4;
    LDS_BARRIER();
    for (int i = tid; i < (NTM * 8448) / 4; i += 512) ((LAS unsigned*)(L + O_CT))[i] = 0u;
    { const int i = tid; ((LAS unsigned*)(L + O_VS1))[i] = ((i & 7) == 0) ? 0x00003F80u : 0u; ((LAS unsigned*)(L + O_VW1))[i] = 0u; }
    f32x4 Cst[2][NTM];
#pragma unroll
    for (int a = 0; a < 2; ++a)
#pragma unroll
        for (int b = 0; b < NTM; ++b) Cst[a][b] = (f32x4){0.f, 0.f, 0.f, 0.f};
    float m_prev = 0.f;
    const __amdgpu_buffer_rsrc_t rK = __builtin_amdgcn_make_buffer_rsrc((void*)(KM + h * 256), 0, T_SEQ * 4096, 0x00020000), rQ = __builtin_amdgcn_make_buffer_rsrc((void*)(QM + h * 256), 0, T_SEQ * 4096, 0x00020000),
                                 rV = __builtin_amdgcn_make_buffer_rsrc((void*)(P + PC_V + h * 512 + c0), 0, (int)((size_t)T_SEQ * NP * 2 - (size_t)(PC_V + h * 512 + c0) * 2), 0x00020000),
                                 rS = __builtin_amdgcn_make_buffer_rsrc((void*)(SP + (size_t)h * 128 * 4096), 0, 128 * 8192, 0x00020000),
                                 rH = __builtin_amdgcn_make_buffer_rsrc((void*)(HNUM + h * 512 + c0), 0, T_SEQ * 16384, 0x00020000), rD = __builtin_amdgcn_make_buffer_rsrc((void*)(DEN + h), 0, T_SEQ * 32, 0x00020000);
    const unsigned voffk = (unsigned)((tid >> 5) * 4096 + (tid & 31) * 16), voffv = (unsigned)((tid >> 3) * (NP * 2) + (tid & 7) * 16);
    const unsigned voffq = (unsigned)((j0 + r16) * 4096 + (sp_ * 128 + quad * 8) * 2), voffs = (unsigned)((j0 + r16) * 128 + quad * 16);
    const unsigned hoff = (unsigned)(((j0 + quad * 4) * 4096 + r16) * 4), doff = (unsigned)((j0 + quad * 4) * 32);
    const float* ga = GAb + (size_t)h * T_SEQ; const float* gb = GBb + (size_t)h * T_SEQ; const float* gc = GCb + (size_t)h * T_SEQ;
    const int vrow = tid >> 3;
    const unsigned lvs = (unsigned)((tid >> 3) * VRS + (tid & 7) * 16);
    v4u pk[4], pv; bf16x8 pq[4], ps[2]; f32x4 pcm, pb; float pa = 0.f, pg = 0.f, pamax = 0.f;
#define P8V4_FETCH(T1) do { \
        _Pragma("unroll") for (int i = 0; i < 4; ++i) pk[i] = __builtin_bit_cast(v4u, __builtin_amdgcn_raw_buffer_load_b128(rK, voffk, (T1) * 4096 + i * 65536, 0)); \
        pv = __builtin_bit_cast(v4u, __builtin_amdgcn_raw_buffer_load_b128(rV, voffv, (T1) * (NP * 2), 0)); \
        _Pragma("unroll") for (int k4 = 0; k4 < 4; ++k4) pq[k4] = __builtin_bit_cast(bf16x8, __builtin_amdgcn_raw_buffer_load_b128(rQ, voffq, (T1) * 4096 + k4 * 64, 0)); \
        _Pragma("unroll") for (int kk = 0; kk < 2; ++kk) ps[kk] = __builtin_bit_cast(bf16x8, __builtin_amdgcn_raw_buffer_load_b128(rS, voffs, ((T1) >> 6) * 8192 + kk * 64, 0)); \
        pcm = *(const f32x4*)(gc + (T1) + j0 + quad * 4); pb = *(const f32x4*)(gb + (T1) + j0 + quad * 4); \
        pa = ga[(T1) + vrow]; pg = gb[(T1) + 63]; pamax = gc[(T1) + 63]; } while (0)
#define P8V4_MINE(n) (((n) == 4) ? (sp_ == 0) : (((n) >> 1) == sp_))
    P8V4_FETCH(0);
    for (int ch = 0; ch < T_SEQ / 64; ++ch) {
        const int t0 = ch * 64, cur = ch & 1;
        const float M63 = fmaxf(m_prev, pamax), decay = __expf(m_prev - M63), wg = __expf(pa - M63);
        float rj[4], inj[4], enj[4];
#pragma unroll
        for (int i = 0; i < 4; ++i) { const float Mj = fmaxf(m_prev, pcm[i]); rj[i] = __expf(pcm[i] - Mj); inj[i] = __expf(m_prev - Mj); enj[i] = (nt == 5 && sp_ == 0) ? __expf(-(pb[i] + Mj)) : 1.f; }
        m_prev = pg + M63;
#pragma unroll
        for (int i = 0; i < 4; ++i) { const int e = tid + 512 * i, rr = e >> 5, cc = e & 31; *(LAS v4u*)(L + O_KS + rr * QRS + cc * 16) = pk[i]; }
        { *(LAS v4u*)(L + O_VS + cur * (64 * VRS) + lvs) = pv; f32x4 x0, x1; pg8::unpack8(pv, x0, x1); *(LAS v4u*)(L + O_VW + lvs) = pg8::pack8(x0 * wg, x1 * wg); }
        if (nt == 5 && (tid & 7) == 0) *(LAS unsigned short*)(L + O_VW1 + (tid >> 3) * 32) = (unsigned short)(cvt_pk_bf16(wg, 0.f) & 0xffffu);
        bf16x8 aq[4], as2[2];
#pragma unroll
        for (int k4 = 0; k4 < 4; ++k4) aq[k4] = pq[k4];
        as2[0] = ps[0]; as2[1] = ps[1];
        if (ch + 1 < T_SEQ / 64) P8V4_FETCH(t0 + 64);
        LDS_BARRIER();
        f32x4 hq[NTM];
#pragma unroll
        for (int n = 0; n < NTM; ++n) hq[n] = (f32x4){0.f, 0.f, 0.f, 0.f};
#pragma unroll
        for (int n = 0; n < NTM; ++n) { if (n < nt) { bf16x8 bc[4];
#pragma unroll
            for (int k4 = 0; k4 < 4; ++k4) bc[k4] = *(const LAS bf16x8*)(L + O_CT + n * 8448 + r16 * QRS + ((sp_ * 4 + k4) * 32 + quad * 8) * 2);
#pragma unroll
            for (int k4 = 0; k4 < 4; ++k4) hq[n] = __builtin_amdgcn_mfma_f32_16x16x32_bf16(aq[k4], bc[k4], hq[n], 0, 0, 0);
            if (!P8V4_MINE(n)) *(LAS f32x4*)(L + O_HQX + ((jt * NTM + n) * 64 + l) * 16) = hq[n]; } }
        { bf16x8 ak[2][2];
#pragma unroll
          for (int dt = 0; dt < 2; ++dt)
#pragma unroll
              for (int kk = 0; kk < 2; ++kk) { const LAS unsigned char* p0 = L + O_KS + (kk * 32 + 8 * quad + (r16 >> 2)) * QRS + ((2 * w + dt) * 16 + 4 * (r16 & 3)) * 2; ak[dt][kk] = tr_pair(p0, p0 + 4 * QRS); }
#pragma unroll
          for (int n = 0; n < NTM; ++n) { if (n < nt) { bf16x8 bvw[2];
#pragma unroll
              for (int kk = 0; kk < 2; ++kk) { const LAS unsigned char* p0 = (n == 4) ? (L + O_VW1 + (kk * 32 + 8 * quad + (r16 >> 2)) * 32 + (r16 & 3) * 8) : (L + O_VW + (kk * 32 + 8 * quad + (r16 >> 2)) * VRS + (n * 16 + 4 * (r16 & 3)) * 2);
                  bvw[kk] = tr_pair(p0, p0 + 4 * ((n == 4) ? 32 : VRS)); }
#pragma unroll
              for (int dt = 0; dt < 2; ++dt) { f32x4 c = Cst[dt][n] * decay;
#pragma unroll
                  for (int kk = 0; kk < 2; ++kk) c = __builtin_amdgcn_mfma_f32_16x16x32_bf16(ak[dt][kk], bvw[kk], c, 0, 0, 0);
                  Cst[dt][n] = c; } } } }
        f32x4 xs[NTM];
#pragma unroll
        for (int n = 0; n < NTM; ++n) { xs[n] = (f32x4){0.f, 0.f, 0.f, 0.f}; if (n < nt && P8V4_MINE(n)) {
#pragma unroll
            for (int kk = 0; kk < 2; ++kk) { const LAS unsigned char* p0 = (n == 4) ? (L + O_VS1 + (kk * 32 + 8 * quad + (r16 >> 2)) * 32 + (r16 & 3) * 8) : (L + O_VS + cur * (64 * VRS) + (kk * 32 + 8 * quad + (r16 >> 2)) * VRS + (n * 16 + 4 * (r16 & 3)) * 2);
                xs[n] = __builtin_amdgcn_mfma_f32_16x16x32_bf16(as2[kk], tr_pair(p0, p0 + 4 * ((n == 4) ? 32 : VRS)), xs[n], 0, 0, 0); } } }
        LDS_BARRIER();
#pragma unroll
        for (int n = 0; n < NTM; ++n) { if (n < nt) {
#pragma unroll
            for (int dt = 0; dt < 2; ++dt) { const int d0 = (2 * w + dt) * 16; const f32x4 c = Cst[dt][n];
                v2u o; o.x = cvt_pk_bf16(c[0], c[1]); o.y = cvt_pk_bf16(c[2], c[3]);
                *(LAS v2u*)(L + O_CT + n * 8448 + r16 * QRS + (d0 + quad * 4) * 2) = o; } } }
#pragma unroll
        for (int n = 0; n < NTM; ++n) { if (n < nt && P8V4_MINE(n)) {
            const f32x4 hx = *(const LAS f32x4*)(L + O_HQX + ((jt * NTM + n) * 64 + l) * 16);
            f32x4 x = xs[n];
#pragma unroll
            for (int i = 0; i < 4; ++i) x[i] = x[i] * rj[i] + inj[i] * (hq[n][i] + hx[i]);
            if (n < 4) {
#pragma unroll
                for (int i = 0; i < 4; ++i) __builtin_amdgcn_raw_buffer_store_b32(__float_as_uint(x[i]), rH, hoff, (t0 + i) * 16384 + n * 64, 0); }
            else if (r16 == 0) {
#pragma unroll
                for (int i = 0; i < 4; ++i) __builtin_amdgcn_raw_buffer_store_b32(__float_as_uint(fmaxf(fabsf(x[i]), enj[i])), rD, doff, (t0 + i) * 32, 0); } } }
    }
#undef P8V4_FETCH
#undef P8V4_MINE
    LDS_BARRIER();
}
template <int VAR> __device__ __forceinline__ void phase5_fast(Frame& F) {
    const bf16* QA = (const bf16*)(F.ws + WS_QA); const bf16* KI = (const bf16*)(F.ws + WS_KI); const float* WI = (const float*)(F.ws + WS_WI); float* SC = (float*)(F.ws + (VAR ? WS_OLAT : WS_SC));
    constexpr int KRS = 144, KBUF = 128 * KRS;
    LAS unsigned char* L = F.lds;
    const int tid = F.tid, w = F.wave, lane = F.lane, r32 = lane & 31, hh = lane >> 5;
    const int pr0 = tid >> 3, pc0 = tid & 7;
    for (int pair = F.bid; pair < 256; pair += F.G) {
#pragma unroll 1
        for (int half = 0; half < 2; ++half) {
            const int ti = half ? (511 - pair) : pair, t0 = ti * 16;
            const int nkt = (t0 + 15) / 128 + 1;
            bf16x8 aq[2][4]; float wv[2][16];
#pragma unroll
            for (int q = 0; q < 2; ++q) { const int t = t0 + 2 * w + q;
#pragma unroll
                for (int ks = 0; ks < 4; ++ks) aq[q][ks] = *(const bf16x8*)(QA + (size_t)t * NQA + 16384 + r32 * 64 + ks * 16 + hh * 8);
#pragma unroll
                for (int i = 0; i < 16; ++i) wv[q][i] = WI[(size_t)t * 32 + (i & 3) + 8 * (i >> 2) + 4 * hh]; }
            LDS_BARRIER();
            { const v4u k0 = *(const v4u*)(KI + (size_t)pr0 * 64 + pc0 * 8), k1 = *(const v4u*)(KI + (size_t)(pr0 + 64) * 64 + pc0 * 8);
              *(LAS v4u*)(L + pr0 * KRS + pc0 * 16) = k0; *(LAS v4u*)(L + (pr0 + 64) * KRS + pc0 * 16) = k1; }
            LDS_BARRIER();
            v4u c0 = (v4u){0u, 0u, 0u, 0u}, c1 = c0;
            if (1 < nkt) { c0 = *(const v4u*)(KI + (size_t)(128 + pr0) * 64 + pc0 * 8); c1 = *(const v4u*)(KI + (size_t)(128 + pr0 + 64) * 64 + pc0 * 8); }
            for (int kt = 0; kt < nkt; ++kt) {
                const LAS unsigned char* kb_ = L + (kt & 1) * KBUF;
                v4u n0 = (v4u){0u, 0u, 0u, 0u}, n1 = n0;
                if (kt + 2 < nkt) { n0 = *(const v4u*)(KI + (size_t)((kt + 2) * 128 + pr0) * 64 + pc0 * 8); n1 = *(const v4u*)(KI + (size_t)((kt + 2) * 128 + pr0 + 64) * 64 + pc0 * 8); }
                if (kt * 128 + 127 <= t0 + 2 * w) {
#pragma unroll
                    for (int kp = 0; kp < 2; ++kp) {
                        bf16x8 bk[2][4];
#pragma unroll
                        for (int b2 = 0; b2 < 2; ++b2)
#pragma unroll
                            for (int ks = 0; ks < 4; ++ks) bk[b2][ks] = *(const LAS bf16x8*)(kb_ + ((kp * 2 + b2) * 32 + r32) * KRS + ks * 32 + hh * 16);
                        f32x16 acc[2][2];
#pragma unroll
                        for (int q = 0; q < 2; ++q)
#pragma unroll
                            for (int b2 = 0; b2 < 2; ++b2)
#pragma unroll
                                for (int i = 0; i < 16; ++i) acc[q][b2][i] = 0.f;
#pragma unroll
                        for (int ks = 0; ks < 4; ++ks)
#pragma unroll
                            for (int q = 0; q < 2; ++q)
#pragma unroll
                                for (int b2 = 0; b2 < 2; ++b2) { if (VAR == 4) {
                                    f32x4 t0 = (f32x4){acc[q][b2][0], acc[q][b2][1], acc[q][b2][2], acc[q][b2][3]}, t1 = (f32x4){acc[q][b2][4], acc[q][b2][5], acc[q][b2][6], acc[q][b2][7]};
                                    t0 = __builtin_amdgcn_mfma_f32_16x16x32_bf16(aq[q][ks], bk[b2][ks], t0, 0, 0, 0); t1 = __builtin_amdgcn_mfma_f32_16x16x32_bf16(aq[q][ks], bk[b2][ks], t1, 0, 0, 0);
                                    acc[q][b2][0] = t0[0]; acc[q][b2][1] = t0[1]; acc[q][b2][2] = t0[2]; acc[q][b2][3] = t0[3]; acc[q][b2][4] = t1[0]; acc[q][b2][5] = t1[1]; acc[q][b2][6] = t1[2]; acc[q][b2][7] = t1[3]; }
                                  else if (VAR != 2) acc[q][b2] = __builtin_amdgcn_mfma_f32_32x32x16_bf16(aq[q][ks], bk[b2][ks], acc[q][b2], 0, 0, 0); else acc[q][b2][ks] += __builtin_bit_cast(float, (int)bk[b2][ks][0]); }
#pragma unroll
                        for (int b2 = 0; b2 < 2; ++b2) { float sq[2];
#pragma unroll
                            for (int q = 0; q < 2; ++q) { float s = 0.f;
#pragma unroll
                                for (int i = 0; i < 16; ++i) { if (VAR != 1 || i == 0) s += wv[q][i] * __builtin_amdgcn_fmed3f(acc[q][b2][i], 0.f, __builtin_inff()); }
                                sq[q] = s; }
                            float a_ = sq[0], b_ = sq[1];
                            asm volatile("s_nop 1\n\tv_permlane32_swap_b32 %0, %1" : "+v"(a_), "+v"(b_));
                            const float tot = a_ + b_;
                            if (VAR != 3 || tot == 12345.f) SC[(size_t)(t0 + 2 * w + (lane >> 5)) * T_SEQ + kt * 128 + (kp * 2 + b2) * 32 + (lane & 31)] = tot; }
                    }
                } else {
#pragma unroll
                for (int kb4 = 0; kb4 < 4; ++kb4) {
                    const int key0 = kt * 128 + kb4 * 32;
                    if (key0 <= t0 + 2 * w + 1) {
                        bf16x8 bk[4];
#pragma unroll
                        for (int ks = 0; ks < 4; ++ks) bk[ks] = *(const LAS bf16x8*)(kb_ + (kb4 * 32 + r32) * KRS + ks * 32 + hh * 16);
#pragma unroll
                        for (int q = 0; q < 2; ++q) { const int t = t0 + 2 * w + q;
                            if (key0 <= t) {
                                f32x16 acc;
#pragma unroll
                                for (int i = 0; i < 16; ++i) acc[i] = 0.f;
#pragma unroll
                                for (int ks = 0; ks < 4; ++ks) acc = __builtin_amdgcn_mfma_f32_32x32x16_bf16(aq[q][ks], bk[ks], acc, 0, 0, 0);
                                float s = 0.f;
#pragma unroll
                                for (int i = 0; i < 16; ++i) s += wv[q][i] * __builtin_amdgcn_fmed3f(acc[i], 0.f, __builtin_inff());
                                s = xor32_allsum(s);
                                if (lane < 32) SC[(size_t)t * T_SEQ + key0 + lane] = s; } } } }
                }
                if (kt + 1 < nkt) { LAS unsigned char* nb = L + ((kt + 1) & 1) * KBUF; *(LAS v4u*)(nb + pr0 * KRS + pc0 * 16) = c0; *(LAS v4u*)(nb + (pr0 + 64) * KRS + pc0 * 16) = c1; }
                c0 = n0; c1 = n1;
                LDS_BARRIER();
            }
        }
    }
}
__device__ __forceinline__ float xor16_allsum(float v) {
    float a = v, b = v;
    asm volatile("s_nop 1\n\tv_permlane16_swap_b32 %0, %1" : "+v"(a), "+v"(b));
    return a + b;
}
struct IdxQ { bf16x8 a[2][2]; float w[8]; };
__device__ __forceinline__ void idx_load_q(IdxQ& q, const bf16* QA, const float* WI, int t, int quad, int r16) {
#pragma unroll
    for (int mt = 0; mt < 2; ++mt) {
#pragma unroll
        for (int ks = 0; ks < 2; ++ks) q.a[mt][ks] = *(const bf16x8*)(QA + (size_t)t * NQA + 16384 + (mt * 16 + r16) * 64 + ks * 32 + quad * 8);
        const f32x4 w4 = *(const f32x4*)(WI + (size_t)t * 32 + mt * 16 + quad * 4);
        q.w[mt * 4] = w4[0]; q.w[mt * 4 + 1] = w4[1]; q.w[mt * 4 + 2] = w4[2]; q.w[mt * 4 + 3] = w4[3]; }
}
__device__ __forceinline__ float idx_unit(const IdxQ& q, const bf16x8 (&bk)[2][2], int quad) {
    f32x4 acc[2][2];
#pragma unroll
    for (int mt = 0; mt < 2; ++mt)
#pragma unroll
        for (int n2 = 0; n2 < 2; ++n2) { acc[mt][n2] = __builtin_amdgcn_mfma_f32_16x16x32_bf16(q.a[mt][0], bk[n2][0], (f32x4){0.f, 0.f, 0.f, 0.f}, 0, 0, 0);
            acc[mt][n2] = __builtin_amdgcn_mfma_f32_16x16x32_bf16(q.a[mt][1], bk[n2][1], acc[mt][n2], 0, 0, 0); }
    float s[2];
#pragma unroll
    for (int n2 = 0; n2 < 2; ++n2) { float x = 0.f;
#pragma unroll
        for (int mt = 0; mt < 2; ++mt)
#pragma unroll
            for (int i = 0; i < 4; ++i) x += q.w[mt * 4 + i] * __builtin_amdgcn_fmed3f(acc[mt][n2][i], 0.f, __builtin_inff());
        s[n2] = x; }
    const float s0 = xor32_allsum(xor16_allsum(s[0])), s1 = xor32_allsum(xor16_allsum(s[1]));
    return (quad & 1) ? s1 : s0;
}
template <int VAR> __device__ __forceinline__ void phase5_v2(Frame& F) {
    const bf16* QA = (const bf16*)(F.ws + WS_QA); const bf16* KI = (const bf16*)(F.ws + WS_KI); const float* WI = (const float*)(F.ws + WS_WI); float* SC = (float*)(F.ws + (VAR ? WS_OLAT : WS_SC));
    constexpr int KRS = 144, KBUF = 128 * KRS;
    LAS unsigned char* L = F.lds;
    const int tid = F.tid, w = F.wave, lane = F.lane, quad = lane >> 4, r16 = lane & 15;
    const int pr0 = tid >> 3, pc0 = tid & 7;
    for (int pair = F.bid; pair < 256; pair += F.G) {
#pragma unroll 1
        for (int half = 0; half < 2; ++half) {
            const int ti = half ? (511 - pair) : pair, t0 = ti * 16;
            const int nkt = (t0 + 15) / 128 + 1;
            IdxQ q0, q1;
            idx_load_q(q0, QA, WI, t0 + 2 * w, quad, r16); idx_load_q(q1, QA, WI, t0 + 2 * w + 1, quad, r16);
            LDS_BARRIER();
            { const v4u k0 = *(const v4u*)(KI + (size_t)pr0 * 64 + pc0 * 8), k1 = *(const v4u*)(KI + (size_t)(pr0 + 64) * 64 + pc0 * 8);
              *(LAS v4u*)(L + pr0 * KRS + pc0 * 16) = k0; *(LAS v4u*)(L + (pr0 + 64) * KRS + pc0 * 16) = k1; }
            LDS_BARRIER();
            v4u c0 = (v4u){0u, 0u, 0u, 0u}, c1 = c0;
            if (1 < nkt) { c0 = *(const v4u*)(KI + (size_t)(128 + pr0) * 64 + pc0 * 8); c1 = *(const v4u*)(KI + (size_t)(128 + pr0 + 64) * 64 + pc0 * 8); }
            for (int kt = 0; kt < nkt; ++kt) {
                const LAS unsigned char* kb_ = L + (kt & 1) * KBUF;
                v4u n0 = (v4u){0u, 0u, 0u, 0u}, n1 = n0;
                if (kt + 2 < nkt) { n0 = *(const v4u*)(KI + (size_t)((kt + 2) * 128 + pr0) * 64 + pc0 * 8); n1 = *(const v4u*)(KI + (size_t)((kt + 2) * 128 + pr0 + 64) * 64 + pc0 * 8); }
                const bool full = (kt * 128 + 127 <= t0 + 2 * w);
#pragma unroll
                for (int kb4 = 0; kb4 < 4; ++kb4) {
                    const int key0 = kt * 128 + kb4 * 32;
                    if (full || key0 <= t0 + 2 * w + 1) {
                        bf16x8 bk[2][2];
#pragma unroll
                        for (int n2 = 0; n2 < 2; ++n2)
#pragma unroll
                            for (int ks = 0; ks < 2; ++ks) bk[n2][ks] = *(const LAS bf16x8*)(kb_ + (kb4 * 32 + n2 * 16 + r16) * KRS + ks * 64 + quad * 16);
                        if (full || key0 <= t0 + 2 * w) { const float s = idx_unit(q0, bk, quad); if (lane < 32) SC[(size_t)(t0 + 2 * w) * T_SEQ + key0 + lane] = s; }
                        { const float s = idx_unit(q1, bk, quad); if (lane < 32) SC[(size_t)(t0 + 2 * w + 1) * T_SEQ + key0 + lane] = s; }
                    }
                }
                if (kt + 1 < nkt) { LAS unsigned char* nb = L + ((kt + 1) & 1) * KBUF; *(LAS v4u*)(nb + pr0 * KRS + pc0 * 16) = c0; *(LAS v4u*)(nb + (pr0 + 64) * KRS + pc0 * 16) = c1; }
                c0 = n0; c1 = n1;
                LDS_BARRIER();
            }
        }
    }
}
template <int NB>
__device__ __forceinline__ unsigned p6_find_bin(const LAS unsigned* hist, unsigned& kth, unsigned& cnt, int lane) {
    unsigned hb[NB]; unsigned tot = 0u;
#pragma unroll
    for (int q = 0; q < NB / 4; ++q) { const v4u h4 = *(const LAS v4u*)(hist + lane * NB + q * 4); hb[q * 4] = h4.x; hb[q * 4 + 1] = h4.y; hb[q * 4 + 2] = h4.z; hb[q * 4 + 3] = h4.w; tot += h4.x + h4.y + h4.z + h4.w; }
    const unsigned inc_ = wave_scan_add_u32(tot);
    unsigned above = lane63_u32(inc_) - inc_;
    unsigned fbin = 0u, fk = 0u, fc = 0u; bool found = false;
#pragma unroll
    for (int b = NB - 1; b >= 0; --b) { if (!found && above < kth && kth <= above + hb[b]) { found = true; fbin = (unsigned)(lane * NB + b); fk = kth - above; fc = hb[b]; } above += hb[b]; }
    const unsigned long long fm = __ballot(found); const int src = (int)__ffsll((long long)fm) - 1;
    kth = (unsigned)__builtin_amdgcn_readlane((int)fk, src); cnt = (unsigned)__builtin_amdgcn_readlane((int)fc, src);
    return (unsigned)__builtin_amdgcn_readlane((int)fbin, src);
}
__device__ __forceinline__ void phase6a_select(Frame& F) {
    const float* SC = (const float*)(F.ws + WS_SC); int* IDX = (int*)(F.ws + WS_IDX); int* CNT = (int*)(F.ws + WS_CNT);
    LAS unsigned* hist = (LAS unsigned*)(F.lds + F.wave * 16384);
    LAS unsigned* cand = hist + 2048;
    constexpr unsigned CAP = 2048u;
    const int gw = F.bid * NWAVES + F.wave, NGW = F.G * NWAVES, lane = F.lane;
    const unsigned long long lt_mask = (1ull << lane) - 1ull;
    for (int qi = gw; qi < T_SEQ; qi += NGW) {
        const int grp = qi / NGW, jj = qi % NGW; int t;
        if (NGW * 4 == T_SEQ) t = (grp == 0) ? jj : (grp == 1) ? (T_SEQ / 2 - 1 - jj) : (grp == 2) ? (T_SEQ / 2 + jj) : (T_SEQ - 1 - jj); else t = qi;
        const int n = t + 1; int* out = IDX + (size_t)t * TOPK;
        if (lane == 0) CNT[t] = n < TOPK ? n : TOPK;
        if (n <= TOPK) {
#pragma unroll
            for (int e = 0; e < 4; ++e) { const int i = lane + 64 * e; out[i] = i < n ? i : 0; }
            continue;
        }
        const float* row = SC + (size_t)t * T_SEQ;
        unsigned kth = TOPK, cnt1 = 0u, cnt2 = 0u;
#pragma unroll
        for (int q = 0; q < 8; ++q) *(LAS v4u*)(hist + q * 256 + lane * 4) = (v4u){0u, 0u, 0u, 0u};
        f32x4 vn[4];
#pragma unroll
        for (int u = 0; u < 4; ++u) vn[u] = *(const f32x4*)(row + u * 256 + lane * 4);
        for (int base = 0; base < n; base += 1024) {
            f32x4 v[4];
#pragma unroll
            for (int u = 0; u < 4; ++u) v[u] = vn[u];
            if (base + 1024 < n) {
#pragma unroll
                for (int u = 0; u < 4; ++u) vn[u] = *(const f32x4*)(row + base + 1024 + u * 256 + lane * 4); }
#pragma unroll
            for (int u = 0; u < 4; ++u)
#pragma unroll
                for (int e = 0; e < 4; ++e) { const unsigned k = f2key(v[u][e]); if (base + u * 256 + lane * 4 + e < n) __hip_atomic_fetch_add(&hist[k >> 21], 1u, __ATOMIC_RELAXED, __HIP_MEMORY_SCOPE_WORKGROUP); }
        }
        const unsigned bin1 = p6_find_bin<32>(hist, kth, cnt1, lane);
#pragma unroll
        for (int q = 0; q < 8; ++q) *(LAS v4u*)(hist + q * 256 + lane * 4) = (v4u){0u, 0u, 0u, 0u};
        const bool fits = cnt1 <= CAP; unsigned nc = 0u;
#pragma unroll
        for (int u = 0; u < 4; ++u) vn[u] = *(const f32x4*)(row + u * 256 + lane * 4);
        for (int base = 0; base < n; base += 1024) {
            f32x4 v[4];
#pragma unroll
            for (int u = 0; u < 4; ++u) v[u] = vn[u];
            if (base + 1024 < n) {
#pragma unroll
                for (int u = 0; u < 4; ++u) vn[u] = *(const f32x4*)(row + base + 1024 + u * 256 + lane * 4); }
#pragma unroll
            for (int u = 0; u < 4; ++u)
#pragma unroll
                for (int e = 0; e < 4; ++e) { const unsigned k = f2key(v[u][e]); const bool m = (base + u * 256 + lane * 4 + e < n) && (k >> 21) == bin1;
                    if (m) __hip_atomic_fetch_add(&hist[(k >> 10) & 2047u], 1u, __ATOMIC_RELAXED, __HIP_MEMORY_SCOPE_WORKGROUP);
                    const unsigned long long mm = __ballot(m);
                    if (fits) { if (m) cand[nc + (unsigned)__popcll(mm & lt_mask)] = k; }
                    nc += (unsigned)__popcll(mm); }
        }
        const unsigned bin2 = p6_find_bin<32>(hist, kth, cnt2, lane);
        const unsigned pre22 = (bin1 << 11) | bin2;
#pragma unroll
        for (int q = 0; q < 4; ++q) *(LAS v4u*)(hist + q * 256 + lane * 4) = (v4u){0u, 0u, 0u, 0u};
        if (fits) { for (unsigned i = (unsigned)lane; i < cnt1; i += 64u) { const unsigned k = cand[i]; if ((k >> 10) == pre22) __hip_atomic_fetch_add(&hist[k & 1023u], 1u, __ATOMIC_RELAXED, __HIP_MEMORY_SCOPE_WORKGROUP); } }
        else { for (int i = lane; i < n; i += 64) { const unsigned k = f2key(row[i]); if ((k >> 10) == pre22) __hip_atomic_fetch_add(&hist[k & 1023u], 1u, __ATOMIC_RELAXED, __HIP_MEMORY_SCOPE_WORKGROUP); } }
        unsigned cnt3 = 0u;
        const unsigned bin3 = p6_find_bin<16>(hist, kth, cnt3, lane);
        const unsigned prefix = (pre22 << 10) | bin3;
        unsigned run = 0u, ties = 0u;
#pragma unroll
        for (int u = 0; u < 4; ++u) vn[u] = *(const f32x4*)(row + u * 256 + lane * 4);
        for (int base = 0; base < n; base += 1024) {
            f32x4 v[4];
#pragma unroll
            for (int u = 0; u < 4; ++u) v[u] = vn[u];
            if (base + 1024 < n) {
#pragma unroll
                for (int u = 0; u < 4; ++u) vn[u] = *(const f32x4*)(row + base + 1024 + u * 256 + lane * 4); }
#pragma unroll
            for (int u = 0; u < 4; ++u) {
                unsigned gtm = 0u, eqm = 0u;
#pragma unroll
                for (int e = 0; e < 4; ++e) { const unsigned k = f2key(v[u][e]); const bool in = base + u * 256 + lane * 4 + e < n; if (in && k > prefix) gtm |= 1u << e; if (in && k == prefix) eqm |= 1u << e; }
                const unsigned ce = (unsigned)__popc(eqm); unsigned selm = gtm;
                if (__ballot(ce != 0u)) {
                    const unsigned inc = wave_scan_add_u32(ce);
                    unsigned rk = ties + inc - ce;
#pragma unroll
                    for (int e = 0; e < 4; ++e) { if ((eqm >> e) & 1u) { if (rk < kth) selm |= 1u << e; ++rk; } }
                    ties += lane63_u32(inc);
                }
                const unsigned cs = (unsigned)__popc(selm); const unsigned inc2 = wave_scan_add_u32(cs);
                unsigned pos = run + inc2 - cs;
#pragma unroll
                for (int e = 0; e < 4; ++e) { if ((selm >> e) & 1u) { if (pos < (unsigned)TOPK) out[pos] = base + u * 256 + lane * 4 + e; ++pos; } }
                run += lane63_u32(inc2);
            }
        }
    }
}

__device__ __forceinline__ float p6_swap_max32(float v) { float a = v, b = v; asm volatile("s_nop 1\n\tv_permlane32_swap_b32 %0, %1\n\ts_nop 1" : "+v"(a), "+v"(b)); return fmaxf(a, b); }
__device__ __forceinline__ float p6_swap_max16(float v) { float a = v, b = v; asm volatile("s_nop 1\n\tv_permlane16_swap_b32 %0, %1\n\ts_nop 1" : "+v"(a), "+v"(b)); return fmaxf(a, b); }
__device__ __forceinline__ float p6_swap_sum32(float v) { float a = v, b = v; asm volatile("s_nop 1\n\tv_permlane32_swap_b32 %0, %1\n\ts_nop 1" : "+v"(a), "+v"(b)); return a + b; }
__device__ __forceinline__ float p6_swap_sum16(float v) { float a = v, b = v; asm volatile("s_nop 1\n\tv_permlane16_swap_b32 %0, %1\n\ts_nop 1" : "+v"(a), "+v"(b)); return a + b; }
__device__ __forceinline__ int p6_query_of(int qn, int G, int bid) { const int rnd = qn / G; return (rnd & 1) ? (T_SEQ - 1 - (rnd >> 1) * G - bid) : ((rnd >> 1) * G + bid); }
template <int VAR> __device__ __forceinline__ void phase6b_attn(Frame& F, int kstart, int kcount, int kstride, int extra = -1) {
    const bf16* QA = (const bf16*)(F.ws + WS_QA); const bf16* CKV = (const bf16*)(F.ws + WS_CKV); const int* IDX = (const int*)(F.ws + WS_IDX); const int* CNT = (const int*)(F.ws + WS_CNT); bf16* OLAT = (bf16*)(F.ws + (VAR ? WS_SC : WS_OLAT));
    constexpr int KRS = 1040, PRS = 144;
    constexpr int O_KV = 0, O_IDX = 66560, O_DIST = 68608, O_AL = 70656, O_LINV = 70784, O_P = 70912, O_EX = 75520, O_OT = 70912;
    LAS unsigned char* L = F.lds;
    LAS float* lal = (LAS float*)(L + O_AL); LAS float* linv = (LAS float*)(L + O_LINV);
    const int tid = F.tid, w = F.wave, l = F.lane, quad = l >> 4, r16 = l & 15, r32 = l & 31, hh = l >> 5;
    const int mt = w & 1, kq = w >> 1;
    const float slope = exp2f(-0.25f * (float)(mt * 16 + r16 + 1));
    const int ktotal = kcount + (extra >= 0 ? 1 : 0);
    if (ktotal <= 0) return;
    const __amdgpu_buffer_rsrc_t rKV = __builtin_amdgcn_make_buffer_rsrc((void*)CKV, 0, T_SEQ * 1024, 0x00020000);
    int t = T_SEQ - 1 - ((kcount > 0) ? kstart : extra); int cnt = CNT[t];
    LDS_BARRIER();
    if (tid < 256) { const int id = IDX[(size_t)t * TOPK + tid]; ((LAS int*)(L + O_IDX))[tid] = id; ((LAS float*)(L + O_DIST))[tid] = (float)(t - id); }
    bf16x8 aq[4];
#pragma unroll
    for (int ks = 0; ks < 4; ++ks) aq[ks] = *(const bf16x8*)(QA + (size_t)t * NQA + (mt * 16 + r16) * 512 + kq * 128 + ks * 32 + quad * 8);
    LDS_BARRIER();
    v4u st[8];
#pragma unroll
    for (int j = 0; j < 8; ++j) { const int id = ((LAS int*)(L + O_IDX))[w * 8 + j]; st[j] = __builtin_bit_cast(v4u, __builtin_amdgcn_raw_buffer_load_b128(rKV, (unsigned)(l * 16), __builtin_amdgcn_readfirstlane(id) * 1024, 0)); }
    int buf = 0;
    for (int qi = 0; qi < ktotal; ++qi) {
        const int nch = (cnt + 63) >> 6;
        LAS int* lidx = (LAS int*)(L + O_IDX + buf * 1024); LAS float* ldist = (LAS float*)(L + O_DIST + buf * 1024);
        LAS int* nidx = (LAS int*)(L + O_IDX + (buf ^ 1) * 1024); LAS float* ndist = (LAS float*)(L + O_DIST + (buf ^ 1) * 1024);
        const bool has_next = qi + 1 < ktotal; const int tn = has_next ? (T_SEQ - 1 - ((qi + 1 < kcount) ? (kstart + (qi + 1) * kstride) : extra)) : t;
        int cnt_n = cnt, nid = 0;
        if (has_next) { cnt_n = CNT[tn]; if (tid < 256) nid = IDX[(size_t)tn * TOPK + tid]; }
        f32x16 oacc[2];
#pragma unroll
        for (int c = 0; c < 2; ++c)
#pragma unroll
            for (int i = 0; i < 16; ++i) oacc[c][i] = 0.f;
        float m_i = -INFINITY, l_i = 0.f;
        for (int c = 0; c < nch; ++c) {
            if (VAR != 5 && VAR != 6) {
#pragma unroll
            for (int j = 0; j < 8; ++j) *(LAS v4u*)(L + O_KV + (w * 8 + j) * KRS + l * 16) = st[j]; }
            if (c == nch - 1 && has_next && tid < 256) { nidx[tid] = nid; ndist[tid] = (float)(tn - nid); }
            LDS_BARRIER();
            {
                const bool last = (c == nch - 1);
                if (VAR != 1 && (!last || has_next)) { const LAS int* srcidx = last ? nidx : (lidx + (c + 1) * 64);
#pragma unroll
                    for (int j = 0; j < 8; ++j) { const int id = srcidx[w * 8 + j]; st[j] = __builtin_bit_cast(v4u, __builtin_amdgcn_raw_buffer_load_b128(rKV, (unsigned)(l * 16), __builtin_amdgcn_readfirstlane(id) * 1024, 0)); } }
 }
            f32x4 lg[4];
#pragma unroll
            for (int nt = 0; nt < 4; ++nt) lg[nt] = (f32x4){0.f, 0.f, 0.f, 0.f};
            if (VAR != 3 && VAR != 5 && VAR != 7) {
#pragma unroll
            for (int kb2 = 0; kb2 < 2; ++kb2) { bf16x8 bk[4][2];
#pragma unroll
                for (int nt = 0; nt < 4; ++nt)
#pragma unroll
                    for (int k1 = 0; k1 < 2; ++k1) bk[nt][k1] = *(const LAS bf16x8*)(L + O_KV + (nt * 16 + r16) * KRS + (kq * 128 + (kb2 * 2 + k1) * 32 + quad * 8) * 2);
                __builtin_amdgcn_sched_barrier(0);
#pragma unroll
                for (int k1 = 0; k1 < 2; ++k1)
#pragma unroll
                    for (int nt = 0; nt < 4; ++nt) lg[nt] = __builtin_amdgcn_mfma_f32_16x16x32_bf16(bk[nt][k1], aq[kb2 * 2 + k1], lg[nt], 0, 0, 0);
                __builtin_amdgcn_sched_barrier(0); }
            if (kq > 0) {
#pragma unroll
                for (int nt = 0; nt < 4; ++nt) *(LAS f32x4*)(L + O_EX + ((((kq - 1) * 2 + mt) * 4 + nt) * 64 + l) * 16) = lg[nt]; }
            }
            LDS_BARRIER();
            if (c == nch - 1 && has_next) {
#pragma unroll
                for (int ks = 0; ks < 4; ++ks) aq[ks] = *(const bf16x8*)(QA + (size_t)tn * NQA + (mt * 16 + r16) * 512 + kq * 128 + ks * 32 + quad * 8); }
            if (VAR != 2 && VAR != 5 && w < 2) {
                float pmax = -INFINITY;
#pragma unroll
                for (int nh = 0; nh < 2; ++nh) { f32x4 ex[2][3]; f32x4 d4[2];
#pragma unroll
                    for (int n2 = 0; n2 < 2; ++n2) {
#pragma unroll
                        for (int k2 = 0; k2 < 3; ++k2) ex[n2][k2] = *(const LAS f32x4*)(L + O_EX + (((k2 * 2 + mt) * 4 + nh * 2 + n2) * 64 + l) * 16);
                        d4[n2] = *(const LAS f32x4*)(ldist + c * 64 + (nh * 2 + n2) * 16 + quad * 4); }
                    __builtin_amdgcn_sched_barrier(0);
#pragma unroll
                    for (int n2 = 0; n2 < 2; ++n2) { const int nt = nh * 2 + n2;
                        lg[nt] += ex[n2][0] + ex[n2][1] + ex[n2][2];
                        const int slot0 = c * 64 + nt * 16 + quad * 4;
#pragma unroll
                        for (int i = 0; i < 4; ++i) {
                            const float v = (slot0 + i < cnt) ? (lg[nt][i] * 0.08838834764831845f - slope * d4[n2][i]) : -INFINITY; lg[nt][i] = v; pmax = fmaxf(pmax, v); } }
                    __builtin_amdgcn_sched_barrier(0); }
                pmax = p6_swap_max32(p6_swap_max16(pmax));
                const float mn = fmaxf(m_i, pmax), alpha = __expf(m_i - mn); m_i = mn;
                float rs = 0.f;
#pragma unroll
                for (int nt = 0; nt < 4; ++nt) { float pe[4];
#pragma unroll
                    for (int i = 0; i < 4; ++i) pe[i] = __expf(lg[nt][i] - mn);
                    v2u pw; pw.x = cvt_pk_bf16(pe[0], pe[1]); pw.y = cvt_pk_bf16(pe[2], pe[3]);
                    rs += (bf_lo(pw.x) + bf_hi(pw.x)) + (bf_lo(pw.y) + bf_hi(pw.y));
                    *(LAS v2u*)(L + O_P + (mt * 16 + r16) * PRS + (nt * 16 + quad * 4) * 2) = pw; }
                rs = p6_swap_sum32(p6_swap_sum16(rs));
                l_i = l_i * alpha + rs;
                if (quad == 0) { lal[mt * 16 + r16] = alpha; if (c == nch - 1) linv[mt * 16 + r16] = __builtin_amdgcn_rcpf(l_i); }
            }
            LDS_BARRIER();
            { float al[16];
#pragma unroll
              for (int g = 0; g < 4; ++g) { const f32x4 a4 = *(const LAS f32x4*)(lal + 8 * g + 4 * hh); al[4 * g] = a4[0]; al[4 * g + 1] = a4[1]; al[4 * g + 2] = a4[2]; al[4 * g + 3] = a4[3]; }
#pragma unroll
              for (int cc = 0; cc < 2; ++cc)
#pragma unroll
                  for (int i = 0; i < 16; ++i) oacc[cc][i] *= al[i]; }
            if (VAR != 4 && VAR != 5 && VAR != 7) {
#pragma unroll
            for (int kb2 = 0; kb2 < 2; ++kb2) { bf16x8 ap[2], bv[2][2];
#pragma unroll
                for (int k1 = 0; k1 < 2; ++k1) { const int ks = kb2 * 2 + k1; ap[k1] = *(const LAS bf16x8*)(L + O_P + r32 * PRS + (ks * 16 + hh * 8) * 2);
#pragma unroll
                    for (int cc = 0; cc < 2; ++cc) { const LAS unsigned char* p0 = L + O_KV + (ks * 16 + 8 * hh + ((l & 15) >> 2)) * KRS + (w * 64 + cc * 32 + 16 * ((l >> 4) & 1) + 4 * (l & 3)) * 2; bv[k1][cc] = tr_pair(p0, p0 + 4 * KRS); } }
                __builtin_amdgcn_sched_barrier(0);
#pragma unroll
                for (int k1 = 0; k1 < 2; ++k1)
#pragma unroll
                    for (int cc = 0; cc < 2; ++cc) oacc[cc] = __builtin_amdgcn_mfma_f32_32x32x16_bf16(ap[k1], bv[k1][cc], oacc[cc], 0, 0, 0);
                __builtin_amdgcn_sched_barrier(0); }
            }
            LDS_BARRIER();
        }
        { float li[16];
#pragma unroll
          for (int g = 0; g < 4; ++g) { const f32x4 a4 = *(const LAS f32x4*)(linv + 8 * g + 4 * hh); li[4 * g] = a4[0]; li[4 * g + 1] = a4[1]; li[4 * g + 2] = a4[2]; li[4 * g + 3] = a4[3]; }
#pragma unroll
          for (int cc = 0; cc < 2; ++cc)
#pragma unroll
              for (int i = 0; i < 16; ++i) { const int head = (i & 3) + 8 * (i >> 2) + 4 * hh;
                  *(LAS unsigned short*)(L + O_OT + head * KRS + (w * 64 + cc * 32 + r32) * 2) = (unsigned short)(cvt_pk_bf16(oacc[cc][i] * li[i], 0.f) & 0xffffu); } }
        LDS_BARRIER();
#pragma unroll
        for (int i = 0; i < 4; ++i) { const int pc = tid + 512 * i, head = pc >> 6, ch16 = pc & 63;
            *(v4u*)(OLAT + (size_t)t * 16384 + head * 512 + ch16 * 8) = *(const LAS v4u*)(L + O_OT + head * KRS + ch16 * 16); }
        t = tn; cnt = cnt_n; buf ^= 1;
    }
}
template <int VAR> __device__ __forceinline__ void phase6c_attn(Frame& F, int kstart, int kcount, int kstride) {
    const bf16* QA = (const bf16*)(F.ws + WS_QA); const bf16* CKV = (const bf16*)(F.ws + WS_CKV); const int* IDX = (const int*)(F.ws + WS_IDX); const int* CNT = (const int*)(F.ws + WS_CNT); bf16* OLAT = (bf16*)(F.ws + (VAR ? WS_SC : WS_OLAT));
    constexpr int KRS = 1040, PRS = 144;
    constexpr int O_KV = 0, O_IDX = 66560, O_DIST = 68608, O_AL = 70656, O_MX = 70784  , O_LP = 71296  , O_P = 71808, O_OT = 71808;
    LAS unsigned char* L = F.lds;
    LAS float* lal = (LAS float*)(L + O_AL); LAS float* lmx = (LAS float*)(L + O_MX); LAS float* llp = (LAS float*)(L + O_LP);
    const int tid = F.tid, w = F.wave, l = F.lane, quad = l >> 4, r16 = l & 15, r32 = l & 31, hh = l >> 5;
    const int mt = w & 1, nq = w >> 1;
    float slope4[4];
#pragma unroll
    for (int i = 0; i < 4; ++i) slope4[i] = exp2f(-0.25f * (float)(mt * 16 + quad * 4 + i + 1));
    if (kcount <= 0) return;
    const __amdgpu_buffer_rsrc_t rKV = __builtin_amdgcn_make_buffer_rsrc((void*)CKV, 0, T_SEQ * 1024, 0x00020000);
    int t = T_SEQ - 1 - kstart; int cnt = CNT[t];
    LDS_BARRIER();
    if (tid < 256) { const int id = IDX[(size_t)t * TOPK + tid]; ((LAS int*)(L + O_IDX))[tid] = id; ((LAS float*)(L + O_DIST))[tid] = (float)(t - id); }
    bf16x8 aq[16];
#pragma unroll
    for (int ks = 0; ks < 16; ++ks) aq[ks] = *(const bf16x8*)(QA + (size_t)t * NQA + (mt * 16 + r16) * 512 + ks * 32 + quad * 8);
    LDS_BARRIER();
    v4u st[8];
#pragma unroll
    for (int j = 0; j < 8; ++j) { const int id = ((LAS int*)(L + O_IDX))[w * 8 + j]; st[j] = __builtin_bit_cast(v4u, __builtin_amdgcn_raw_buffer_load_b128(rKV, (unsigned)(l * 16), __builtin_amdgcn_readfirstlane(id) * 1024, 0)); }
    int buf = 0;
    for (int qi = 0; qi < kcount; ++qi) {
        const int nch = (cnt + 63) >> 6;
        LAS int* lidx = (LAS int*)(L + O_IDX + buf * 1024); LAS float* ldist = (LAS float*)(L + O_DIST + buf * 1024);
        LAS int* nidx = (LAS int*)(L + O_IDX + (buf ^ 1) * 1024); LAS float* ndist = (LAS float*)(L + O_DIST + (buf ^ 1) * 1024);
        const bool has_next = qi + 1 < kcount; const int tn = has_next ? (T_SEQ - 1 - (kstart + (qi + 1) * kstride)) : t;
        int cnt_n = cnt, nid = 0;
        if (has_next) { cnt_n = CNT[tn]; if (tid < 256) nid = IDX[(size_t)tn * TOPK + tid]; }
        f32x16 oacc[2];
#pragma unroll
        for (int c = 0; c < 2; ++c)
#pragma unroll
            for (int i = 0; i < 16; ++i) oacc[c][i] = 0.f;
        float m_i[4] = {-INFINITY, -INFINITY, -INFINITY, -INFINITY}, l_i[4] = {0.f, 0.f, 0.f, 0.f};
        for (int c = 0; c < nch; ++c) {
            if (VAR != 5 && VAR != 6) {
#pragma unroll
            for (int j = 0; j < 8; ++j) *(LAS v4u*)(L + O_KV + (w * 8 + j) * KRS + l * 16) = st[j]; }
            if (c == nch - 1 && has_next && tid < 256) { nidx[tid] = nid; ndist[tid] = (float)(tn - nid); }
            LDS_BARRIER();
            f32x4 lg = (f32x4){0.f, 0.f, 0.f, 0.f};
            { f32x4 lg2 = lg;
#pragma unroll
              for (int kb = 0; kb < 2; ++kb) { bf16x8 bk[8];
#pragma unroll
                  for (int k1 = 0; k1 < 8; ++k1) bk[k1] = *(const LAS bf16x8*)(L + O_KV + (nq * 16 + r16) * KRS + ((kb * 8 + k1) * 32 + quad * 8) * 2);
                  __builtin_amdgcn_sched_barrier(0);
#pragma unroll
                  for (int k1 = 0; k1 < 8; k1 += 2) { lg = __builtin_amdgcn_mfma_f32_16x16x32_bf16(aq[kb * 8 + k1], bk[k1], lg, 0, 0, 0); lg2 = __builtin_amdgcn_mfma_f32_16x16x32_bf16(aq[kb * 8 + k1 + 1], bk[k1 + 1], lg2, 0, 0, 0); }
                  __builtin_amdgcn_sched_barrier(0); }
              lg += lg2; }
            { const int slot = c * 64 + nq * 16 + r16; const float dist = ldist[slot]; const bool valid = slot < cnt;
#pragma unroll
              for (int i = 0; i < 4; ++i) { const float v = valid ? (lg[i] * 0.08838834764831845f - slope4[i] * dist) : -INFINITY; lg[i] = v;
                  float mx = v; mx = fmaxf(mx, __shfl_xor(mx, 1)); mx = fmaxf(mx, __shfl_xor(mx, 2)); mx = fmaxf(mx, __shfl_xor(mx, 4)); mx = fmaxf(mx, __shfl_xor(mx, 8));
                  if (r16 == 0) lmx[nq * 32 + mt * 16 + quad * 4 + i] = mx; } }
            LDS_BARRIER();
            {
                const bool last = (c == nch - 1);
                if (VAR != 1 && (!last || has_next)) { const LAS int* srcidx = last ? nidx : (lidx + (c + 1) * 64);
#pragma unroll
                    for (int j = 0; j < 8; ++j) { const int id = srcidx[w * 8 + j]; st[j] = __builtin_bit_cast(v4u, __builtin_amdgcn_raw_buffer_load_b128(rKV, (unsigned)(l * 16), __builtin_amdgcn_readfirstlane(id) * 1024, 0)); } }
                if (last && has_next) {
#pragma unroll
                    for (int ks = 0; ks < 16; ++ks) aq[ks] = *(const bf16x8*)(QA + (size_t)tn * NQA + (mt * 16 + r16) * 512 + ks * 32 + quad * 8); } }
            {
                const f32x4 m0 = *(const LAS f32x4*)(lmx + 0 * 32 + mt * 16 + quad * 4), m1 = *(const LAS f32x4*)(lmx + 1 * 32 + mt * 16 + quad * 4), m2 = *(const LAS f32x4*)(lmx + 2 * 32 + mt * 16 + quad * 4), m3 = *(const LAS f32x4*)(lmx + 3 * 32 + mt * 16 + quad * 4);
#pragma unroll
                for (int i = 0; i < 4; ++i) { const float cm = fmaxf(fmaxf(m0[i], m1[i]), fmaxf(m2[i], m3[i]));
                    const float mn = fmaxf(m_i[i], cm); const float alpha = __expf(m_i[i] - mn); m_i[i] = mn;
                    const float p = __expf(lg[i] - mn); const unsigned pb = cvt_pk_bf16(p, 0.f) & 0xffffu;
                    *(LAS unsigned short*)(L + O_P + (mt * 16 + quad * 4 + i) * PRS + (nq * 16 + r16) * 2) = (unsigned short)pb;
                    float s = bf_lo(pb); s += __shfl_xor(s, 1); s += __shfl_xor(s, 2); s += __shfl_xor(s, 4); s += __shfl_xor(s, 8);
                    l_i[i] = l_i[i] * alpha + s;
                    if (r16 == 0) { if (nq == 0) lal[mt * 16 + quad * 4 + i] = alpha; if (c == nch - 1) llp[nq * 32 + mt * 16 + quad * 4 + i] = l_i[i]; } }
            }
            LDS_BARRIER();
            { float al[16];
#pragma unroll
              for (int g = 0; g < 4; ++g) { const f32x4 a4 = *(const LAS f32x4*)(lal + 8 * g + 4 * hh); al[4 * g] = a4[0]; al[4 * g + 1] = a4[1]; al[4 * g + 2] = a4[2]; al[4 * g + 3] = a4[3]; }
#pragma unroll
              for (int cc = 0; cc < 2; ++cc)
#pragma unroll
                  for (int i = 0; i < 16; ++i) oacc[cc][i] *= al[i]; }
            if (VAR != 4 && VAR != 5 && VAR != 7) {
#pragma unroll
            for (int kb2 = 0; kb2 < 2; ++kb2) { bf16x8 ap[2], bv[2][2];
#pragma unroll
                for (int k1 = 0; k1 < 2; ++k1) { const int ks = kb2 * 2 + k1; ap[k1] = *(const LAS bf16x8*)(L + O_P + r32 * PRS + (ks * 16 + hh * 8) * 2);
#pragma unroll
                    for (int cc = 0; cc < 2; ++cc) { const LAS unsigned char* p0 = L + O_KV + (ks * 16 + 8 * hh + ((l & 15) >> 2)) * KRS + (w * 64 + cc * 32 + 16 * ((l >> 4) & 1) + 4 * (l & 3)) * 2; bv[k1][cc] = tr_pair(p0, p0 + 4 * KRS); } }
                __builtin_amdgcn_sched_barrier(0);
#pragma unroll
                for (int k1 = 0; k1 < 2; ++k1)
#pragma unroll
                    for (int cc = 0; cc < 2; ++cc) oacc[cc] = __builtin_amdgcn_mfma_f32_32x32x16_bf16(ap[k1], bv[k1][cc], oacc[cc], 0, 0, 0);
                __builtin_amdgcn_sched_barrier(0); }
            }
            LDS_BARRIER();
        }
        { float li[16];
#pragma unroll
          for (int g = 0; g < 4; ++g) { const f32x4 a4 = *(const LAS f32x4*)(llp + 8 * g + 4 * hh) + *(const LAS f32x4*)(llp + 32 + 8 * g + 4 * hh) + *(const LAS f32x4*)(llp + 64 + 8 * g + 4 * hh) + *(const LAS f32x4*)(llp + 96 + 8 * g + 4 * hh);
              li[4 * g] = __builtin_amdgcn_rcpf(a4[0]); li[4 * g + 1] = __builtin_amdgcn_rcpf(a4[1]); li[4 * g + 2] = __builtin_amdgcn_rcpf(a4[2]); li[4 * g + 3] = __builtin_amdgcn_rcpf(a4[3]); }
#pragma unroll
          for (int cc = 0; cc < 2; ++cc)
#pragma unroll
              for (int i = 0; i < 16; ++i) { const int head = (i & 3) + 8 * (i >> 2) + 4 * hh;
                  *(LAS unsigned short*)(L + O_OT + head * KRS + (w * 64 + cc * 32 + r32) * 2) = (unsigned short)(cvt_pk_bf16(oacc[cc][i] * li[i], 0.f) & 0xffffu); } }
        LDS_BARRIER();
#pragma unroll
        for (int i = 0; i < 4; ++i) { const int pc = tid + 512 * i, head = pc >> 6, ch16 = pc & 63;
            *(v4u*)(OLAT + (size_t)t * 16384 + head * 512 + ch16 * 8) = *(const LAS v4u*)(L + O_OT + head * KRS + ch16 * 16); }
        t = tn; cnt = cnt_n; buf ^= 1;
    }
}
__device__ __forceinline__ void phase6d_attn(Frame& F, int kstart, int kcount, int kstride) {
    const bf16* QA = (const bf16*)(F.ws + WS_QA); const bf16* CKV = (const bf16*)(F.ws + WS_CKV); const int* IDX = (const int*)(F.ws + WS_IDX); const int* CNT = (const int*)(F.ws + WS_CNT); bf16* OLAT = (bf16*)(F.ws + WS_OLAT);
    constexpr int KRS = 1040, PRS = 80;
    constexpr int G_KV = 0, G_IDX = 33280  , G_DIST = 35328  , G_AL = 37376, G_LINV = 37504, G_P = 37632  , G_EX = 40192  , GSZ = 44288;
    static_assert(2 * GSZ <= RING_BYTES, "attention LDS map");
    const int tid = F.tid, w = F.wave, l = F.lane, quad = l >> 4, r16 = l & 15, r32 = l & 31, hh = l >> 5;
    const int g = w >> 2, wl = w & 3, mt = wl & 1, kh = wl >> 1, gt = tid & 255;
    LAS unsigned char* L = F.lds + g * GSZ;
    LAS float* lal = (LAS float*)(L + G_AL); LAS float* linv = (LAS float*)(L + G_LINV);
    float slope4[4];
#pragma unroll
    for (int i = 0; i < 4; ++i) slope4[i] = exp2f(-0.25f * (float)(mt * 16 + quad * 4 + i + 1));
    if (kcount <= 0) return;
    const __amdgpu_buffer_rsrc_t rKV = __builtin_amdgcn_make_buffer_rsrc((void*)CKV, 0, T_SEQ * 1024, 0x00020000);
    const int npair = (kcount + 1) >> 1;
#define P6D_TICKET(p) (kstart + (((2 * (p) + g) < kcount) ? (2 * (p) + g) : (kcount - 1)) * kstride)
    int t = T_SEQ - 1 - P6D_TICKET(0);
    int cntA = CNT[T_SEQ - 1 - (kstart)], cntB = CNT[T_SEQ - 1 - (kstart + ((1 < kcount) ? 1 : 0) * kstride)];
    int cnt = g ? cntB : cntA;
    LDS_BARRIER();
    { const int id = IDX[(size_t)t * TOPK + gt]; ((LAS int*)(L + G_IDX))[gt] = id; ((LAS float*)(L + G_DIST))[gt] = (float)(t - id); }
    bf16x8 aq[8];
#pragma unroll
    for (int ks = 0; ks < 8; ++ks) aq[ks] = *(const bf16x8*)(QA + (size_t)t * NQA + (mt * 16 + r16) * 512 + kh * 256 + ks * 32 + quad * 8);
    LDS_BARRIER();
    v4u st[8];
#pragma unroll
    for (int j = 0; j < 8; ++j) { const int id = ((LAS int*)(L + G_IDX))[wl * 8 + j]; st[j] = __builtin_bit_cast(v4u, __builtin_amdgcn_raw_buffer_load_b128(rKV, (unsigned)(l * 16), __builtin_amdgcn_readfirstlane(id) * 1024, 0)); }
    int buf = 0;
    for (int p = 0; p < npair; ++p) {
        const int nch = (((cntA > cntB) ? cntA : cntB) + 31) >> 5;
        LAS int* lidx = (LAS int*)(L + G_IDX + buf * 1024); LAS float* ldist = (LAS float*)(L + G_DIST + buf * 1024);
        LAS int* nidx = (LAS int*)(L + G_IDX + (buf ^ 1) * 1024); LAS float* ndist = (LAS float*)(L + G_DIST + (buf ^ 1) * 1024);
        const bool has_next = p + 1 < npair; const int tn = has_next ? (T_SEQ - 1 - P6D_TICKET(p + 1)) : t;
        int cntA_n = cntA, cntB_n = cntB, nid = 0;
        if (has_next) { const int ka = kstart + (2 * (p + 1)) * kstride, kb = kstart + (((2 * (p + 1) + 1) < kcount) ? (2 * (p + 1) + 1) : (kcount - 1)) * kstride;
            cntA_n = CNT[T_SEQ - 1 - ka]; cntB_n = CNT[T_SEQ - 1 - kb]; nid = IDX[(size_t)tn * TOPK + gt]; }
        f32x16 oacc[4];
#pragma unroll
        for (int c = 0; c < 4; ++c)
#pragma unroll
            for (int i = 0; i < 16; ++i) oacc[c][i] = 0.f;
        float m_i[4] = {-INFINITY, -INFINITY, -INFINITY, -INFINITY}, l_i[4] = {0.f, 0.f, 0.f, 0.f};
        for (int c = 0; c < nch; ++c) {
#pragma unroll
            for (int j = 0; j < 8; ++j) *(LAS v4u*)(L + G_KV + (wl * 8 + j) * KRS + l * 16) = st[j];
            if (c == nch - 1 && has_next) { nidx[gt] = nid; ndist[gt] = (float)(tn - nid); }
            LDS_BARRIER();
            f32x4 lg[2];
            lg[0] = (f32x4){0.f, 0.f, 0.f, 0.f}; lg[1] = lg[0];
#pragma unroll
            for (int kb2 = 0; kb2 < 2; ++kb2) { bf16x8 bk[2][4];
#pragma unroll
                for (int nt = 0; nt < 2; ++nt)
#pragma unroll
                    for (int k1 = 0; k1 < 4; ++k1) bk[nt][k1] = *(const LAS bf16x8*)(L + G_KV + (nt * 16 + r16) * KRS + (kh * 256 + (kb2 * 4 + k1) * 32 + quad * 8) * 2);
                __builtin_amdgcn_sched_barrier(0);
#pragma unroll
                for (int k1 = 0; k1 < 4; ++k1)
#pragma unroll
                    for (int nt = 0; nt < 2; ++nt) lg[nt] = __builtin_amdgcn_mfma_f32_16x16x32_bf16(aq[kb2 * 4 + k1], bk[nt][k1], lg[nt], 0, 0, 0);
                __builtin_amdgcn_sched_barrier(0); }
            if (kh == 1) {
#pragma unroll
                for (int nt = 0; nt < 2; ++nt) *(LAS f32x4*)(L + G_EX + ((mt * 2 + nt) * 64 + l) * 16) = lg[nt]; }
            LDS_BARRIER();
            {
                const bool last = (c == nch - 1);
                if (!last || has_next) { const LAS int* srcidx = last ? nidx : (lidx + (c + 1) * 32);
#pragma unroll
                    for (int j = 0; j < 8; ++j) { const int id = srcidx[wl * 8 + j]; st[j] = __builtin_bit_cast(v4u, __builtin_amdgcn_raw_buffer_load_b128(rKV, (unsigned)(l * 16), __builtin_amdgcn_readfirstlane(id) * 1024, 0)); } }
                if (last && has_next) {
#pragma unroll
                    for (int ks = 0; ks < 8; ++ks) aq[ks] = *(const bf16x8*)(QA + (size_t)tn * NQA + (mt * 16 + r16) * 512 + kh * 256 + ks * 32 + quad * 8); } }
            if (kh == 0) {
                float pmax[4] = {-INFINITY, -INFINITY, -INFINITY, -INFINITY};
#pragma unroll
                for (int nt = 0; nt < 2; ++nt) {
                    lg[nt] += *(const LAS f32x4*)(L + G_EX + ((mt * 2 + nt) * 64 + l) * 16);
                    const int slot = c * 32 + nt * 16 + r16; const float dist = ldist[slot]; const bool valid = slot < cnt;
#pragma unroll
                    for (int i = 0; i < 4; ++i) { const float v = valid ? (lg[nt][i] * 0.08838834764831845f - slope4[i] * dist) : -INFINITY; lg[nt][i] = v; pmax[i] = fmaxf(pmax[i], v); } }
                float alpha[4], rs[4];
#pragma unroll
                for (int i = 0; i < 4; ++i) { const float mx = row16_allmax(pmax[i]);
                    const float mn = fmaxf(m_i[i], mx); alpha[i] = (mn == -INFINITY) ? 1.0f : __expf(m_i[i] - mn); m_i[i] = mn; rs[i] = 0.f; }
#pragma unroll
                for (int nt = 0; nt < 2; ++nt)
#pragma unroll
                    for (int i = 0; i < 4; ++i) { const float pv_ = (m_i[i] == -INFINITY) ? 0.f : __expf(lg[nt][i] - m_i[i]); const unsigned pb = cvt_pk_bf16(pv_, 0.f) & 0xffffu; rs[i] += bf_lo(pb);
                        *(LAS unsigned short*)(L + G_P + (mt * 16 + quad * 4 + i) * PRS + (nt * 16 + r16) * 2) = (unsigned short)pb; }
#pragma unroll
                for (int i = 0; i < 4; ++i) { const float s = row16_allsum(rs[i]);
                    l_i[i] = l_i[i] * alpha[i] + s;
                    if (r16 == 0) { lal[mt * 16 + quad * 4 + i] = alpha[i]; if (c == nch - 1) linv[mt * 16 + quad * 4 + i] = __builtin_amdgcn_rcpf(l_i[i]); } }
            }
            LDS_BARRIER();
            { float al[16];
#pragma unroll
              for (int q4 = 0; q4 < 4; ++q4) { const f32x4 a4 = *(const LAS f32x4*)(lal + 8 * q4 + 4 * hh); al[4 * q4] = a4[0]; al[4 * q4 + 1] = a4[1]; al[4 * q4 + 2] = a4[2]; al[4 * q4 + 3] = a4[3]; }
#pragma unroll
              for (int cc = 0; cc < 4; ++cc)
#pragma unroll
                  for (int i = 0; i < 16; ++i) oacc[cc][i] *= al[i]; }
#pragma unroll
            for (int ks = 0; ks < 2; ++ks) { bf16x8 bv[4];
                const bf16x8 ap = *(const LAS bf16x8*)(L + G_P + r32 * PRS + (ks * 16 + hh * 8) * 2);
#pragma unroll
                for (int cc = 0; cc < 4; ++cc) { const LAS unsigned char* p0 = L + G_KV + (ks * 16 + 8 * hh + ((l & 15) >> 2)) * KRS + (wl * 128 + cc * 32 + 16 * ((l >> 4) & 1) + 4 * (l & 3)) * 2; bv[cc] = tr_pair(p0, p0 + 4 * KRS); }
                __builtin_amdgcn_sched_barrier(0);
#pragma unroll
                for (int cc = 0; cc < 4; ++cc) oacc[cc] = __builtin_amdgcn_mfma_f32_32x32x16_bf16(ap, bv[cc], oacc[cc], 0, 0, 0);
                __builtin_amdgcn_sched_barrier(0); }
            LDS_BARRIER();
        }
        { float li[16];
#pragma unroll
          for (int q4 = 0; q4 < 4; ++q4) { const f32x4 a4 = *(const LAS f32x4*)(linv + 8 * q4 + 4 * hh); li[4 * q4] = a4[0]; li[4 * q4 + 1] = a4[1]; li[4 * q4 + 2] = a4[2]; li[4 * q4 + 3] = a4[3]; }
#pragma unroll
          for (int cc = 0; cc < 4; ++cc)
#pragma unroll
              for (int i = 0; i < 16; ++i) { const int head = (i & 3) + 8 * (i >> 2) + 4 * hh;
                  *(LAS unsigned short*)(L + G_KV + head * KRS + (wl * 128 + cc * 32 + r32) * 2) = (unsigned short)(cvt_pk_bf16(oacc[cc][i] * li[i], 0.f) & 0xffffu); } }
        LDS_BARRIER();
#pragma unroll
        for (int i = 0; i < 8; ++i) { const int pc = gt + 256 * i, head = pc >> 6, ch16 = pc & 63;
            *(v4u*)(OLAT + (size_t)t * 16384 + head * 512 + ch16 * 8) = *(const LAS v4u*)(L + G_KV + head * KRS + ch16 * 16); }
        LDS_BARRIER();
        t = tn; cntA = cntA_n; cntB = cntB_n; cnt = g ? cntB : cntA; buf ^= 1;
    }
#undef P6D_TICKET
}
constexpr int N_PHASES = 14;
constexpr int CW_BAR = 4096;
__global__ void __launch_bounds__(NWAVES * 64, 2) hybrid_fwd(Args args) {
    extern __shared__ __attribute__((aligned(16))) unsigned char lds[];
    Frame F;
    F.lds = (LAS unsigned char*)lds;
    F.tid = threadIdx.x; F.lane = F.tid & 63; F.wave = __builtin_amdgcn_readfirstlane(F.tid >> 6);
    F.G = gridDim.x; F.bid = blockIdx.x;
    F.p_I_X = args.in[0]; F.p_I_C = args.in[1]; F.p_I_WADA = args.in[2]; F.p_I_BADA = args.in[3]; F.p_I_WIN = args.in[4]; F.p_I_BIN = args.in[5]; F.p_I_GQ = args.in[6]; F.p_I_GKV = args.in[7]; F.p_I_WUQ = args.in[8]; F.p_I_WIQ = args.in[9]; F.p_I_WUK = args.in[10]; F.p_I_WUV = args.in[11]; F.p_I_GKIDX = args.in[12]; F.p_I_BKIDX = args.in[13]; F.p_I_CONVW = args.in[14]; F.p_I_CONVB = args.in[15]; F.p_I_GMH = args.in[16]; F.p_I_WAO = args.in[17]; F.p_I_WMO = args.in[18]; F.p_I_WOUT = args.in[19]; F.p_I_LNG = args.in[20]; F.p_I_LNB = args.in[21];
    F.out = args.out; F.ws = args.ws;
    volatile LAS unsigned* MISCW = (volatile LAS unsigned*)(F.lds + MISC_OFF);
    for (int u = F.tid; u < (LDS_BYTES - LDSCTL_OFF) / 4; u += NWAVES * 64) ((LAS unsigned*)(F.lds + LDSCTL_OFF))[u] = 0u;
    __syncthreads();
    const int lo = args.ph_lo, hi = args.ph_hi;
    XcdBarrier bar; bar.bar = (unsigned*)(args.ws + WS_CTL) + CW_BAR + args.li * XCD_BAR_WORDS; bar.x = 0; bar.st = nullptr;
    if (hi - lo > 1) bar = xcd_barrier_post((unsigned*)(args.ws + WS_CTL) + CW_BAR + args.li * XCD_BAR_WORDS, MISCW + 8);
#ifndef PROBE_DUP_MASK
#define PROBE_DUP_MASK 0
#endif
#define DUP(k) ((PROBE_DUP_MASK >> (k)) & 1)
#ifndef PROBE_VAR
#define PROBE_VAR 0
#endif
#ifndef MK_ATT_NB
#define MK_ATT_NB 41
#endif
#ifndef MK_ATT_S0
#define MK_ATT_S0 4
#endif
#define IN(k) (lo <= (k) && (k) < hi)
#define FRESH() do { int t_ = threadIdx.x; asm volatile("" : "+v"(t_)); F.tid = t_; F.lane = t_ & 63; F.wave = __builtin_amdgcn_readfirstlane(t_ >> 6); } while (0)
#define SEAM(k) do { if (IN(k) && IN((k) + 1)) xcd_barrier(bar); } while (0)

    if (IN(0)) { FRESH(); phase0(F); if (DUP(0)) { __syncthreads(); phase0(F); } SEAM(0); }
    if (IN(1)) { FRESH(); phase1(F); if (DUP(1)) { __syncthreads(); phase1(F); } SEAM(1); }
    if (IN(2)) {
        { pg8::Gemm g{(const bf16*)(F.ws + WS_U), (const bf16*)(F.ws + WS_WINT), T_SEQ, 1792, 4096, 4096, 4096, 0};
          pg8::StaticOrder S; S.init(T_SEQ, 1792, F.G, F.bid);
          pg8::EpiProj E{(bf16*)(F.ws + WS_P), (float*)(F.ws + WS_MISC), (const float*)(F.ws + WS_MOD) + 16384, 0};
          pg8::gemm_phase<pg8::EpiProj, pg8::StaticOrder, PG8_ALIGN, PG8_SP2, false>(F.lds + RING_OFF, g, S, E); }
        { pg8::Gemm g{(const bf16*)(F.ws + WS_U8), (const bf16*)(F.ws + WS_WINT8), T_SEQ, NP - 1792, 2048, 2048, 2048, 0, 0x79797979u};
          pg8::StaticOrder S; S.init(T_SEQ, NP - 1792, F.G, F.bid);
          pg8::EpiProj E{(bf16*)(F.ws + WS_P), (float*)(F.ws + WS_MISC), (const float*)(F.ws + WS_MOD) + 16384, 7};
          pg8::gemm_phase<pg8::EpiProj, pg8::StaticOrder, PG8_ALIGN, PG8_SP2, true>(F.lds + RING_OFF, g, S, E); }
        SEAM(2);
    }
    if (IN(3)) { FRESH(); phase3(F); if (DUP(3)) { __syncthreads(); phase3(F); } SEAM(3); }
    if (IN(4)) {
        { pg8::Gemm g{(const bf16*)(F.ws + WS_CQ8), (const bf16*)(F.ws + WS_WQT), T_SEQ, 16384, 512, 512, 512, 0, 0x79797979u, 0x7F7F7F7Fu};
          pg8::StaticOrder S; S.init(T_SEQ, 16384, F.G, F.bid);
          pg8::EpiPlain E{(bf16*)(F.ws + WS_QA), NQA};
          pg8::gemm_phase<pg8::EpiPlain, pg8::StaticOrder, PG8_ALIGN, PG8_SP2, true>(F.lds + RING_OFF, g, S, E); }
        { pg8::Gemm g{(const bf16*)(F.ws + WS_CQ), (const bf16*)(F.ws + WS_WIQT), T_SEQ, 2048, 1024, 1024, 1024, 0};
          pg8::StaticOrder S; S.init(T_SEQ, 2048, F.G, F.bid);
          pg8::EpiPlain E{(bf16*)(F.ws + WS_QA) + 16384, NQA};
          pg8::gemm_phase<pg8::EpiPlain, pg8::StaticOrder, PG8_ALIGN, PG8_SP2, false>(F.lds + RING_OFF, g, S, E); }
        SEAM(4);
    }
    if (IN(5)) { FRESH(); phase5_fast<0>(F); if (DUP(5)) { __syncthreads(); phase5_fast<PROBE_VAR>(F); } SEAM(5); }
    if (IN(6)) { FRESH(); { const int gwi = F.bid * NWAVES + F.wave; for (int it = gwi; it < 1024; it += F.G * NWAVES) mlstm_pre_item(F, it); } LDS_BARRIER(); phase6a_select(F); if (DUP(6)) { __syncthreads(); phase6a_select(F); } SEAM(6); }
    if (IN(7)) {
        FRESH();
        constexpr int ATT_NB = MK_ATT_NB;
        if (F.G == 256) {
            constexpr int ATT_MB = (T_SEQ - 192 * ATT_NB) / 64; static_assert(192 * ATT_NB + 64 * ATT_MB == T_SEQ && ATT_MB >= 0, "ticket split");
            if (F.bid < 64) { phase8_v4(F, F.bid); FRESH();
                 phase6b_attn<0>(F, 192 * ATT_NB + F.bid, ATT_MB, 64); }
            else phase6b_attn<0>(F, F.bid - 64, ATT_NB, 192);
        } else {
            for (int b = F.bid; b < 64; b += F.G) { phase8_v4(F, b); FRESH(); }
            phase6b_attn<0>(F, F.bid, (T_SEQ - F.bid + F.G - 1) / F.G, F.G);
        }
        SEAM(7);
    }
    if (IN(8)) {
        pg8::Gemm g{(const bf16*)(F.ws + WS_OLAT), (const bf16*)(F.ws + WS_WUVT), T_SEQ, 4096, 1024, 16384, 1024, 1024};
        pg8::StaticOrder S; S.init(T_SEQ, 4096, F.G, F.bid);
        pg8::EpiGate<0, true> E{(void*)(F.ws + WS_OG), 4096, (const bf16*)(F.ws + WS_P) + PC_ZA, NP, nullptr, 16.0f};
        pg8::gemm_phase<pg8::EpiGate<0, true>, pg8::StaticOrder, PG8_ALIGN, PG8_SP2>(F.lds + RING_OFF, g, S, E);
    }
    if (IN(10)) { FRESH(); phase9(F); if (DUP(10)) { __syncthreads(); phase9(F); } SEAM(10); }
    if (IN(11)) {
        { pg8::Gemm g{(const bf16*)(F.ws + WS_OG), (const bf16*)(F.ws + WS_WAOT), T_SEQ, 4096, 2048, 2048, 2048, 0, 0x79797979u, 0x7B7B7B7Bu};
          pg8::StaticOrder S; S.init(T_SEQ, 4096, F.G, F.bid);
          pg8::EpiGate<0, false> E{(void*)(F.ws + WS_TMP), 4096, (const bf16*)(F.ws + WS_P) + PC_GA, NP, nullptr, 1.0f};
          pg8::gemm_phase<pg8::EpiGate<0, false>, pg8::StaticOrder, PG8_ALIGN, PG8_SP2, true>(F.lds + RING_OFF, g, S, E); }
        VM_WAIT(); __syncthreads();
        { pg8::Gemm g{(const bf16*)(F.ws + WS_HG), (const bf16*)(F.ws + WS_WMOT), T_SEQ, 4096, 2048, 2048, 2048, 0, 0x79797979u, 0x7D7D7D7Du};
          pg8::StaticOrder S; S.init(T_SEQ, 4096, F.G, F.bid);
          pg8::EpiGate<1, true> E{(void*)(F.ws + WS_MERGED), 4096, (const bf16*)(F.ws + WS_P) + PC_GM, NP, (const bf16*)(F.ws + WS_TMP), 8.0f};
          pg8::gemm_phase<pg8::EpiGate<1, true>, pg8::StaticOrder, PG8_ALIGN, PG8_SP2, true>(F.lds + RING_OFF, g, S, E); }
        SEAM(11);
    }
    if (IN(12)) {
        pg8::Gemm g{(const bf16*)(F.ws + WS_MERGED), (const bf16*)(F.ws + WS_WOT), T_SEQ, 4096, 2048, 2048, 2048, 0, 0x79797979u, 0x7C7C7C7Cu};
        pg8::StaticOrder S; S.init(T_SEQ, 4096, F.G, F.bid);
        pg8::EpiOut E{(bf16*)(F.ws + WS_TMP), F.p_I_X, (const float*)(F.ws + WS_MOD) + 8192, DN_ALPHA};
        pg8::gemm_phase<pg8::EpiOut, pg8::StaticOrder, PG8_ALIGN, PG8_SP2, true>(F.lds + RING_OFF, g, S, E);
        SEAM(12);
    }
    if (IN(13)) { FRESH(); phase12(F); }
#undef IN
#undef SEAM
}

#ifndef MK_PER_PHASE
#define MK_PER_PHASE 0
#endif
extern "C" void kernel_launch(void* const* d_in, const int* in_sizes, int n_in, void* d_out, int out_size, void* d_ws, size_t ws_size, hipStream_t stream) {
    static int grid = 0;
    if (grid == 0) {
        if (n_in != 22 || out_size != T_SEQ * DM || ws_size < WS_END) { fprintf(stderr, "kernel_launch: unexpected shapes (n_in %d out %d ws %zu need %zu)\n", n_in, out_size, ws_size, (size_t)WS_END); grid = -1; return; }
        int dev = 0, cus = 0, per_cu = 0;
        if (hipGetDevice(&dev) != hipSuccess || hipDeviceGetAttribute(&cus, hipDeviceAttributeMultiprocessorCount, dev) != hipSuccess) { grid = -1; return; }
        if (hipFuncSetAttribute((const void*)hybrid_fwd, hipFuncAttributeMaxDynamicSharedMemorySize, LDS_BYTES) != hipSuccess) { fprintf(stderr, "kernel_launch: hipFuncSetAttribute failed\n"); grid = -1; return; }
        if (hipOccupancyMaxActiveBlocksPerMultiprocessor(&per_cu, (const void*)hybrid_fwd, NWAVES * 64, LDS_BYTES) != hipSuccess || per_cu < 1) fprintf(stderr, "kernel_launch: occupancy query reports %d\n", per_cu);
        (void)hipGetLastError();
        grid = cus;
    }
    if (grid < 0) return;
    if (hipMemsetAsync((char*)d_ws + WS_CTL, 0, CTL_ZERO_BYTES, stream) != hipSuccess) return;
    Args a{};
    for (int i = 0; i < 22; ++i) a.in[i] = (const float*)d_in[i];
    a.out = (float*)d_out; a.ws = (unsigned char*)d_ws; a.pad = 0;
#if MK_PER_PHASE
    for (int p = 0; p < N_PHASES; ++p) { a.ph_lo = p; a.ph_hi = p + 1; a.li = 0; hipLaunchKernelGGL(hybrid_fwd, dim3(grid), dim3(NWAVES * 64), LDS_BYTES, stream, a); }
#else
    a.ph_lo = 0; a.ph_hi = N_PHASES; a.li = 0;
    hipLaunchKernelGGL(hybrid_fwd, dim3(grid), dim3(NWAVES * 64), LDS_BYTES, stream, a);
#endif
}
```

```cpp
#include <hip/hip_runtime.h>
#include <cstdio>
#include <cstdint>
constexpr int T_SEQ = 8192, DM = 4096;
constexpr int NSRC = 30320;
constexpr int NP = 30464;
constexpr int NQA = 18432;
constexpr int NHEAD = 32, KVR = 512, QLR = 1024, IDXD = 64, TOPK = 256;
constexpr int MH = 8, MDK = 256, MDV = 512, MCH = 64;
constexpr int PC_QLAT = 0, PC_KV = 1024, PC_MISC = 1536, PC_ZA = 1792, PC_QK = 5888, PC_V = 9984, PC_O = 14080, PC_ZM = 18176, PC_GA = 22272, PC_GM = 26368;
constexpr float NORM_EPS = 1e-6f;
constexpr float DN_ALPHA = 1.189207115002721f;
constexpr float SOFTCAP = 15.0f;

constexpr size_t MiB = 1u << 20;
constexpr size_t WS_CTL = 0, CTL_ZERO_BYTES = 1 * MiB;
constexpr size_t WS_MOD = 1 * MiB;
constexpr size_t WS_WQT = 2 * MiB;
constexpr size_t WS_WUVT = 38 * MiB;
constexpr size_t WS_WAOT = 46 * MiB, WS_WMOT = 78 * MiB, WS_WOT = 110 * MiB;
constexpr size_t WS_CQ = 142 * MiB;
constexpr size_t WS_CKV = 158 * MiB;
constexpr size_t WS_KI = 166 * MiB;
constexpr size_t WS_WI = 167 * MiB;
constexpr size_t WS_IG = 168 * MiB;
constexpr size_t WS_LF = 168 * MiB + 256 * 1024;
constexpr size_t WS_DEN = 168 * MiB + 512 * 1024;
constexpr size_t WS_MISC = 169 * MiB;
constexpr size_t WS_QM = 177 * MiB, WS_KM = 209 * MiB;
constexpr size_t WS_OG = 241 * MiB;
constexpr size_t WS_MERGED = 305 * MiB;
constexpr size_t WS_CQ8 = 337 * MiB;
constexpr size_t WS_WIQT = 18 * MiB;
constexpr size_t WS_WINT = 369 * MiB;
constexpr size_t WS_WINT8 = 385 * MiB;
constexpr size_t WS_U8 = 503 * MiB;
constexpr size_t WS_U = 607 * MiB;
constexpr size_t WS_SC = 369 * MiB;
constexpr size_t WS_P = 671 * MiB;
constexpr size_t WS_QA = 1147 * MiB;
constexpr size_t WS_HNUM = 1709 * MiB;
constexpr size_t WS_HG = 1275 * MiB;
constexpr size_t WS_TMP = 1339 * MiB;
constexpr size_t WS_OLAT = 1435 * MiB;
constexpr size_t WS_IDX = 1691 * MiB;
constexpr size_t WS_CNT = 1699 * MiB;
constexpr size_t WS_SP = 1700 * MiB;
constexpr size_t WS_GATES = 1708 * MiB;
constexpr size_t WS_END = 1837 * MiB;
static_assert(WS_WINT + (size_t)NP * 4096 * 2 <= WS_U && WS_U + (size_t)T_SEQ * 4096 * 2 <= WS_P && WS_SC + (size_t)T_SEQ * T_SEQ * 4 <= WS_P, "ws map 1");
static_assert(WS_P + (size_t)T_SEQ * NP * 2 <= WS_QA && WS_QA + (size_t)T_SEQ * NQA * 2 <= WS_OLAT && WS_TMP + (size_t)T_SEQ * 4096 * 2 <= WS_OLAT, "ws map 2");
static_assert(WS_WQT + (size_t)NQA * 1024 * 2 <= WS_WUVT, "ws map 3");
namespace pg8 {
#define PG8_LAS __attribute__((address_space(3)))
typedef unsigned short bf16_t;
typedef short bf16x8 __attribute__((ext_vector_type(8)));
typedef float f32x4 __attribute__((ext_vector_type(4)));
typedef unsigned u32x4 __attribute__((ext_vector_type(4)));
typedef int v4i_t __attribute__((ext_vector_type(4)));
typedef int v8i_t __attribute__((ext_vector_type(8)));
constexpr int BM = 256, BK = 64, HALF = 128, HTB = HALF * BK * 2  , STAGE_BYTES = 8 * HTB, NXCD = 8, WGM = 8;

__host__ __device__ __forceinline__ int lds_byte(int r, int c) { const int st = (r >> 4) * 2 + (c >> 5), rr = r & 15, cc = c & 31, ob = rr * 64 + cc * 2; return st * 1024 + (ob ^ (((ob >> 9) & 1) << 5)); }
__host__ __device__ __forceinline__ void stage_rc(int b, int& R, int& C) { const int st = b / 1024, sb = b % 1024, swz = sb ^ (((sb >> 9) & 1) << 5); R = (st >> 1) * 16 + swz / 64; C = (st & 1) * 32 + (swz % 64) / 2; }
__host__ __device__ __forceinline__ int perm32(int rho) { const int n = rho >> 4, i = rho & 15; return 8 * (i >> 2) + 4 * n + (i & 3); }

struct Unit { int pm, pn; };
struct Gemm { const bf16_t* A; const bf16_t* Bt; int M, N, K; int lda, ldb; long a_pn_off; unsigned wscale = 0x7F7F7F7Fu, ascale = 0x7F7F7F7Fu; };

struct StaticOrder {
    int nM, nN, nwg, G, c;
    __host__ __device__ void init(int M, int N, int G_, int c_) { nM = M / BM; nN = N / BM; nwg = nM * nN; G = G_; c = c_; }
    __host__ __device__ bool next(int i, Unit& u) const {
        const long L = (long)i * G + c; if (L >= nwg) return false;
        int wgid = (int)L; { const int q = nwg / NXCD, r = nwg % NXCD, xcd = wgid % NXCD, off = wgid / NXCD; wgid = (xcd < r ? xcd * (q + 1) : r * (q + 1) + (xcd - r) * q) + off; }
        const int nig = WGM * nN, gid = wgid / nig, fm = gid * WGM, gsz = (nM - fm) < WGM ? (nM - fm) : WGM;
        u.pm = fm + ((wgid % nig) % gsz); u.pn = (wgid % nig) / gsz; return true;
    }
    __device__ __forceinline__ void a_ready(const Unit&) const {}
    __device__ __forceinline__ void done(const Unit&) const {}
};

typedef float f32x2_t __attribute__((ext_vector_type(2)));
typedef __bf16 bf16x2_t __attribute__((ext_vector_type(2)));
__device__ __forceinline__ unsigned cvt_pk_bf16(float lo, float hi) { const f32x2_t v = {lo, hi}; const bf16x2_t b = __builtin_convertvector(v, bf16x2_t); return __builtin_bit_cast(unsigned, b); }
__device__ __forceinline__ float bf_lo(unsigned w) { return __uint_as_float(w << 16); }
__device__ __forceinline__ float bf_hi(unsigned w) { return __uint_as_float(w & 0xffff0000u); }
__device__ __forceinline__ float sigmoid_f(float x) { return __builtin_amdgcn_rcpf(1.0f + __expf(-x)); }
__device__ __forceinline__ float silu_f(float x) { return x * sigmoid_f(x); }
__device__ __forceinline__ u32x4 pack8(const f32x4& v0, const f32x4& v1) { u32x4 w; w.x = cvt_pk_bf16(v0[0], v0[1]); w.y = cvt_pk_bf16(v0[2], v0[3]); w.z = cvt_pk_bf16(v1[0], v1[1]); w.w = cvt_pk_bf16(v1[2], v1[3]); return w; }
__device__ __forceinline__ void unpack8(const u32x4& w, f32x4& v0, f32x4& v1) { v0 = (f32x4){bf_lo(w.x), bf_hi(w.x), bf_lo(w.y), bf_hi(w.y)}; v1 = (f32x4){bf_lo(w.z), bf_hi(w.z), bf_lo(w.w), bf_hi(w.w)}; }

typedef unsigned u32x2 __attribute__((ext_vector_type(2)));
__device__ __forceinline__ float clamp448(float x) { return fminf(fmaxf(x, -448.f), 448.f); }
__device__ __forceinline__ u32x2 pack_fp8x8(const float (&x)[8]) {
    int p0 = __builtin_amdgcn_cvt_pk_fp8_f32(clamp448(x[0]), clamp448(x[1]), 0, false); p0 = __builtin_amdgcn_cvt_pk_fp8_f32(clamp448(x[2]), clamp448(x[3]), p0, true);
    int p1 = __builtin_amdgcn_cvt_pk_fp8_f32(clamp448(x[4]), clamp448(x[5]), 0, false); p1 = __builtin_amdgcn_cvt_pk_fp8_f32(clamp448(x[6]), clamp448(x[7]), p1, true);
    return (u32x2){(unsigned)p0, (unsigned)p1};
}
struct EpiProj {
    static constexpr bool PERM = true, AFTER_DRAIN = false;
    bf16_t* P; float* MISC; const float* bias; int tile0;
    __device__ __forceinline__ void operator()(const f32x4 (&acc)[2][2][4][2], const Unit& u, int wr, int wc, int fr, int fq) const {
        const int tile = u.pn + tile0;
        int mode;
        if (tile < 6) mode = 0; else if (tile == 6) mode = 3; else if (tile < 23) mode = 1; else if (tile < 55) mode = 0; else if (tile < 71) mode = 2; else if (tile < 87) mode = 1; else mode = 2;
        const int cin = wc * 32 + 8 * fq, col0 = tile * BM + cin;
        const __amdgpu_buffer_rsrc_t rP = __builtin_amdgcn_make_buffer_rsrc((void*)P, 0, 0x7fffffff, 0x00020000), rM = __builtin_amdgcn_make_buffer_rsrc((void*)MISC, 0, 8192 * 256 * 4, 0x00020000);
        const unsigned voffP = (unsigned)(wr * 64 + fr) * (unsigned)(NP * 2) + (unsigned)cin * 2u, voffM = (unsigned)(wr * 64 + fr) * 1024u + (unsigned)cin * 4u;
        const int sP = u.pm * BM * (NP * 2) + tile * (BM * 2), sM = u.pm * BM * 1024;
        f32x4 bv[2][2];
#pragma unroll
        for (int bj = 0; bj < 2; ++bj)
#pragma unroll
            for (int n = 0; n < 2; ++n) bv[bj][n] = *(const f32x4*)(bias + col0 + bj * HALF + 4 * n);
#pragma unroll
        for (int ai = 0; ai < 2; ++ai)
#pragma unroll
            for (int m = 0; m < 4; ++m) { const int rloc = ai * HALF + m * 16;
#pragma unroll
                for (int bj = 0; bj < 2; ++bj) { f32x4 v0 = acc[ai][bj][m][0] + bv[bj][0], v1 = acc[ai][bj][m][1] + bv[bj][1];
                    if (mode == 3) { __builtin_amdgcn_raw_buffer_store_b128(__builtin_bit_cast(u32x4, v0), rM, voffM, sM + rloc * 1024 + bj * 512, 0); __builtin_amdgcn_raw_buffer_store_b128(__builtin_bit_cast(u32x4, v1), rM, voffM, sM + rloc * 1024 + bj * 512 + 16, 0); }
                    else {
                        if (mode == 1) {
#pragma unroll
                            for (int j = 0; j < 4; ++j) { v0[j] = silu_f(v0[j]); v1[j] = silu_f(v1[j]); } }
                        else if (mode == 2) {
#pragma unroll
                            for (int j = 0; j < 4; ++j) { v0[j] = sigmoid_f(v0[j]); v1[j] = sigmoid_f(v1[j]); } }
                        __builtin_amdgcn_raw_buffer_store_b128(pack8(v0, v1), rP, voffP, sP + rloc * (NP * 2) + bj * 256, 0); } } }
    }
};
struct EpiPlain {
    static constexpr bool PERM = true, AFTER_DRAIN = false;
    bf16_t* O; int ldc;
    __device__ __forceinline__ void operator()(const f32x4 (&acc)[2][2][4][2], const Unit& u, int wr, int wc, int fr, int fq) const {
        const int row0 = u.pm * BM + wr * 64 + fr, col0 = u.pn * BM + wc * 32 + 8 * fq;
#pragma unroll
        for (int ai = 0; ai < 2; ++ai)
#pragma unroll
            for (int m = 0; m < 4; ++m) { bf16_t* rowp = O + (size_t)(row0 + ai * HALF + m * 16) * ldc + col0;
#pragma unroll
                for (int bj = 0; bj < 2; ++bj) *(u32x4*)(rowp + bj * HALF) = pack8(acc[ai][bj][m][0], acc[ai][bj][m][1]); }
    }
};
template <int MODE, bool OUT8> struct EpiGate {
    static constexpr bool PERM = true, AFTER_DRAIN = false;
    void* O; int ldc; const bf16_t* G; int ldg; const bf16_t* Tm; float oscale;
    __device__ __forceinline__ void operator()(const f32x4 (&acc)[2][2][4][2], const Unit& u, int wr, int wc, int fr, int fq) const {
        const int row0 = u.pm * BM + wr * 64 + fr, col0 = u.pn * BM + wc * 32 + 8 * fq;
#pragma unroll
        for (int ai = 0; ai < 2; ++ai)
#pragma unroll
            for (int m = 0; m < 4; ++m) { const size_t row = (size_t)(row0 + ai * HALF + m * 16);
#pragma unroll
                for (int bj = 0; bj < 2; ++bj) {
                    const u32x4 gw = *(const u32x4*)(G + row * ldg + col0 + bj * HALF); f32x4 g0, g1; unpack8(gw, g0, g1);
                    f32x4 v0 = acc[ai][bj][m][0] * g0, v1 = acc[ai][bj][m][1] * g1;
                    if (MODE == 1) { const u32x4 tw = *(const u32x4*)(Tm + row * ldc + col0 + bj * HALF); f32x4 t0, t1; unpack8(tw, t0, t1); v0 += t0; v1 += t1; }
                    if (OUT8) { const float x[8] = {v0[0] * oscale, v0[1] * oscale, v0[2] * oscale, v0[3] * oscale, v1[0] * oscale, v1[1] * oscale, v1[2] * oscale, v1[3] * oscale};
                        *(u32x2*)((unsigned char*)O + row * ldc + col0 + bj * HALF) = pack_fp8x8(x); }
                    else *(u32x4*)((bf16_t*)O + row * ldc + col0 + bj * HALF) = pack8(v0, v1); } }
    }
};
struct EpiOut {
    static constexpr bool PERM = false, AFTER_DRAIN = false;
    bf16_t* Y; const float* X; const float* gate; float alpha;
    __device__ __forceinline__ void operator()(const f32x4 (&acc)[2][2][4][2], const Unit& u, int wr, int wc, int fr, int fq) const {
        const int row0 = u.pm * BM + wr * 64 + fr, col0 = u.pn * BM + wc * 32 + 4 * fq;
        f32x4 gv[2][2];
#pragma unroll
        for (int bj = 0; bj < 2; ++bj)
#pragma unroll
            for (int n = 0; n < 2; ++n) gv[bj][n] = *(const f32x4*)(gate + col0 + bj * HALF + n * 16);
#pragma unroll
        for (int ai = 0; ai < 2; ++ai)
#pragma unroll
            for (int m = 0; m < 4; ++m) { const size_t off = (size_t)(row0 + ai * HALF + m * 16) * DM + col0;
#pragma unroll
                for (int bj = 0; bj < 2; ++bj)
#pragma unroll
                    for (int n = 0; n < 2; ++n) { const f32x4 xv = *(const f32x4*)(X + off + bj * HALF + n * 16); const f32x4 y = xv * alpha + gv[bj][n] * acc[ai][bj][m][n];
                        u32x2 o; o.x = cvt_pk_bf16(y[0], y[1]); o.y = cvt_pk_bf16(y[2], y[3]); *(u32x2*)(Y + off + bj * HALF + n * 16) = o; } }
    }
};

template <class Epi, class Sched, bool ALIGN_EPI = false, bool SP2 = false, bool FP8 = false>
__device__ __forceinline__ void gemm_phase(PG8_LAS unsigned char* lds, const Gemm g, const Sched& S, const Epi& E) {
    int tid = threadIdx.x; asm volatile("" : "+v"(tid));
    const int wid = __builtin_amdgcn_readfirstlane(tid >> 6), lane = tid & 63, wr = wid >> 2, wc = wid & 3, fr = lane & 15, fq = lane >> 4;
    const int K = g.K, nt = K / BK;
    unsigned voffA[2], voffB[2];
#pragma unroll
    for (int i = 0; i < 2; ++i) { int R, C; stage_rc(tid * 16 + i * 8192, R, C); const int Rb = Epi::PERM ? ((R & ~31) + perm32(R & 31)) : R;
        voffA[i] = (unsigned)(R * g.lda + C) * 2u; voffB[i] = (unsigned)(Rb * g.ldb + C) * 2u; }
    const size_t kstep = (size_t)(BK * 2);
    const size_t hstepA = (size_t)HALF * g.lda * 2, hstepB = (size_t)HALF * g.ldb * 2;
    const size_t tstepA = 2 * hstepA, tstepB = 2 * hstepB, pnA = (size_t)g.a_pn_off * 2;
    const unsigned ldsw = (unsigned)wid * 1024u;
    const int aoff = lds_byte(wr * 64 + fr, fq * 8), boff = lds_byte(wc * 32 + fr, fq * 8);
#define PG8_SA(b, h) (((b) * 2 + (h)) * HTB)
#define PG8_SB(b, h) ((4 + (b) * 2 + (h)) * HTB)
#define PG8_STAGE(bufoff, gbase, voff) do { _Pragma("unroll") for (int _i = 0; _i < 2; ++_i) \
        __builtin_amdgcn_global_load_lds((const unsigned*)((const char*)(gbase) + (voff)[_i]), (PG8_LAS unsigned*)(lds + (bufoff) + ldsw + _i * 8192), 16, 0, 0); } while (0)
#define PG8_LDA(dst, b, h) do { _Pragma("unroll") for (int m = 0; m < 4; ++m) { \
        const bf16x8 _l0 = *(const PG8_LAS bf16x8*)(lds + PG8_SA(b, h) + aoff + m * 2048), _l1 = *(const PG8_LAS bf16x8*)(lds + PG8_SA(b, h) + aoff + m * 2048 + 1024); \
        if constexpr (FP8) dst##8[m] = __builtin_shufflevector(__builtin_bit_cast(v4i_t, _l0), __builtin_bit_cast(v4i_t, _l1), 0, 1, 2, 3, 4, 5, 6, 7); else { dst[m][0] = _l0; dst[m][1] = _l1; } } } while (0)
#define PG8_LDB(dst, b, h) do { _Pragma("unroll") for (int n = 0; n < 2; ++n) { \
        const bf16x8 _l0 = *(const PG8_LAS bf16x8*)(lds + PG8_SB(b, h) + boff + n * 2048), _l1 = *(const PG8_LAS bf16x8*)(lds + PG8_SB(b, h) + boff + n * 2048 + 1024); \
        if constexpr (FP8) dst##8[n] = __builtin_shufflevector(__builtin_bit_cast(v4i_t, _l0), __builtin_bit_cast(v4i_t, _l1), 0, 1, 2, 3, 4, 5, 6, 7); else { dst[n][0] = _l0; dst[n][1] = _l1; } } } while (0)
#define PG8_MMA(ai, bj, At, Bt) do { __builtin_amdgcn_s_setprio(1); \
        if constexpr (FP8) { _Pragma("unroll") for (int m = 0; m < 4; ++m) _Pragma("unroll") for (int n = 0; n < 2; ++n) \
            asm volatile("v_mfma_scale_f32_16x16x128_f8f6f4 %0, %1, %2, %0, %3, %4 op_sel_hi:[0,0,0]" : "+v"(acc[ai][bj][m][n]) : "v"(Bt##8[n]), "v"(At##8[m]), "v"(f8_ws), "v"(f8_one)); } \
        else { _Pragma("unroll") for (int m = 0; m < 4; ++m) _Pragma("unroll") for (int n = 0; n < 2; ++n) _Pragma("unroll") for (int k = 0; k < 2; ++k) \
            acc[ai][bj][m][n] = __builtin_amdgcn_mfma_f32_16x16x32_bf16(Bt[n][k], At[m][k], acc[ai][bj][m][n], 0, 0, 0); } \
        __builtin_amdgcn_s_setprio(0); } while (0)
#define PG8_WAIT_V(n) asm volatile("s_waitcnt vmcnt(" #n ")" ::: "memory")
#define PG8_WAIT_L(n) asm volatile("s_waitcnt lgkmcnt(" #n ")" ::: "memory")
#define PG8_BAR __builtin_amdgcn_s_barrier()
#define PG8_SCHED __builtin_amdgcn_sched_barrier(0)
    Unit cur, nxt; int ui = 0;
    if (!S.next(0, cur)) return;
    f32x4 acc[2][2][4][2];
#pragma unroll
    for (int a = 0; a < 2; ++a)
#pragma unroll
        for (int b = 0; b < 2; ++b)
#pragma unroll
            for (int m = 0; m < 4; ++m)
#pragma unroll
                for (int n = 0; n < 2; ++n) acc[a][b][m][n] = (f32x4){0.f, 0.f, 0.f, 0.f};
    const int f8_ws = (int)g.wscale, f8_one = (int)g.ascale;
    bf16x8 At[4][2], B0[2][2], B1[2][2]; v8i_t At8[4], B08[2], B18[2];
    const char* cA = (const char*)g.A + (size_t)cur.pm * tstepA + (size_t)cur.pn * pnA; const char* cB = (const char*)g.Bt + (size_t)cur.pn * tstepB;
    S.a_ready(cur);
    if constexpr (SP2) {
        PG8_STAGE(PG8_SB(0, 0), cB, voffB); PG8_STAGE(PG8_SB(0, 1), cB + hstepB, voffB); PG8_STAGE(PG8_SA(0, 0), cA, voffA); PG8_STAGE(PG8_SA(0, 1), cA + hstepA, voffA);
        if (wr == 1) PG8_BAR;
        PG8_WAIT_V(2); PG8_BAR;
        PG8_STAGE(PG8_SB(1, 0), cB + kstep, voffB); PG8_STAGE(PG8_SA(1, 0), cA + kstep, voffA); PG8_STAGE(PG8_SB(1, 1), cB + hstepB + kstep, voffB);
        PG8_WAIT_V(6); PG8_BAR;
    } else {
        PG8_STAGE(PG8_SB(0, 0), cB, voffB); PG8_STAGE(PG8_SA(0, 0), cA, voffA); PG8_STAGE(PG8_SB(0, 1), cB + hstepB, voffB); PG8_STAGE(PG8_SA(0, 1), cA + hstepA, voffA);
        if (wr == 1) PG8_BAR;
        PG8_WAIT_V(4); PG8_BAR;
        PG8_STAGE(PG8_SB(1, 0), cB + kstep, voffB); PG8_STAGE(PG8_SA(1, 0), cA + kstep, voffA); PG8_STAGE(PG8_SB(1, 1), cB + hstepB + kstep, voffB);
        PG8_WAIT_V(6); PG8_BAR;
    }
    for (;;) {
        const bool has_next = S.next(ui + 1, nxt);
        const char* nA = has_next ? (const char*)g.A + (size_t)nxt.pm * tstepA + (size_t)nxt.pn * pnA : cA; const char* nB = has_next ? (const char*)g.Bt + (size_t)nxt.pn * tstepB : cB;
        for (int t = 0; t < nt; t += 2) {
            const bool last = (t == nt - 2);
            const char* a1 = cA + (size_t)(t + 1) * kstep;
            const char* a2 = last ? nA : cA + (size_t)(t + 2) * kstep; const char* b2 = last ? nB : cB + (size_t)(t + 2) * kstep;
            const char* a3 = a2 + kstep; const char* b3 = b2 + kstep;
            if (last && has_next) S.a_ready(nxt);
            if constexpr (SP2) {
            PG8_LDB(B0, 0, 0); PG8_LDB(B1, 0, 1); PG8_SCHED; PG8_LDA(At, 0, 0); PG8_STAGE(PG8_SA(1, 1), a1 + hstepA, voffA);
            PG8_WAIT_V(8); PG8_WAIT_L(0); PG8_BAR; PG8_MMA(0, 0, At, B0); PG8_MMA(0, 1, At, B1); PG8_BAR; PG8_SCHED;
            PG8_LDA(At, 0, 1); PG8_STAGE(PG8_SB(0, 0), b2, voffB); PG8_STAGE(PG8_SB(0, 1), b2 + hstepB, voffB); PG8_STAGE(PG8_SA(0, 0), a2, voffA);
            PG8_WAIT_V(8); PG8_WAIT_L(0); PG8_BAR; PG8_MMA(1, 0, At, B0); PG8_MMA(1, 1, At, B1); PG8_BAR; PG8_SCHED;
            PG8_LDB(B0, 1, 0); PG8_LDB(B1, 1, 1); PG8_SCHED; PG8_LDA(At, 1, 0); PG8_STAGE(PG8_SA(0, 1), a2 + hstepA, voffA);
            PG8_WAIT_V(8); PG8_WAIT_L(0); PG8_BAR; PG8_MMA(0, 0, At, B0); PG8_MMA(0, 1, At, B1); PG8_BAR; PG8_SCHED;
            PG8_LDA(At, 1, 1); PG8_STAGE(PG8_SB(1, 0), b3, voffB); PG8_STAGE(PG8_SB(1, 1), b3 + hstepB, voffB); PG8_STAGE(PG8_SA(1, 0), a3, voffA);
            PG8_WAIT_V(8); PG8_WAIT_L(0); PG8_BAR; PG8_MMA(1, 0, At, B0); PG8_MMA(1, 1, At, B1); PG8_BAR; PG8_SCHED;
            } else {
            PG8_LDB(B0, 0, 0); PG8_SCHED; PG8_LDA(At, 0, 0); PG8_STAGE(PG8_SA(1, 1), a1 + hstepA, voffA);
            PG8_WAIT_L(8); PG8_BAR; PG8_WAIT_L(0); PG8_MMA(0, 0, At, B0); PG8_BAR; PG8_SCHED;
            PG8_LDB(B1, 0, 1); PG8_STAGE(PG8_SB(0, 0), b2, voffB);
            PG8_BAR; PG8_WAIT_L(0); PG8_MMA(0, 1, At, B1); PG8_BAR;
            PG8_LDA(At, 0, 1); PG8_STAGE(PG8_SA(0, 0), a2, voffA);
            PG8_BAR; PG8_WAIT_L(0); PG8_MMA(1, 0, At, B0); PG8_BAR; PG8_SCHED;
            PG8_STAGE(PG8_SB(0, 1), b2 + hstepB, voffB);
            PG8_WAIT_V(6); PG8_BAR; PG8_MMA(1, 1, At, B1); PG8_BAR;
            PG8_LDB(B0, 1, 0); PG8_SCHED; PG8_LDA(At, 1, 0); PG8_STAGE(PG8_SA(0, 1), a2 + hstepA, voffA);
            PG8_WAIT_L(8); PG8_BAR; PG8_WAIT_L(0); PG8_MMA(0, 0, At, B0); PG8_BAR; PG8_SCHED;
            PG8_LDB(B1, 1, 1); PG8_STAGE(PG8_SB(1, 0), b3, voffB);
            PG8_BAR; PG8_WAIT_L(0); PG8_MMA(0, 1, At, B1); PG8_BAR;
            PG8_LDA(At, 1, 1); PG8_STAGE(PG8_SA(1, 0), a3, voffA);
            PG8_BAR; PG8_WAIT_L(0); PG8_MMA(1, 0, At, B0); PG8_BAR; PG8_SCHED;
            PG8_STAGE(PG8_SB(1, 1), b3 + hstepB, voffB);
            PG8_WAIT_V(6); PG8_BAR; PG8_MMA(1, 1, At, B1); PG8_BAR;
            }
        }
        if constexpr (ALIGN_EPI) { if (wr == 0) PG8_BAR; }
        if constexpr (!Epi::AFTER_DRAIN) { E(acc, cur, wr, wc, fr, fq); S.done(cur); }
        if (!has_next) break;
#pragma unroll
        for (int a = 0; a < 2; ++a)
#pragma unroll
            for (int b = 0; b < 2; ++b)
#pragma unroll
                for (int m = 0; m < 4; ++m)
#pragma unroll
                    for (int n = 0; n < 2; ++n) acc[a][b][m][n] = (f32x4){0.f, 0.f, 0.f, 0.f};
        cur = nxt; cA = nA; cB = nB; ++ui;
        if constexpr (ALIGN_EPI) { if (wr == 1) PG8_BAR; }
    }
    PG8_WAIT_V(0);
    if constexpr (!ALIGN_EPI) { if (wr == 0) PG8_BAR; }
    PG8_BAR;
    if constexpr (Epi::AFTER_DRAIN) { E.fused(acc, cur, wr, wc, fr, fq, lds, wid, lane); S.done(cur); }
#undef PG8_SA
#undef PG8_SB
#undef PG8_STAGE
#undef PG8_LDA
#undef PG8_LDB
#undef PG8_MMA
#undef PG8_WAIT_V
#undef PG8_WAIT_L
#undef PG8_BAR
#undef PG8_SCHED
}
}
#ifndef PG8_SP2
#define PG8_SP2 true
#endif
#ifndef PG8_ALIGN
#define PG8_ALIGN true
#endif

constexpr int NWAVES = 8;
constexpr int RING_OFF = 0, RING_BYTES = 131072;
constexpr int LDSCTL_OFF = RING_BYTES, MISC_OFF = LDSCTL_OFF + 320;
constexpr int LDS_BYTES = 147456;
static_assert(MISC_OFF + 128 <= LDS_BYTES, "LDS map");

#define GAS __attribute__((address_space(1)))
#define LAS __attribute__((address_space(3)))
typedef unsigned short bf16;
typedef unsigned v4u __attribute__((ext_vector_type(4)));
typedef unsigned v2u __attribute__((ext_vector_type(2)));
typedef float f32x4 __attribute__((ext_vector_type(4)));
typedef float f32x16 __attribute__((ext_vector_type(16)));
typedef short bf16x8 __attribute__((ext_vector_type(8)));
typedef short s16x4 __attribute__((ext_vector_type(4)));
typedef GAS unsigned gu32;
#define RLX_AGENT __ATOMIC_RELAXED, __HIP_MEMORY_SCOPE_AGENT
#define LDS_WAIT() asm volatile("s_waitcnt lgkmcnt(0)" ::: "memory")
#define VM_WAIT() asm volatile("s_waitcnt vmcnt(0)" ::: "memory")
#define LDS_BARRIER() do { asm volatile("s_waitcnt lgkmcnt(0)" ::: "memory"); __builtin_amdgcn_s_barrier(); asm volatile("" ::: "memory"); } while (0)
using pg8::pack_fp8x8; using pg8::clamp448; using pg8::cvt_pk_bf16; using pg8::bf_lo; using pg8::bf_hi; using pg8::sigmoid_f; using pg8::silu_f;
#define FR_DPP(v, ctrl) __builtin_bit_cast(float, __builtin_amdgcn_update_dpp(__builtin_bit_cast(int, (float)(v)), __builtin_bit_cast(int, (float)(v)), (ctrl), 0xf, 0xf, false))
#define FR_LANE(v, k) __builtin_bit_cast(float, __builtin_amdgcn_readlane(__builtin_bit_cast(int, (float)(v)), (k)))
__device__ __forceinline__ float wave_sum(float v) {
    v += FR_DPP(v, 0x128); v += FR_DPP(v, 0x124); v += FR_DPP(v, 0x122); v += FR_DPP(v, 0x121);
    return (FR_LANE(v, 0) + FR_LANE(v, 16)) + (FR_LANE(v, 32) + FR_LANE(v, 48));
}
__device__ __forceinline__ float wave_max(float v) {
    v = fmaxf(v, FR_DPP(v, 0x128)); v = fmaxf(v, FR_DPP(v, 0x124)); v = fmaxf(v, FR_DPP(v, 0x122)); v = fmaxf(v, FR_DPP(v, 0x121));
    return fmaxf(fmaxf(FR_LANE(v, 0), FR_LANE(v, 16)), fmaxf(FR_LANE(v, 32), FR_LANE(v, 48)));
}
#define XB_TMO      128
#define XB_XCNT(j)  (256  + 64 * (j))
#define XB_XSUB(j)  (1280 + 64 * (j))
#define XB_XGEN(j)  (2304 + 64 * (j))
#define XB_TOP      3328
#define XB_TOPGEN   3392
#define XCD_BAR_WORDS 3456
#define XB_SPIN_CAP (1u << 18)

__device__ __forceinline__ unsigned xb_ld(unsigned* p)              { return __hip_atomic_load(p, __ATOMIC_RELAXED, __HIP_MEMORY_SCOPE_AGENT); }
__device__ __forceinline__ unsigned xb_add(unsigned* p, unsigned v) { return __hip_atomic_fetch_add(p, v, __ATOMIC_RELAXED, __HIP_MEMORY_SCOPE_AGENT); }
__device__ __forceinline__ unsigned xb_xcc_id() { return (unsigned)__builtin_amdgcn_s_getreg((3 << 11) | 20) & 0xFu; }
#define XB_SPIN(cond, bar) do { unsigned _sp = 0; while (cond) { __builtin_amdgcn_s_sleep(1); \
    if ((++_sp & 255u) == 0u) { if (xb_ld(&(bar)[XB_TMO])) break; if (_sp > XB_SPIN_CAP) { atomicAdd(&(bar)[XB_TMO], 1u); break; } } } } while (0)

struct XcdBarrier {
    unsigned* bar; unsigned x;
    volatile LAS unsigned* st;
};

__device__ __forceinline__ XcdBarrier xcd_barrier_post(unsigned* bar, volatile LAS unsigned* st) {
    XcdBarrier b; b.bar = bar; b.x = xb_xcc_id(); b.st = st;
    if (threadIdx.x == 0) (void)xb_add(&bar[XB_XCNT(b.x)], 1u);
    return b;
}
__device__ __forceinline__ void xcd_barrier_complete(unsigned* bar, unsigned x, unsigned& nloc, unsigned& nx) {
    const unsigned G = gridDim.x * gridDim.y * gridDim.z;
    unsigned sum, cnt, mine, sp = 0u;
    for (;;) {
        sum = 0u; cnt = 0u; mine = 0u;
#pragma unroll
        for (unsigned j = 0; j < 16; ++j) { const unsigned c = xb_ld(&bar[XB_XCNT(j)]); sum += c; cnt += (c > 0u) ? 1u : 0u; mine = (j == x) ? c : mine; }
        if (sum == G) break;
        __builtin_amdgcn_s_sleep(1);
        if ((++sp & 255u) == 0u) { if (xb_ld(&bar[XB_TMO])) break; if (sp > XB_SPIN_CAP) { atomicAdd(&bar[XB_TMO], 1u); break; } }
    }
    nloc = mine > 0u ? mine : 1u; nx = cnt > 0u ? cnt : 1u;
}

__device__ __forceinline__ void xcd_barrier(const XcdBarrier& b) {
    asm volatile("s_waitcnt vmcnt(0)" ::: "memory");
    __syncthreads();
    if (threadIdx.x == 0) {
        unsigned* bar = b.bar;
        __builtin_amdgcn_s_waitcnt(0);
        unsigned nloc = b.st[0], nx = b.st[1];
        if (nloc == 0u) { xcd_barrier_complete(bar, b.x, nloc, nx); b.st[0] = nloc; b.st[1] = nx; }
        const unsigned old = xb_add(&bar[XB_XSUB(b.x)], 1u);
        const unsigned gen = old / nloc;
        if (old + 1u == (gen + 1u) * nloc) {
            __builtin_amdgcn_fence(__ATOMIC_RELEASE, "agent");
            asm volatile("s_waitcnt vmcnt(0)" ::: "memory");
            const unsigned og = xb_add(&bar[XB_TOP], 1u);
            const unsigned tg = og / nx;
            if (og + 1u == (tg + 1u) * nx) xb_add(&bar[XB_TOPGEN], 1u);
            else XB_SPIN(xb_ld(&bar[XB_TOPGEN]) == tg, bar);
            __builtin_amdgcn_fence(__ATOMIC_ACQUIRE, "agent");
            xb_add(&bar[XB_XGEN(b.x)], 1u);
            asm volatile("s_waitcnt vmcnt(0)" ::: "memory");
        } else {
            XB_SPIN(xb_ld(&bar[XB_XGEN(b.x)]) == gen, bar);
            __builtin_amdgcn_fence(__ATOMIC_ACQUIRE, "agent");
            asm volatile("s_waitcnt vmcnt(0)" ::: "memory");
        }
    }
    __syncthreads();
}
struct Args { const float* in[22]; float* out; unsigned char* ws; int ph_lo, ph_hi, li, pad; };
enum { I_X = 0, I_C, I_WADA, I_BADA, I_WIN, I_BIN, I_GQ, I_GKV, I_WUQ, I_WIQ, I_WUK, I_WUV, I_GKIDX, I_BKIDX, I_CONVW, I_CONVB, I_GMH, I_WAO, I_WMO, I_WOUT, I_LNG, I_LNB };

__device__ __forceinline__ void tr_item(const float* src, int src_ld, int nvalid, bf16* dst, int dst_ld, LAS float* scr, int lane) {
    const int n = lane & 31;
#pragma unroll 8
    for (int i = 0; i < 32; ++i) { const int kk = 2 * i + (lane >> 5); scr[kk * 33 + n] = (n < nvalid) ? src[(size_t)kk * src_ld + n] : 0.f; }
    LDS_WAIT(); asm volatile("" ::: "memory");
    const int c = lane & 7;
#pragma unroll
    for (int j = 0; j < 4; ++j) { const int nn = (lane >> 3) + 8 * j; const LAS float* s = scr + (8 * c) * 33 + nn;
        v4u o; o.x = cvt_pk_bf16(s[0 * 33], s[1 * 33]); o.y = cvt_pk_bf16(s[2 * 33], s[3 * 33]); o.z = cvt_pk_bf16(s[4 * 33], s[5 * 33]); o.w = cvt_pk_bf16(s[6 * 33], s[7 * 33]);
        *(v4u*)(dst + (size_t)nn * dst_ld + 8 * c) = o; }
    LDS_WAIT(); asm volatile("" ::: "memory");
}
__device__ __forceinline__ void tr_item64(const float* src_k0, int src_ld, int srccol, bf16* dst_n0k0, int dst_ld, LAS unsigned char* scr, int lane) {
    f32x4 v[16];
    const float* sp = src_k0 + (size_t)(lane >> 4) * src_ld + (srccol >= 0 ? srccol : 0);
#pragma unroll
    for (int i = 0; i < 16; ++i) v[i] = *(const f32x4*)(sp + (size_t)(4 * i) * src_ld);
    const bool pad = srccol < 0;
#pragma unroll
    for (int i = 0; i < 16; ++i) { v2u o; o.x = cvt_pk_bf16(v[i][0], v[i][1]); o.y = cvt_pk_bf16(v[i][2], v[i][3]); if (pad) { o.x = 0u; o.y = 0u; }
        *(LAS v2u*)(scr + (4 * i + (lane >> 4)) * 136 + (lane & 15) * 8) = o; }
    LDS_WAIT(); asm volatile("" ::: "memory");
    const int g = lane >> 4, q = (lane & 15) >> 2, p = lane & 3;
#pragma unroll
    for (int c = 0; c < 4; ++c)
#pragma unroll
        for (int ks = 0; ks < 2; ++ks) { const LAS unsigned char* p0 = scr + (32 * ks + 8 * g + q) * 136 + (16 * c + 4 * p) * 2;
            const s16x4 a = __builtin_amdgcn_ds_read_tr16_b64_v4i16((LAS s16x4*)p0), b = __builtin_amdgcn_ds_read_tr16_b64_v4i16((LAS s16x4*)(p0 + 4 * 136));
            const bf16x8 o = (bf16x8){a[0], a[1], a[2], a[3], b[0], b[1], b[2], b[3]};
            *(bf16x8*)(dst_n0k0 + (size_t)(16 * c + (lane & 15)) * dst_ld + 32 * ks + 8 * g) = o; }
    LDS_WAIT(); asm volatile("" ::: "memory");
}
__device__ __forceinline__ void tr_item64_f8(const float* src_k0, int src_ld, int srccol, unsigned char* dst_n0k0, int dst_ld, float scale, LAS unsigned char* scr, int lane) {
    f32x4 v[16];
    const float* sp = src_k0 + (size_t)(lane >> 4) * src_ld + (srccol >= 0 ? srccol : 0);
#pragma unroll
    for (int i = 0; i < 16; ++i) v[i] = *(const f32x4*)(sp + (size_t)(4 * i) * src_ld);
    const bool pad = srccol < 0;
#pragma unroll
    for (int i = 0; i < 16; ++i) { v2u o; o.x = cvt_pk_bf16(v[i][0] * scale, v[i][1] * scale); o.y = cvt_pk_bf16(v[i][2] * scale, v[i][3] * scale); if (pad) { o.x = 0u; o.y = 0u; }
        *(LAS v2u*)(scr + (4 * i + (lane >> 4)) * 136 + (lane & 15) * 8) = o; }
    LDS_WAIT(); asm volatile("" ::: "memory");
    const int g = lane >> 4, q = (lane & 15) >> 2, p = lane & 3;
#pragma unroll
    for (int c = 0; c < 4; ++c)
#pragma unroll
        for (int ks = 0; ks < 2; ++ks) { const LAS unsigned char* p0 = scr + (32 * ks + 8 * g + q) * 136 + (16 * c + 4 * p) * 2;
            const s16x4 a = __builtin_amdgcn_ds_read_tr16_b64_v4i16((LAS s16x4*)p0), b = __builtin_amdgcn_ds_read_tr16_b64_v4i16((LAS s16x4*)(p0 + 4 * 136));
            const float x[8] = {bf_lo((unsigned)(unsigned short)a[0]), bf_lo((unsigned)(unsigned short)a[1]), bf_lo((unsigned)(unsigned short)a[2]), bf_lo((unsigned)(unsigned short)a[3]),
                                bf_lo((unsigned)(unsigned short)b[0]), bf_lo((unsigned)(unsigned short)b[1]), bf_lo((unsigned)(unsigned short)b[2]), bf_lo((unsigned)(unsigned short)b[3])};
            *(v2u*)(dst_n0k0 + (size_t)(16 * c + (lane & 15)) * dst_ld + 32 * ks + 8 * g) = pack_fp8x8(x); }
    LDS_WAIT(); asm volatile("" ::: "memory");
}
__device__ __forceinline__ int win_src_col(int nd, int& nvalid) {
    nvalid = 32;
    if (nd < PC_MISC) return nd;
    if (nd < PC_ZA) { const int j = (nd - PC_MISC) >> 5; if (j < 2) return 1536 + 32 * j; if (j == 2) return 1600; if (j == 3) { nvalid = 16; return 18016; } nvalid = 0; return 0; }
    if (nd < PC_ZM) return 1632 + (nd - PC_ZA);
    return 18032 + (nd - PC_ZM);
}
__device__ __forceinline__ int win_src_col1(int nd) {
    if (nd < PC_MISC) return nd;
    if (nd < PC_ZA) { const int j = nd - PC_MISC; if (j < 64) return 1536 + j; if (j < 96) return 1600 + (j - 64); if (j < 112) return 18016 + (j - 96); return -1; }
    if (nd < PC_ZM) return 1632 + (nd - PC_ZA);
    return 18032 + (nd - PC_ZM);
}

constexpr int TRI_IN = 64 * (NP / 64), TRI_IQ = 16 * 32, TRI_UV = 32 * 8 * 2, TRI_SQ = 64 * 64, TRI_N = TRI_IN + TRI_IQ + TRI_UV + 3 * TRI_SQ;
__device__ __forceinline__ void tri_load16(f32x4 (&v)[16], int it, bool& pad, int lane, const float* pWIN, const float* pWIQ, const float* pWUV, const float* pWAO, const float* pWMO, const float* pWOUT) {
    const int lc = (lane & 15) * 4; const float* sp; int ld, col; int r = it;
    if (r < TRI_IN) { const int nb = r >> 6, kb = r & 63; sp = pWIN + (size_t)(kb * 64) * NSRC; ld = NSRC; col = win_src_col1(nb * 64 + lc); }
    else { r -= TRI_IN;
        if (r < TRI_IQ) { const int nb = r >> 4, kb = r & 15; sp = pWIQ + (size_t)(kb * 64) * 2048; ld = 2048; col = nb * 64 + lc; }
        else { r -= TRI_IQ;
            if (r < TRI_UV) { const int h = r >> 4, kb = (r >> 1) & 7, nb = r & 1; sp = pWUV + (size_t)h * 65536 + (size_t)(kb * 64) * 128; ld = 128; col = nb * 64 + lc; }
            else { r -= TRI_UV; const int wsel = r / TRI_SQ; r -= wsel * TRI_SQ; const int nb = r >> 6, kb = r & 63;
                sp = (wsel == 0 ? pWAO : (wsel == 1 ? pWMO : pWOUT)) + (size_t)(kb * 64) * 4096; ld = 4096; col = nb * 64 + lc; } } }
    pad = col < 0;
    const float* q = sp + (size_t)(lane >> 4) * ld + (col >= 0 ? col : 0);
#pragma unroll
    for (int i = 0; i < 16; ++i) v[i] = *(const f32x4*)(q + (size_t)(4 * i) * ld);
}
__device__ __forceinline__ void tri_finish(f32x4 (&v)[16], int it, bool pad, int lane, unsigned char* wsb, LAS unsigned char* scr) {
    int r = it; bool f8 = false; unsigned char* dst; int dld;
    if (r < TRI_IN) { const int nb = r >> 6, kb = r & 63; if (nb < 28) { dst = wsb + WS_WINT + ((size_t)(nb * 64) * 4096 + kb * 64) * 2; dld = 4096; } else { f8 = true; dst = wsb + WS_WINT8 + (size_t)(nb * 64 - 1792) * 4096 + kb * 64; dld = 4096; } }
    else { r -= TRI_IN;
        if (r < TRI_IQ) { const int nb = r >> 4, kb = r & 15; dst = wsb + WS_WIQT + ((size_t)(nb * 64) * 1024 + kb * 64) * 2; dld = 1024; }
        else { r -= TRI_IQ;
            if (r < TRI_UV) { const int h = r >> 4, kb = (r >> 1) & 7, nb = r & 1; dst = wsb + WS_WUVT + ((size_t)(256 * (h >> 1) + 128 * (h & 1) + nb * 64) * 1024 + 512 * (h & 1) + kb * 64) * 2; dld = 1024; }
            else { r -= TRI_UV; const int wsel = r / TRI_SQ; r -= wsel * TRI_SQ; const int nb = r >> 6, kb = r & 63; f8 = true;
                dst = wsb + (wsel == 0 ? WS_WAOT : (wsel == 1 ? WS_WMOT : WS_WOT)) + (size_t)(nb * 64) * 4096 + kb * 64; dld = 4096; } } }
    const float scale = f8 ? 64.0f : 1.0f;
#pragma unroll
    for (int i = 0; i < 16; ++i) { v2u o; o.x = cvt_pk_bf16(v[i][0] * scale, v[i][1] * scale); o.y = cvt_pk_bf16(v[i][2] * scale, v[i][3] * scale); if (pad) { o.x = 0u; o.y = 0u; }
        *(LAS v2u*)(scr + (4 * i + (lane >> 4)) * 136 + (lane & 15) * 8) = o; }
    LDS_WAIT(); asm volatile("" ::: "memory");
    const int g = lane >> 4, q = (lane & 15) >> 2, pp = lane & 3;
#pragma unroll
    for (int c = 0; c < 4; ++c)
#pragma unroll
        for (int ks = 0; ks < 2; ++ks) { const LAS unsigned char* p0 = scr + (32 * ks + 8 * g + q) * 136 + (16 * c + 4 * pp) * 2;
            const s16x4 a = __builtin_amdgcn_ds_read_tr16_b64_v4i16((LAS s16x4*)p0), b = __builtin_amdgcn_ds_read_tr16_b64_v4i16((LAS s16x4*)(p0 + 4 * 136));
            const size_t eo = (size_t)(16 * c + (lane & 15)) * dld + 32 * ks + 8 * g;
            if (f8) { const float x[8] = {bf_lo((unsigned)(unsigned short)a[0]), bf_lo((unsigned)(unsigned short)a[1]), bf_lo((unsigned)(unsigned short)a[2]), bf_lo((unsigned)(unsigned short)a[3]),
                                          bf_lo((unsigned)(unsigned short)b[0]), bf_lo((unsigned)(unsigned short)b[1]), bf_lo((unsigned)(unsigned short)b[2]), bf_lo((unsigned)(unsigned short)b[3])};
                *(v2u*)(dst + eo) = pack_fp8x8(x); }
            else *(bf16x8*)(dst + eo * 2) = (bf16x8){a[0], a[1], a[2], a[3], b[0], b[1], b[2], b[3]}; }
    LDS_WAIT(); asm volatile("" ::: "memory");
}
struct Frame {
    LAS unsigned char* lds; int tid, lane, wave, G, bid;
    const float *p_I_X, *p_I_C, *p_I_WADA, *p_I_BADA, *p_I_WIN, *p_I_BIN, *p_I_GQ, *p_I_GKV, *p_I_WUQ, *p_I_WIQ, *p_I_WUK, *p_I_WUV, *p_I_GKIDX, *p_I_BKIDX, *p_I_CONVW, *p_I_CONVB, *p_I_GMH, *p_I_WAO, *p_I_WMO, *p_I_WOUT, *p_I_LNG, *p_I_LNB;
    float* out; unsigned char* ws;
};

__device__ __forceinline__ void phase0(Frame& F) {
    float* MOD = (float*)(F.ws + WS_MOD); float* BIASP = MOD + 16384;
    {
        LAS float* red = (LAS float*)F.lds;
        LAS float* sc_ = (LAS float*)(F.lds + 8192);
        const float* w_ada = F.p_I_WADA; const float* cvec = F.p_I_C; const float* b_ada = F.p_I_BADA;
        for (int k = F.tid; k < 4096; k += 512) { const float cv = cvec[k]; sc_[k] = cv / (1.0f + __expf(-cv)); }
        __syncthreads();
        for (int cb = F.bid; cb < 256; cb += F.G) {
            if (F.tid < 384) {
                const int kg = F.tid / 12, c4 = F.tid % 12;
                const float* w = w_ada + (size_t)(kg * 128) * 12288 + cb * 48 + c4 * 4; const LAS float* cc = sc_ + kg * 128;
                f32x4 acc = (f32x4){0.f, 0.f, 0.f, 0.f};
#pragma unroll 16
                for (int k = 0; k < 128; ++k) { const f32x4 wv = *(const f32x4*)(w + (size_t)k * 12288); acc += wv * cc[k]; }
                *(LAS f32x4*)(red + kg * 48 + c4 * 4) = acc;
            }
            __syncthreads();
            if (F.tid < 48) { float s = b_ada[cb * 48 + F.tid];
                for (int g = 0; g < 32; ++g) s += red[g * 48 + F.tid];
                MOD[cb * 48 + F.tid] = s; }
            __syncthreads();
        }
    }
    const bool qabs_late = (F.wave & 1) != 0;
    for (int pass = 0; pass < 2; ++pass) {
    if ((pass == 0) != qabs_late)
    {
        const float* w_uq = F.p_I_WUQ; const float* w_uk = F.p_I_WUK; bf16* WQT = (bf16*)(F.ws + WS_WQT);
        const int gw = F.bid * NWAVES + F.wave, NGW = F.G * NWAVES, quad = F.lane >> 4, r16 = F.lane & 15;
        for (int it = gw; it < 2048; it += NGW) {
            const int h = it >> 6, rt = (it >> 1) & 31, kh = it & 1;
            bf16x8 ah[4], al[4];
#pragma unroll
            for (int ks = 0; ks < 4; ++ks) { float x[8]; unsigned hi[4], lo[4];
#pragma unroll
                for (int j = 0; j < 8; ++j) x[j] = w_uk[(size_t)h * 65536 + (size_t)(ks * 32 + quad * 8 + j) * 512 + rt * 16 + r16];
#pragma unroll
                for (int j = 0; j < 4; ++j) { hi[j] = cvt_pk_bf16(x[2 * j], x[2 * j + 1]); lo[j] = cvt_pk_bf16(x[2 * j] - bf_lo(hi[j]), x[2 * j + 1] - bf_hi(hi[j])); }
                ah[ks] = __builtin_bit_cast(bf16x8, (v4u){hi[0], hi[1], hi[2], hi[3]}); al[ks] = __builtin_bit_cast(bf16x8, (v4u){lo[0], lo[1], lo[2], lo[3]}); }
#pragma unroll 2
            for (int nt = 0; nt < 32; ++nt) {
                const float* bp = w_uq + (size_t)(kh * 512 + nt * 16 + r16) * 4096 + h * 128 + quad * 8;
                f32x4 acc = (f32x4){0.f, 0.f, 0.f, 0.f};
#pragma unroll
                for (int ks = 0; ks < 4; ++ks) { const f32x4 b0 = *(const f32x4*)(bp + ks * 32), b1 = *(const f32x4*)(bp + ks * 32 + 4);
                    unsigned hi[4], lo[4];
                    hi[0] = cvt_pk_bf16(b0[0], b0[1]); hi[1] = cvt_pk_bf16(b0[2], b0[3]); hi[2] = cvt_pk_bf16(b1[0], b1[1]); hi[3] = cvt_pk_bf16(b1[2], b1[3]);
                    lo[0] = cvt_pk_bf16(b0[0] - bf_lo(hi[0]), b0[1] - bf_hi(hi[0])); lo[1] = cvt_pk_bf16(b0[2] - bf_lo(hi[1]), b0[3] - bf_hi(hi[1]));
                    lo[2] = cvt_pk_bf16(b1[0] - bf_lo(hi[2]), b1[1] - bf_hi(hi[2])); lo[3] = cvt_pk_bf16(b1[2] - bf_lo(hi[3]), b1[3] - bf_hi(hi[3]));
                    const bf16x8 bh = __builtin_bit_cast(bf16x8, (v4u){hi[0], hi[1], hi[2], hi[3]}), bl = __builtin_bit_cast(bf16x8, (v4u){lo[0], lo[1], lo[2], lo[3]});
                    acc = __builtin_amdgcn_mfma_f32_16x16x32_bf16(ah[ks], bh, acc, 0, 0, 0);
                    acc = __builtin_amdgcn_mfma_f32_16x16x32_bf16(ah[ks], bl, acc, 0, 0, 0);
                    acc = __builtin_amdgcn_mfma_f32_16x16x32_bf16(al[ks], bh, acc, 0, 0, 0); }
#pragma unroll
                for (int i = 0; i < 4; ++i) ((unsigned char*)WQT)[(size_t)(h * 512 + rt * 16 + quad * 4 + i) * 1024 + kh * 512 + nt * 16 + r16] = (unsigned char)(__builtin_amdgcn_cvt_pk_fp8_f32(clamp448(acc[i] * 64.0f), 0.f, 0, false) & 0xff);
            }
        }
    }
    if (pass == 0)
    {
        LAS unsigned char* scr = F.lds + F.wave * 16384;
        const int gw = F.bid * NWAVES + F.wave, NGW = F.G * NWAVES, lane = F.lane;
        bf16* WUVT = (bf16*)(F.ws + WS_WUVT);
        const float* const pWIN = F.p_I_WIN; const float* const pWIQ = F.p_I_WIQ; const float* const pWUV = F.p_I_WUV; const float* const pWAO = F.p_I_WAO; const float* const pWMO = F.p_I_WMO; const float* const pWOUT = F.p_I_WOUT;
        unsigned char* const wsb = F.ws;
        f32x4 vA[16], vB[16]; bool padA = false, padB = false;
        int it = gw;
        if (it < TRI_N) tri_load16(vA, it, padA, lane, pWIN, pWIQ, pWUV, pWAO, pWMO, pWOUT);
        for (; it < TRI_N; it += 2 * NGW) {
            if (it + NGW < TRI_N) tri_load16(vB, it + NGW, padB, lane, pWIN, pWIQ, pWUV, pWAO, pWMO, pWOUT);
            tri_finish(vA, it, padA, lane, wsb, scr);
            if (it + 2 * NGW < TRI_N) tri_load16(vA, it + 2 * NGW, padA, lane, pWIN, pWIQ, pWUV, pWAO, pWMO, pWOUT);
            if (it + NGW < TRI_N) tri_finish(vB, it + NGW, padB, lane, wsb, scr);
        }
        for (int n = gw; n < 4096; n += NGW) { const int hsel = (n >> 7) & 1; *(v4u*)(WUVT + (size_t)n * 1024 + 512 * (1 - hsel) + F.lane * 8) = (v4u){0u, 0u, 0u, 0u}; }
        const float* b_in = F.p_I_BIN;
        for (int n = gw * 64 + F.lane; n < NP; n += NGW * 64) { const int s = win_src_col1(n); BIASP[n] = s >= 0 ? b_in[s] : 0.f; }
    }
    }
}

__device__ __forceinline__ void phase1(Frame& F) {
    const float* MOD = (const float*)(F.ws + WS_MOD); const float* x = F.p_I_X; bf16* U = (bf16*)(F.ws + WS_U);
    const size_t nvec = (size_t)T_SEQ * DM / 8;
    const int col = F.tid * 8;
    const f32x4 sh0 = *(const f32x4*)(MOD + col), sh1 = *(const f32x4*)(MOD + col + 4), sc0 = *(const f32x4*)(MOD + 4096 + col) + 1.0f, sc1 = *(const f32x4*)(MOD + 4096 + col + 4) + 1.0f;
#pragma unroll 4
    for (size_t i = (size_t)F.bid * 512 + F.tid; i < nvec; i += (size_t)F.G * 512) {
        const f32x4 x0 = *(const f32x4*)(x + i * 8), x1 = *(const f32x4*)(x + i * 8 + 4);
        const f32x4 u0 = x0 * sc0 + sh0, u1 = x1 * sc1 + sh1;
        *(v4u*)(U + i * 8) = pg8::pack8(u0, u1);
        { const float xx[8] = {u0[0], u0[1], u0[2], u0[3], u1[0], u1[1], u1[2], u1[3]}; *(v2u*)(F.ws + WS_U8 + i * 8) = pack_fp8x8(xx); }
    }
}

__device__ __forceinline__ void phase3(Frame& F) {
    const bf16* P = (const bf16*)(F.ws + WS_P); const float* MISC = (const float*)(F.ws + WS_MISC);
    bf16* CQ = (bf16*)(F.ws + WS_CQ); bf16* CKV = (bf16*)(F.ws + WS_CKV); bf16* KI = (bf16*)(F.ws + WS_KI); float* WI = (float*)(F.ws + WS_WI);
    float* IG = (float*)(F.ws + WS_IG); float* LF = (float*)(F.ws + WS_LF); bf16* QM = (bf16*)(F.ws + WS_QM); bf16* KM = (bf16*)(F.ws + WS_KM);
    const float* g_q = F.p_I_GQ; const float* g_kv = F.p_I_GKV; const float* g_kidx = F.p_I_GKIDX; const float* b_kidx = F.p_I_BKIDX;
    const float* conv_w = F.p_I_CONVW; const float* conv_b = F.p_I_CONVB;
    const int gw = F.bid * NWAVES + F.wave, NGW = F.G * NWAVES, lane = F.lane;
    f32x4 gq_[4]; const f32x4 gkv0 = *(const f32x4*)(g_kv + lane * 8), gkv1 = *(const f32x4*)(g_kv + lane * 8 + 4); const float gki = g_kidx[lane], bki = b_kidx[lane];
#pragma unroll
    for (int j = 0; j < 2; ++j) { gq_[2 * j] = *(const f32x4*)(g_q + j * 512 + lane * 8); gq_[2 * j + 1] = *(const f32x4*)(g_q + j * 512 + lane * 8 + 4); }
    for (int t = gw; t < T_SEQ; t += NGW) {
        const bf16* prow = P + (size_t)t * NP;
        { f32x4 a[4]; float ss = 0.f;
#pragma unroll
          for (int j = 0; j < 2; ++j) { const v4u w = *(const v4u*)(prow + PC_QLAT + j * 512 + lane * 8); pg8::unpack8(w, a[2 * j], a[2 * j + 1]); }
#pragma unroll
          for (int j = 0; j < 4; ++j) ss += (a[j][0] * a[j][0] + a[j][1] * a[j][1]) + (a[j][2] * a[j][2] + a[j][3] * a[j][3]);
          const float rstd = rsqrtf(wave_sum(ss) * (1.0f / 1024.0f) + NORM_EPS);
#pragma unroll
          for (int j = 0; j < 2; ++j) { const int c = j * 512 + lane * 8; const f32x4 g0 = gq_[2 * j], g1 = gq_[2 * j + 1];
              const f32x4 y0 = a[2 * j] * rstd * g0, y1 = a[2 * j + 1] * rstd * g1;
              *(v4u*)(CQ + (size_t)t * 1024 + c) = pg8::pack8(y0, y1);
              { const float x[8] = {y0[0], y0[1], y0[2], y0[3], y1[0], y1[1], y1[2], y1[3]}; *(v2u*)(F.ws + WS_CQ8 + (size_t)t * 1024 + c) = pack_fp8x8(x); } } }
        { f32x4 a0, a1; const v4u w = *(const v4u*)(prow + PC_KV + lane * 8); pg8::unpack8(w, a0, a1);
          const float ss = (a0[0] * a0[0] + a0[1] * a0[1]) + (a0[2] * a0[2] + a0[3] * a0[3]) + (a1[0] * a1[0] + a1[1] * a1[1]) + (a1[2] * a1[2] + a1[3] * a1[3]);
          const float rstd = rsqrtf(wave_sum(ss) * (1.0f / 512.0f) + NORM_EPS);
          *(v4u*)(CKV + (size_t)t * 512 + lane * 8) = pg8::pack8(a0 * rstd * gkv0, a1 * rstd * gkv1); }
        { const float* mrow = MISC + (size_t)t * 256;
          const float kv = mrow[lane]; const float mu = wave_sum(kv) * (1.0f / 64.0f); const float dlt = kv - mu; const float var = wave_sum(dlt * dlt) * (1.0f / 64.0f);
          const float y = dlt * rsqrtf(var + NORM_EPS) * gki + bki;
          KI[(size_t)t * 64 + lane] = (bf16)(cvt_pk_bf16(y, 0.f) & 0xffffu);
          if (lane < 32) WI[(size_t)t * 32 + lane] = mrow[64 + lane] * 0.022097086912079608f;
          if (lane < 16) { const float gpre = mrow[96 + lane]; const float sc = SOFTCAP * tanhf(gpre * (1.0f / SOFTCAP));
              if (lane < 8) IG[(size_t)t * 8 + lane] = sc;
              else { const float ls = fminf(sc, 0.f) - log1pf(__expf(-fabsf(sc))); LF[(size_t)t * 8 + lane - 8] = ls; } } }
    }
    for (int it = gw; it < 8 * (T_SEQ / 32); it += NGW) {
        const int j = it & 7, t0 = (it >> 3) * 32, c = j * 512 + lane * 8;
        f32x4 w0[4], w1[4];
#pragma unroll
        for (int w = 0; w < 4; ++w) { w0[w] = *(const f32x4*)(conv_w + w * 4096 + c); w1[w] = *(const f32x4*)(conv_w + w * 4096 + c + 4); }
        const f32x4 b0 = *(const f32x4*)(conv_b + c), b1 = *(const f32x4*)(conv_b + c + 4);
        v4u rows[35];
#pragma unroll
        for (int r = 0; r < 35; ++r) { const int tt = t0 - 3 + r; rows[r] = (tt >= 0) ? *(const v4u*)(P + (size_t)tt * NP + PC_QK + c) : (v4u){0u, 0u, 0u, 0u}; }
#pragma unroll
        for (int r = 0; r < 32; ++r) { f32x4 s0 = b0, s1 = b1;
#pragma unroll
            for (int w = 0; w < 4; ++w) { f32x4 a0, a1; pg8::unpack8(rows[r + w], a0, a1); s0 += a0 * w0[w]; s1 += a1 * w1[w]; }
#pragma unroll
            for (int e = 0; e < 4; ++e) { s0[e] = silu_f(s0[e]); s1[e] = silu_f(s1[e]); }
            if (c < 2048) *(v4u*)(QM + (size_t)(t0 + r) * 2048 + c) = pg8::pack8(s0, s1);
            else *(v4u*)(KM + (size_t)(t0 + r) * 2048 + (c - 2048)) = pg8::pack8(s0 * 0.0625f, s1 * 0.0625f); }
    }
}

__device__ __forceinline__ void phase5(Frame& F) {
    const bf16* QA = (const bf16*)(F.ws + WS_QA); const bf16* KI = (const bf16*)(F.ws + WS_KI); const float* WI = (const float*)(F.ws + WS_WI); float* SC = (float*)(F.ws + WS_SC);
    const int gw = F.bid * NWAVES + F.wave, NGW = F.G * NWAVES, lane = F.lane, r = lane & 31, h = lane >> 5;
    for (int qi = gw; qi < T_SEQ; qi += NGW) {
        const int grp = qi / NGW, j = qi % NGW; int t;
        if (NGW * 4 == T_SEQ) t = (grp == 0) ? j : (grp == 1) ? (T_SEQ / 2 - 1 - j) : (grp == 2) ? (T_SEQ / 2 + j) : (T_SEQ - 1 - j); else t = qi;
        bf16x8 a[4]; float wv[16];
#pragma unroll
        for (int ks = 0; ks < 4; ++ks) a[ks] = *(const bf16x8*)(QA + (size_t)t * NQA + 16384 + r * 64 + ks * 16 + h * 8);
#pragma unroll
        for (int i = 0; i < 16; ++i) wv[i] = WI[(size_t)t * 32 + (i & 3) + 8 * (i >> 2) + 4 * h];
        const int nkb = t / 32 + 1;
        for (int kb = 0; kb < nkb; ++kb) {
            const bf16* kp = KI + (size_t)(kb * 32 + r) * 64 + h * 8;
            f32x16 acc;
#pragma unroll
            for (int i = 0; i < 16; ++i) acc[i] = 0.f;
#pragma unroll
            for (int ks = 0; ks < 4; ++ks) { const bf16x8 b = *(const bf16x8*)(kp + ks * 16); acc = __builtin_amdgcn_mfma_f32_32x32x16_bf16(a[ks], b, acc, 0, 0, 0); }
            float s = 0.f;
#pragma unroll
            for (int i = 0; i < 16; ++i) s += wv[i] * fmaxf(acc[i], 0.f);
            s += __shfl_xor(s, 32);
            if (lane < 32) SC[(size_t)t * T_SEQ + kb * 32 + lane] = s;
        }
    }
}

__device__ __forceinline__ unsigned f2key(float f) { const unsigned u = __float_as_uint(f); return (u & 0x80000000u) ? ~u : (u | 0x80000000u); }
__device__ __forceinline__ int select_topk(Frame& F, const float* row, int n, LAS unsigned* w, LAS int* idx) {
    LAS unsigned* hist = w; LAS unsigned* bmg = w + 256; LAS unsigned* bme = w + 512; LAS unsigned* scan = w + 768; LAS unsigned* ctl = w + 800;
    const int tid = F.tid;
    if (n <= TOPK) { if (tid < TOPK) idx[tid] = tid < n ? tid : 0; __syncthreads(); return n; }
    unsigned prefix = 0u, mask = 0u, kth = TOPK;
#pragma unroll 1
    for (int pass = 0; pass < 4; ++pass) {
        const int shift = 24 - 8 * pass;
        if (tid < 256) hist[tid] = 0u;
        __syncthreads();
        for (int i = tid; i < n; i += 512) { const unsigned k = f2key(row[i]); if ((k & mask) == prefix) __hip_atomic_fetch_add(&hist[(k >> shift) & 255u], 1u, __ATOMIC_RELAXED, __HIP_MEMORY_SCOPE_WORKGROUP); }
        __syncthreads();
        if (tid < 256) { unsigned above = 0u; for (int b = tid + 1; b < 256; ++b) above += hist[b];
            const unsigned mine = hist[tid]; if (above < kth && kth <= above + mine) { ctl[0] = (unsigned)tid; ctl[1] = kth - above; } }
        __syncthreads();
        prefix |= ctl[0] << shift; mask |= 0xffu << shift; kth = ctl[1];
        __syncthreads();
    }
    if (tid < 256) { bmg[tid] = 0u; bme[tid] = 0u; }
    __syncthreads();
    for (int i = tid; i < n; i += 512) { const unsigned k = f2key(row[i]); if (k > prefix) __hip_atomic_fetch_or(&bmg[i >> 5], 1u << (i & 31), __ATOMIC_RELAXED, __HIP_MEMORY_SCOPE_WORKGROUP); else if (k == prefix) __hip_atomic_fetch_or(&bme[i >> 5], 1u << (i & 31), __ATOMIC_RELAXED, __HIP_MEMORY_SCOPE_WORKGROUP); }
    __syncthreads();
    unsigned word = 0u, excl = 0u;
    if (tid < 256) {
        word = bme[tid]; const unsigned ce = __popc(word); unsigned incl = ce;
#pragma unroll
        for (int o = 1; o < 64; o <<= 1) { const unsigned v = __shfl_up(incl, o); if (F.lane >= o) incl += v; }
        if (F.lane == 63) scan[F.wave] = incl;
        excl = incl - ce;
    }
    __syncthreads();
    if (tid < 256) {
        unsigned rnk = excl; for (int wv = 0; wv < F.wave; ++wv) rnk += scan[wv];
        unsigned e = word, keep = 0u;
        while (e) { const unsigned b = e & (0u - e); if (rnk < kth) keep |= b; ++rnk; e ^= b; }
        word = bmg[tid] | keep;
        const unsigned cw = __popc(word); unsigned incl = cw;
#pragma unroll
        for (int o = 1; o < 64; o <<= 1) { const unsigned v = __shfl_up(incl, o); if (F.lane >= o) incl += v; }
        if (F.lane == 63) scan[16 + F.wave] = incl;
        excl = incl - cw;
    }
    __syncthreads();
    if (tid < 256) {
        unsigned pos = excl; for (int wv = 0; wv < F.wave; ++wv) pos += scan[16 + wv];
        unsigned e = word;
        while (e) { const int b = __ffs(e) - 1; if (pos < (unsigned)TOPK) idx[pos] = tid * 32 + b; ++pos; e &= e - 1u; }
    }
    __syncthreads();
    return TOPK;
}

__device__ __forceinline__ void phase6_simple(Frame& F) {
    const bf16* QA = (const bf16*)(F.ws + WS_QA); const bf16* CKV = (const bf16*)(F.ws + WS_CKV); const float* SC = (const float*)(F.ws + WS_SC); bf16* OLAT = (bf16*)(F.ws + WS_OLAT);
    LAS float* qab = (LAS float*)F.lds;
    LAS float* pl = (LAS float*)(F.lds + 65536);
    LAS int* idx = (LAS int*)(F.lds + 98304);
    LAS unsigned* selw = (LAS unsigned*)(F.lds + 98304 + 1024);
    const int tid = F.tid;
    for (int qn = F.bid; qn < T_SEQ; qn += F.G) {
        const int rnd = qn / F.G; const int t = (rnd & 1) ? (T_SEQ - 1 - (rnd >> 1) * F.G - F.bid) : ((rnd >> 1) * F.G + F.bid);
        const int cnt = select_topk(F, SC + (size_t)t * T_SEQ, t + 1, selw, idx);
        { const bf16* qrow = QA + (size_t)t * NQA;
#pragma unroll
          for (int i = 0; i < 4; ++i) { const int e = (tid + 512 * i) * 8; const v4u w = *(const v4u*)(qrow + e); f32x4 a0, a1; pg8::unpack8(w, a0, a1); *(LAS f32x4*)(qab + e) = a0; *(LAS f32x4*)(qab + e + 4) = a1; } }
        __syncthreads();
        { const int kk = tid & 255, hg = tid >> 8; const int key = idx[kk]; const bool valid = kk < cnt;
          float acc[16];
#pragma unroll
          for (int j = 0; j < 16; ++j) acc[j] = 0.f;
          const bf16* krow = CKV + (size_t)key * 512;
          for (int r8 = 0; r8 < 64; ++r8) { const v4u w = *(const v4u*)(krow + r8 * 8); f32x4 k0, k1; pg8::unpack8(w, k0, k1);
#pragma unroll
              for (int j = 0; j < 16; ++j) { const LAS float* qp = qab + (hg * 16 + j) * 512 + r8 * 8; const f32x4 q0 = *(const LAS f32x4*)qp, q1 = *(const LAS f32x4*)(qp + 4);
                  acc[j] += (q0[0] * k0[0] + q0[1] * k0[1]) + (q0[2] * k0[2] + q0[3] * k0[3]) + (q1[0] * k1[0] + q1[1] * k1[1]) + (q1[2] * k1[2] + q1[3] * k1[3]); } }
          const float dist = (float)(t - key);
#pragma unroll
          for (int j = 0; j < 16; ++j) { const int hh = hg * 16 + j; const float slope = exp2f(-8.0f * (float)(hh + 1) / 32.0f);
              pl[kk * 32 + hh] = valid ? (acc[j] * 0.08838834764831845f - slope * dist) : -INFINITY; } }
        __syncthreads();
        { for (int hq = 0; hq < 4; ++hq) { const int hh = F.wave * 4 + hq; float v[4]; float mx = -INFINITY;
#pragma unroll
              for (int i = 0; i < 4; ++i) { v[i] = pl[(F.lane + 64 * i) * 32 + hh]; mx = fmaxf(mx, v[i]); }
              mx = wave_max(mx); float sm = 0.f;
#pragma unroll
              for (int i = 0; i < 4; ++i) { v[i] = __expf(v[i] - mx); sm += v[i]; }
              sm = wave_sum(sm); const float inv = 1.0f / sm;
#pragma unroll
              for (int i = 0; i < 4; ++i) { const float p = v[i] * inv; pl[(F.lane + 64 * i) * 32 + hh] = bf_lo(cvt_pk_bf16(p, 0.f)); } } }
        __syncthreads();
        { float o[32];
#pragma unroll
          for (int j = 0; j < 32; ++j) o[j] = 0.f;
          for (int k = 0; k < cnt; ++k) { const float v = bf_lo((unsigned)CKV[(size_t)idx[k] * 512 + tid]);
#pragma unroll
              for (int q = 0; q < 8; ++q) { const f32x4 p4 = *(const LAS f32x4*)(pl + k * 32 + q * 4); o[q * 4 + 0] += p4[0] * v; o[q * 4 + 1] += p4[1] * v; o[q * 4 + 2] += p4[2] * v; o[q * 4 + 3] += p4[3] * v; } }
          bf16* orow = OLAT + (size_t)t * 16384 + tid;
#pragma unroll
          for (int j = 0; j < 32; ++j) orow[j * 512] = (bf16)(cvt_pk_bf16(o[j], 0.f) & 0xffffu); }
        __syncthreads();
    }
}

__device__ __forceinline__ void phase8_simple(Frame& F) {
    const bf16* QM = (const bf16*)(F.ws + WS_QM); const bf16* KM = (const bf16*)(F.ws + WS_KM); const bf16* P = (const bf16*)(F.ws + WS_P);
    const float* IG = (const float*)(F.ws + WS_IG); const float* LF = (const float*)(F.ws + WS_LF); float* HNUM = (float*)(F.ws + WS_HNUM); float* DEN = (float*)(F.ws + WS_DEN);
    LAS bf16* qs = (LAS bf16*)F.lds;
    LAS bf16* ks = (LAS bf16*)(F.lds + 32768);
    LAS float* vs = (LAS float*)(F.lds + 65536);
    LAS float* gs = (LAS float*)(F.lds + 65536 + 4096);
    LAS float* red = (LAS float*)(F.lds + 65536 + 8192);
    const int tid = F.tid, c = tid & 15, dg = tid >> 4;
    for (int blk = F.bid; blk < 256; blk += F.G) {
        const int h = blk >> 5, c0 = (blk & 31) * 16;
        float C[8], nn[8]; float m = 0.f;
#pragma unroll
        for (int j = 0; j < 8; ++j) { C[j] = 0.f; nn[j] = 0.f; }
        for (int ch = 0; ch < T_SEQ / 64; ++ch) {
            const int t0 = ch * 64;
            __syncthreads();
#pragma unroll
            for (int i = 0; i < 4; ++i) { const int e = tid + 512 * i, rr = e >> 5, cc = (e & 31) * 8;
                *(LAS v4u*)(qs + rr * 256 + cc) = *(const v4u*)(QM + (size_t)(t0 + rr) * 2048 + h * 256 + cc);
                *(LAS v4u*)(ks + rr * 256 + cc) = *(const v4u*)(KM + (size_t)(t0 + rr) * 2048 + h * 256 + cc); }
#pragma unroll
            for (int i = 0; i < 2; ++i) { const int e = tid + 512 * i, rr = e >> 4, cc = e & 15; vs[e] = bf_lo((unsigned)P[(size_t)(t0 + rr) * NP + PC_V + h * 512 + c0 + cc]); }
            if (tid < 64) { gs[tid * 2] = IG[(size_t)(t0 + tid) * 8 + h]; gs[tid * 2 + 1] = LF[(size_t)(t0 + tid) * 8 + h]; }
            __syncthreads();
            for (int s = 0; s < 64; ++s) {
                const float ig = gs[s * 2], lf = gs[s * 2 + 1];
                const float mn = fmaxf(lf + m, ig); const float fa = __expf(lf + m - mn), ia = __expf(ig - mn); m = mn;
                const v4u qw = *(const LAS v4u*)(qs + s * 256 + dg * 8), kw = *(const LAS v4u*)(ks + s * 256 + dg * 8);
                f32x4 q0, q1, k0, k1; pg8::unpack8(qw, q0, q1); pg8::unpack8(kw, k0, k1);
                const float kk[8] = {k0[0], k0[1], k0[2], k0[3], k1[0], k1[1], k1[2], k1[3]}; const float qq[8] = {q0[0], q0[1], q0[2], q0[3], q1[0], q1[1], q1[2], q1[3]};
                const float vv = vs[s * 16 + c] * ia; float pn = 0.f, pq = 0.f;
#pragma unroll
                for (int j = 0; j < 8; ++j) { C[j] = fa * C[j] + kk[j] * vv; nn[j] = fa * nn[j] + ia * kk[j]; pn += C[j] * qq[j]; pq += nn[j] * qq[j]; }
                pn += __shfl_xor(pn, 16); pn += __shfl_xor(pn, 32); pq += __shfl_xor(pq, 16); pq += __shfl_xor(pq, 32);
                LAS float* rb = red + (s & 1) * 160;
                if (F.lane < 16) { rb[F.wave * 20 + c] = pn; if (c == 0) rb[F.wave * 20 + 16] = pq; }
                __syncthreads();
                if (tid < 17) { float sm = 0.f;
#pragma unroll
                    for (int wv = 0; wv < 8; ++wv) sm += rb[wv * 20 + tid];
                    if (tid < 16) HNUM[(size_t)(t0 + s) * 4096 + h * 512 + c0 + tid] = sm;
                    else if (c0 == 0) DEN[(size_t)(t0 + s) * 8 + h] = fmaxf(fabsf(sm), __expf(-m)); }
            }
        }
    }
}

__device__ __forceinline__ void phase9(Frame& F) {
    const float* HNUM = (const float*)(F.ws + WS_HNUM); const float* DEN = (const float*)(F.ws + WS_DEN); const bf16* P = (const bf16*)(F.ws + WS_P); bf16* HG = (bf16*)(F.ws + WS_HG);
    const float* g_mh = F.p_I_GMH;
    const int gw = F.bid * NWAVES + F.wave, NGW = F.G * NWAVES, lane = F.lane;
    const int h = gw & 7;
    const f32x4 g0 = *(const f32x4*)(g_mh + h * 512 + lane * 8), g1 = *(const f32x4*)(g_mh + h * 512 + lane * 8 + 4);
#pragma unroll 4
    for (int it = gw; it < T_SEQ * MH; it += NGW) {
        const int t = it >> 3; const size_t off = (size_t)t * 4096 + h * 512 + lane * 8;
        const f32x4 a0 = *(const f32x4*)(HNUM + off), a1 = *(const f32x4*)(HNUM + off + 4);
        const float ss = wave_sum((a0[0] * a0[0] + a0[1] * a0[1]) + (a0[2] * a0[2] + a0[3] * a0[3]) + (a1[0] * a1[0] + a1[1] * a1[1]) + (a1[2] * a1[2] + a1[3] * a1[3]));
        const float d = DEN[(size_t)t * 8 + h];
        const float sc = rsqrtf(ss * (1.0f / 512.0f) + NORM_EPS * d * d);
        f32x4 o0, o1, z0, z1; pg8::unpack8(*(const v4u*)(P + (size_t)t * NP + PC_O + h * 512 + lane * 8), o0, o1); pg8::unpack8(*(const v4u*)(P + (size_t)t * NP + PC_ZM + h * 512 + lane * 8), z0, z1);
        { const f32x4 r0 = a0 * sc * g0 * o0 * z0 * 4.0f, r1 = a1 * sc * g1 * o1 * z1 * 4.0f; const float x[8] = {r0[0], r0[1], r0[2], r0[3], r1[0], r1[1], r1[2], r1[3]};
          *(v2u*)((unsigned char*)HG + off) = pack_fp8x8(x); }
    }
}

__device__ __forceinline__ void phase12(Frame& F) {
    const float* ln_g = F.p_I_LNG; const float* ln_b = F.p_I_LNB; const bf16* Y = (const bf16*)(F.ws + WS_TMP);
    const int gw = F.bid * NWAVES + F.wave, NGW = F.G * NWAVES, lane = F.lane;
    f32x4 gg[16], bb[16];
#pragma unroll
    for (int j = 0; j < 16; ++j) { const int c = (j >> 1) * 512 + lane * 8 + (j & 1) * 4; gg[j] = *(const f32x4*)(ln_g + c); bb[j] = *(const f32x4*)(ln_b + c); }
    for (int t = gw; t < T_SEQ; t += NGW) {
        const bf16* yrow = Y + (size_t)t * DM; float* row = F.out + (size_t)t * DM; f32x4 v[16]; float s = 0.f;
#pragma unroll
        for (int j = 0; j < 8; ++j) { pg8::unpack8(*(const v4u*)(yrow + j * 512 + lane * 8), v[2 * j], v[2 * j + 1]); }
#pragma unroll
        for (int j = 0; j < 16; ++j) s += (v[j][0] + v[j][1]) + (v[j][2] + v[j][3]);
        const float mu = wave_sum(s) * (1.0f / 4096.0f); float q = 0.f;
#pragma unroll
        for (int j = 0; j < 16; ++j) { v[j] = v[j] - mu; q += (v[j][0] * v[j][0] + v[j][1] * v[j][1]) + (v[j][2] * v[j][2] + v[j][3] * v[j][3]); }
        const float rstd = rsqrtf(wave_sum(q) * (1.0f / 4096.0f) + NORM_EPS);
#pragma unroll
        for (int j = 0; j < 16; ++j) { const int c = (j >> 1) * 512 + lane * 8 + (j & 1) * 4; *(f32x4*)(row + c) = v[j] * rstd * gg[j] + bb[j]; }
    }
}
__device__ __forceinline__ bf16x8 tr_pair(const LAS unsigned char* p0, const LAS unsigned char* p1) {
    const s16x4 a = __builtin_amdgcn_ds_read_tr16_b64_v4i16((LAS s16x4*)p0), b = __builtin_amdgcn_ds_read_tr16_b64_v4i16((LAS s16x4*)p1);
    return (bf16x8){a[0], a[1], a[2], a[3], b[0], b[1], b[2], b[3]};
}
#define P8_DPP(old, src, ctrl, rmask) __builtin_bit_cast(float, __builtin_amdgcn_update_dpp(__builtin_bit_cast(int, (float)(old)), __builtin_bit_cast(int, (float)(src)), (ctrl), (rmask), 0xf, false))
__device__ __forceinline__ float wave_scan_add(float v) {
    v += P8_DPP(0.f, v, 0x111, 0xf); v += P8_DPP(0.f, v, 0x112, 0xf); v += P8_DPP(0.f, v, 0x114, 0xf); v += P8_DPP(0.f, v, 0x118, 0xf);
    v += P8_DPP(0.f, v, 0x142, 0xa); v += P8_DPP(0.f, v, 0x143, 0xc); return v;
}
__device__ __forceinline__ float wave_scan_max(float v) {
    const float e = -INFINITY;
    v = fmaxf(v, P8_DPP(e, v, 0x111, 0xf)); v = fmaxf(v, P8_DPP(e, v, 0x112, 0xf)); v = fmaxf(v, P8_DPP(e, v, 0x114, 0xf)); v = fmaxf(v, P8_DPP(e, v, 0x118, 0xf));
    v = fmaxf(v, P8_DPP(e, v, 0x142, 0xa)); v = fmaxf(v, P8_DPP(e, v, 0x143, 0xc)); return v;
}
#define P8_DPPI(old, src, ctrl, rmask) __builtin_amdgcn_update_dpp((int)(old), (int)(src), (ctrl), (rmask), 0xf, false)
__device__ __forceinline__ unsigned wave_scan_add_u32(unsigned v) {
    v += (unsigned)P8_DPPI(0, v, 0x111, 0xf); v += (unsigned)P8_DPPI(0, v, 0x112, 0xf); v += (unsigned)P8_DPPI(0, v, 0x114, 0xf); v += (unsigned)P8_DPPI(0, v, 0x118, 0xf);
    v += (unsigned)P8_DPPI(0, v, 0x142, 0xa); v += (unsigned)P8_DPPI(0, v, 0x143, 0xc); return v;
}
__device__ __forceinline__ unsigned lane63_u32(unsigned v) { return (unsigned)__builtin_amdgcn_readlane((int)v, 63); }
__device__ __forceinline__ float row16_allmax(float v) {
    v = fmaxf(v, P8_DPP(v, v, 0x128, 0xf)); v = fmaxf(v, P8_DPP(v, v, 0x124, 0xf)); v = fmaxf(v, P8_DPP(v, v, 0x122, 0xf)); v = fmaxf(v, P8_DPP(v, v, 0x121, 0xf)); return v;
}
__device__ __forceinline__ float row16_allsum(float v) {
    v += P8_DPP(v, v, 0x128, 0xf); v += P8_DPP(v, v, 0x124, 0xf); v += P8_DPP(v, v, 0x122, 0xf); v += P8_DPP(v, v, 0x121, 0xf); return v;
}
__device__ __forceinline__ float xor32_allsum(float v) {
    float a = v, b = v;
    asm volatile("s_nop 1\n\tv_permlane32_swap_b32 %0, %1" : "+v"(a), "+v"(b));
    return a + b;
}
__device__ __forceinline__ void p8_gates(float ig, float lf, float& m_prev, LAS float* GA, int l) {
    const float b = wave_scan_add(lf);
    const float a = ig - b; const float cm = wave_scan_max(a);
    const float M = fmaxf(m_prev, cm);
    const float M63 = __builtin_bit_cast(float, __builtin_amdgcn_readlane(__builtin_bit_cast(int, M), 63)), g = __builtin_bit_cast(float, __builtin_amdgcn_readlane(__builtin_bit_cast(int, b), 63));
    GA[l] = a; GA[64 + l] = M; GA[128 + l] = __expf(m_prev - M); GA[192 + l] = __expf(-(b + M)); GA[256 + l] = __expf(a - M63);
    if (l == 0) GA[320] = __expf(m_prev - M63);
    m_prev = g + M63;
}
template <int VAR> __device__ __forceinline__ void phase8_fast(Frame& F) {
    const bf16* QM = (const bf16*)(F.ws + WS_QM); const bf16* KM = (const bf16*)(F.ws + WS_KM); const bf16* P = (const bf16*)(F.ws + WS_P);
    const float* IG = (const float*)(F.ws + WS_IG); const float* LF = (const float*)(F.ws + WS_LF); float* HNUM = (float*)(F.ws + (VAR ? WS_SC : WS_HNUM)); float* DEN = (float*)(F.ws + (VAR ? WS_SC + 192 * MiB : WS_DEN));
    constexpr int QRS = 528, SRS = 144;
    constexpr int O_QS = 0, O_KS = 33792, O_VS = 67584, O_VW = 69632, O_VS1 = 71680, O_VW1 = 73728, O_SS = 75776, O_CT0 = 84992, O_CT1 = 93440, O_GA = 101888, O_HQX = 104960;
    constexpr int GW = 4;
    LAS unsigned char* L = F.lds;
    const int tid = F.tid, w = F.wave, l = F.lane, quad = l >> 4, r16 = l & 15;
    for (int blk = F.bid; blk < 256; blk += F.G) {
        const int h = blk >> 5, c0 = (blk & 31) * 16; const int nt = (c0 == 0) ? 2 : 1;
        LDS_BARRIER();
        for (int i = tid; i < (2 * 8448) / 4; i += 512) ((LAS unsigned*)(L + O_CT0))[i] = 0u;
        for (int i = tid; i < 512; i += 512) { ((LAS unsigned*)(L + O_VS1))[i] = ((i & 7) == 0) ? 0x00003F80u : 0u; ((LAS unsigned*)(L + O_VW1))[i] = 0u; }
        f32x4 Cst[2][2];
#pragma unroll
        for (int a = 0; a < 2; ++a)
#pragma unroll
            for (int b = 0; b < 2; ++b) Cst[a][b] = (f32x4){0.f, 0.f, 0.f, 0.f};
        float m_prev = 0.f;
        const unsigned voff = (unsigned)((tid >> 5) * 4096 + (tid & 31) * 16), voffv = (unsigned)((tid >> 1) * (NP * 2) + (tid & 1) * 16);
        v4u pq[4], pk[4], pv = (v4u){0u, 0u, 0u, 0u}; float pgi = 0.f, pgf = 0.f;
        const __amdgpu_buffer_rsrc_t rQ = __builtin_amdgcn_make_buffer_rsrc((void*)(QM + h * 256), 0, T_SEQ * 4096, 0x00020000), rK = __builtin_amdgcn_make_buffer_rsrc((void*)(KM + h * 256), 0, T_SEQ * 4096, 0x00020000),
                                     rV = __builtin_amdgcn_make_buffer_rsrc((void*)(P + PC_V + h * 512 + c0), 0, (int)((size_t)T_SEQ * NP * 2 - (size_t)(PC_V + h * 512 + c0) * 2), 0x00020000);
        const __amdgpu_buffer_rsrc_t rH = __builtin_amdgcn_make_buffer_rsrc((void*)(HNUM + h * 512 + c0), 0, T_SEQ * 16384, 0x00020000), rD = __builtin_amdgcn_make_buffer_rsrc((void*)(DEN + h), 0, T_SEQ * 32, 0x00020000);
        const unsigned hoff = (unsigned)((((w & 3) * 16 + quad * 4) * 4096 + r16) * 4), doff = (unsigned)(((w & 3) * 16 + quad * 4) * 32);
#pragma unroll
        for (int i = 0; i < 4; ++i) { pq[i] = __builtin_bit_cast(v4u, __builtin_amdgcn_raw_buffer_load_b128(rQ, voff, i * 65536, 0)); pk[i] = __builtin_bit_cast(v4u, __builtin_amdgcn_raw_buffer_load_b128(rK, voff, i * 65536, 0)); }
        if (tid < 128) pv = __builtin_bit_cast(v4u, __builtin_amdgcn_raw_buffer_load_b128(rV, voffv, 0, 0));
        if (w == GW) { pgi = IG[(size_t)l * 8 + h]; pgf = LF[(size_t)l * 8 + h]; }
        if (w == GW) p8_gates(pgi, pgf, m_prev, (LAS float*)(L + O_GA), l);
        for (int ch = 0; ch < T_SEQ / 64; ++ch) {
          {
            const int t0 = ch * 64; const int s2 = ch & 1;
            LAS float* GA = (LAS float*)(L + O_GA + s2 * 1536);
#pragma unroll
            for (int i = 0; i < 4; ++i) { const int e = tid + 512 * i, rr = e >> 5, cc = e & 31; *(LAS v4u*)(L + O_QS + rr * QRS + cc * 16) = pq[i]; *(LAS v4u*)(L + O_KS + rr * QRS + cc * 16) = pk[i]; }
            if (tid < 128) *(LAS v4u*)(L + O_VS + (tid >> 1) * 32 + (tid & 1) * 16) = pv;
            LDS_BARRIER();
            if (VAR != 1 && ch + 1 < T_SEQ / 64) { const int t1 = t0 + 64;
#pragma unroll
                for (int i = 0; i < 4; ++i) { pq[i] = __builtin_bit_cast(v4u, __builtin_amdgcn_raw_buffer_load_b128(rQ, voff, t1 * 4096 + i * 65536, 0)); pk[i] = __builtin_bit_cast(v4u, __builtin_amdgcn_raw_buffer_load_b128(rK, voff, t1 * 4096 + i * 65536, 0)); }
                if (tid < 128) pv = __builtin_bit_cast(v4u, __builtin_amdgcn_raw_buffer_load_b128(rV, voffv, t1 * (NP * 2), 0));
                if (w == GW) { pgi = IG[(size_t)(t1 + l) * 8 + h]; pgf = LF[(size_t)(t1 + l) * 8 + h]; } }
            const int jt = w & 3, sp = w >> 2, j0 = jt * 16;
            if (tid < 128) { const int rr = tid >> 1; const float wg = GA[256 + rr]; const v4u vv = *(const LAS v4u*)(L + O_VS + rr * 32 + (tid & 1) * 16); f32x4 x0, x1; pg8::unpack8(vv, x0, x1);
                *(LAS v4u*)(L + O_VW + rr * 32 + (tid & 1) * 16) = pg8::pack8(x0 * wg, x1 * wg); }
            if (nt == 2 && tid >= 128 && tid < 192) { const int rr = tid - 128; *(LAS unsigned short*)(L + O_VW1 + rr * 32) = (unsigned short)(cvt_pk_bf16(GA[256 + rr], 0.f) & 0xffffu); }
            f32x4 sacc[2], hq[2];
            sacc[0] = (f32x4){0.f, 0.f, 0.f, 0.f}; sacc[1] = sacc[0]; hq[0] = sacc[0]; hq[1] = sacc[0];
#pragma unroll
            for (int kh = 0; kh < 2; ++kh) {
                bf16x8 aq[4], bk[2][4], bc[2][4];
#pragma unroll
                for (int k4 = 0; k4 < 4; ++k4) aq[k4] = *(const LAS bf16x8*)(L + O_QS + (j0 + r16) * QRS + ((kh * 4 + k4) * 32 + quad * 8) * 2);
#pragma unroll
                for (int si = 0; si < 2; ++si) { const int st = 2 * sp + si;
                    if (st <= jt) {
#pragma unroll
                        for (int k4 = 0; k4 < 4; ++k4) bk[si][k4] = *(const LAS bf16x8*)(L + O_KS + (st * 16 + r16) * QRS + ((kh * 4 + k4) * 32 + quad * 8) * 2); } }
                if (kh == sp) {
#pragma unroll
                    for (int k4 = 0; k4 < 4; ++k4) { bc[0][k4] = *(const LAS bf16x8*)(L + O_CT0 + r16 * QRS + ((kh * 4 + k4) * 32 + quad * 8) * 2);
                        if (nt == 2) bc[1][k4] = *(const LAS bf16x8*)(L + O_CT1 + r16 * QRS + ((kh * 4 + k4) * 32 + quad * 8) * 2); } }
                __builtin_amdgcn_sched_barrier(0);
#pragma unroll
                for (int k4 = 0; k4 < 4; ++k4) {
#pragma unroll
                    for (int si = 0; si < 2; ++si) { if (2 * sp + si <= jt) sacc[si] = __builtin_amdgcn_mfma_f32_16x16x32_bf16(aq[k4], bk[si][k4], sacc[si], 0, 0, 0); }
                    if (kh == sp) { hq[0] = __builtin_amdgcn_mfma_f32_16x16x32_bf16(aq[k4], bc[0][k4], hq[0], 0, 0, 0);
                        if (nt == 2) hq[1] = __builtin_amdgcn_mfma_f32_16x16x32_bf16(aq[k4], bc[1][k4], hq[1], 0, 0, 0); } }
                __builtin_amdgcn_sched_barrier(0);
            }
#pragma unroll
            for (int si = 0; si < 2; ++si) { const int st = 2 * sp + si, s0 = st * 16; f32x4 acc = sacc[si];
                if (st <= jt) { const int s = s0 + r16; const float as = GA[s];
#pragma unroll
                    for (int i = 0; i < 4; ++i) { const int j = j0 + quad * 4 + i; acc[i] = (s <= j) ? acc[i] * __expf(as - GA[64 + j]) : 0.f; } }
#pragma unroll
                for (int i = 0; i < 4; ++i) { const int j = j0 + quad * 4 + i; *(LAS unsigned short*)(L + O_SS + j * SRS + (s0 + r16) * 2) = (unsigned short)(cvt_pk_bf16(acc[i], 0.f) & 0xffffu); } }
            if (sp == 1) { *(LAS f32x4*)(L + O_HQX + ((jt * 2 + 0) * 64 + l) * 16) = hq[0]; if (nt == 2) *(LAS f32x4*)(L + O_HQX + ((jt * 2 + 1) * 64 + l) * 16) = hq[1]; }
            LDS_BARRIER();
            bf16x8 ak[2][2], bvw[2][2];
#pragma unroll
            for (int dt = 0; dt < 2; ++dt)
#pragma unroll
                for (int kk = 0; kk < 2; ++kk) { const LAS unsigned char* p0 = L + O_KS + (kk * 32 + 8 * quad + (r16 >> 2)) * QRS + ((2 * w + dt) * 16 + 4 * (r16 & 3)) * 2; ak[dt][kk] = tr_pair(p0, p0 + 4 * QRS); }
#pragma unroll
            for (int n = 0; n < 2; ++n) { if (n < nt) {
#pragma unroll
                for (int kk = 0; kk < 2; ++kk) { const LAS unsigned char* p0 = L + (n ? O_VW1 : O_VW) + (kk * 32 + 8 * quad + (r16 >> 2)) * 32 + (r16 & 3) * 8; bvw[n][kk] = tr_pair(p0, p0 + 4 * 32); } } }
            if (w < 4) {
                bf16x8 as2[2], bv[2][2]; f32x4 hx[2];
#pragma unroll
                for (int kk = 0; kk < 2; ++kk) as2[kk] = *(const LAS bf16x8*)(L + O_SS + (j0 + r16) * SRS + (kk * 32 + quad * 8) * 2);
#pragma unroll
                for (int n = 0; n < 2; ++n) { if (n < nt) { hx[n] = *(const LAS f32x4*)(L + O_HQX + ((jt * 2 + n) * 64 + l) * 16);
#pragma unroll
                    for (int kk = 0; kk < 2; ++kk) { const LAS unsigned char* p0 = L + (n ? O_VS1 : O_VS) + (kk * 32 + 8 * quad + (r16 >> 2)) * 32 + (r16 & 3) * 8; bv[n][kk] = tr_pair(p0, p0 + 4 * 32); } } }
#pragma unroll
                for (int n = 0; n < 2; ++n) { if (n < nt) {
                    f32x4 x = hq[n] + hx[n];
#pragma unroll
                    for (int i = 0; i < 4; ++i) x[i] *= GA[128 + j0 + quad * 4 + i];
#pragma unroll
                    for (int kk = 0; kk < 2; ++kk) x = __builtin_amdgcn_mfma_f32_16x16x32_bf16(as2[kk], bv[n][kk], x, 0, 0, 0);
                    if (n == 0) {
#pragma unroll
                        for (int i = 0; i < 4; ++i) __builtin_amdgcn_raw_buffer_store_b32(__float_as_uint(x[i]), rH, hoff, (t0 + i) * 16384, 0); }
                    else if (r16 == 0) {
#pragma unroll
                        for (int i = 0; i < 4; ++i) { const int j = j0 + quad * 4 + i; __builtin_amdgcn_raw_buffer_store_b32(__float_as_uint(fmaxf(fabsf(x[i]), GA[192 + j])), rD, doff, (t0 + i) * 32, 0); } } } }
            }
            { const float decay = GA[320];
#pragma unroll
              for (int dt = 0; dt < 2; ++dt) { const int d0 = (2 * w + dt) * 16;
#pragma unroll
                  for (int n = 0; n < 2; ++n) { if (n < nt) {
                      f32x4 c = Cst[dt][n] * decay;
#pragma unroll
                      for (int kk = 0; kk < 2; ++kk) c = __builtin_amdgcn_mfma_f32_16x16x32_bf16(ak[dt][kk], bvw[n][kk], c, 0, 0, 0);
                      Cst[dt][n] = c;
                      v2u o; o.x = cvt_pk_bf16(c[0], c[1]); o.y = cvt_pk_bf16(c[2], c[3]);
                      *(LAS v2u*)(L + (n ? O_CT1 : O_CT0) + r16 * QRS + (d0 + quad * 4) * 2) = o; } } } }
            if (w == GW && ch + 1 < T_SEQ / 64) p8_gates(pgi, pgf, m_prev, (LAS float*)(L + O_GA + (1 - s2) * 1536), l);
            LDS_BARRIER();
          }
        }
    }
}
__device__ __forceinline__ void mlstm_pre_item(Frame& F, int item) {
    const bf16* QM = (const bf16*)(F.ws + WS_QM); const bf16* KM = (const bf16*)(F.ws + WS_KM); const float* IG = (const float*)(F.ws + WS_IG); const float* LF = (const float*)(F.ws + WS_LF);
    bf16* SP = (bf16*)(F.ws + WS_SP); float* GAb = (float*)(F.ws + WS_GATES); float* GBb = GAb + 8 * T_SEQ; float* GCb = GBb + 8 * T_SEQ;
    LAS float* sc = (LAS float*)(F.lds + F.wave * 16384);
    const int h = item >> 7, ch = item & 127, t0 = ch * 64, l = F.lane, quad = l >> 4, r16 = l & 15;
    const float b = wave_scan_add(LF[(size_t)(t0 + l) * 8 + h]);
    const float a = IG[(size_t)(t0 + l) * 8 + h] - b; const float cm = wave_scan_max(a);
    GAb[(size_t)h * T_SEQ + t0 + l] = a; GBb[(size_t)h * T_SEQ + t0 + l] = b; GCb[(size_t)h * T_SEQ + t0 + l] = cm;
    sc[l] = a; sc[64 + l] = cm;
    LDS_WAIT(); asm volatile("" ::: "memory");
    bf16* sp = SP + (size_t)item * 4096;
#pragma unroll 1
    for (int jt = 0; jt < 4; ++jt) {
        bf16x8 aq[8];
#pragma unroll
        for (int kk = 0; kk < 8; ++kk) aq[kk] = *(const bf16x8*)(QM + (size_t)(t0 + jt * 16 + r16) * 2048 + h * 256 + kk * 32 + quad * 8);
#pragma unroll 1
        for (int st = 0; st < 4; ++st) {
            f32x4 acc = (f32x4){0.f, 0.f, 0.f, 0.f};
            if (st <= jt) {
                bf16x8 bk[8];
#pragma unroll
                for (int kk = 0; kk < 8; ++kk) bk[kk] = *(const bf16x8*)(KM + (size_t)(t0 + st * 16 + r16) * 2048 + h * 256 + kk * 32 + quad * 8);
#pragma unroll
                for (int kk = 0; kk < 8; ++kk) acc = __builtin_amdgcn_mfma_f32_16x16x32_bf16(aq[kk], bk[kk], acc, 0, 0, 0);
                const int s = st * 16 + r16; const float as = sc[s];
#pragma unroll
                for (int i = 0; i < 4; ++i) { const int j = jt * 16 + quad * 4 + i; acc[i] = (s <= j) ? acc[i] * __expf(as - sc[64 + j]) : 0.f; }
            }
#pragma unroll
            for (int i = 0; i < 4; ++i) sp[(jt * 16 + quad * 4 + i) * 64 + st * 16 + r16] = (bf16)(cvt_pk_bf16(acc[i], 0.f) & 0xffffu);
        }
    }
}

template <int VAR> __device__ __forceinline__ void phase8_v2(Frame& F) {
    const bf16* QM = (const bf16*)(F.ws + WS_QM); const bf16* KM = (const bf16*)(F.ws + WS_KM); const bf16* P = (const bf16*)(F.ws + WS_P); const bf16* SP = (const bf16*)(F.ws + WS_SP);
    const float* GAb = (const float*)(F.ws + WS_GATES); const float* GBb = GAb + 8 * T_SEQ; const float* GCb = GBb + 8 * T_SEQ;
    float* HNUM = (float*)(F.ws + (VAR ? WS_SC : WS_HNUM)); float* DEN = (float*)(F.ws + (VAR ? WS_SC + 192 * MiB : WS_DEN));
    constexpr int QRS = 528;
    constexpr int O_KS = 0, O_VS = 33792  , O_VW = 37888, O_VS1 = 39936, O_VW1 = 41984, O_CT = 44032  , O_HQX = 77824  , O_QS = 94208;
    LAS unsigned char* L = F.lds;
    const int tid = F.tid, w = F.wave, l = F.lane, quad = l >> 4, r16 = l & 15;
    const int jt = w & 3, sp_ = w >> 2, j0 = jt * 16;
    for (int blk = F.bid; blk < 256; blk += F.G) {
        const int h = blk >> 5, c0 = (blk & 31) * 16; const int nt = (c0 == 0) ? 2 : 1;
        LDS_BARRIER();
        for (int i = tid; i < (4 * 8448) / 4; i += 512) ((LAS unsigned*)(L + O_CT))[i] = 0u;
        for (int i = tid; i < 512; i += 512) { ((LAS unsigned*)(L + O_VS1))[i] = ((i & 7) == 0) ? 0x00003F80u : 0u; ((LAS unsigned*)(L + O_VW1))[i] = 0u; }
        f32x4 Cst[2][2];
#pragma unroll
        for (int a = 0; a < 2; ++a)
#pragma unroll
            for (int b = 0; b < 2; ++b) Cst[a][b] = (f32x4){0.f, 0.f, 0.f, 0.f};
        float m_prev = 0.f;
        const __amdgpu_buffer_rsrc_t rK = __builtin_amdgcn_make_buffer_rsrc((void*)(KM + h * 256), 0, T_SEQ * 4096, 0x00020000), rQ = __builtin_amdgcn_make_buffer_rsrc((void*)(QM + h * 256), 0, T_SEQ * 4096, 0x00020000),
                                     rV = __builtin_amdgcn_make_buffer_rsrc((void*)(P + PC_V + h * 512 + c0), 0, (int)((size_t)T_SEQ * NP * 2 - (size_t)(PC_V + h * 512 + c0) * 2), 0x00020000),
                                     rS = __builtin_amdgcn_make_buffer_rsrc((void*)(SP + (size_t)h * 128 * 4096), 0, 128 * 8192, 0x00020000),
                                     rH = __builtin_amdgcn_make_buffer_rsrc((void*)(HNUM + h * 512 + c0), 0, T_SEQ * 16384, 0x00020000), rD = __builtin_amdgcn_make_buffer_rsrc((void*)(DEN + h), 0, T_SEQ * 32, 0x00020000);
        const unsigned voffk = (unsigned)((tid >> 5) * 4096 + (tid & 31) * 16), voffv = (unsigned)((tid >> 1) * (NP * 2) + (tid & 1) * 16);
        const unsigned voffq = (unsigned)((j0 + r16) * 4096 + (sp_ * 128 + quad * 8) * 2), voffs = (unsigned)((j0 + r16) * 128 + quad * 16);
        const unsigned hoff = (unsigned)(((j0 + quad * 4) * 4096 + r16) * 4), doff = (unsigned)((j0 + quad * 4) * 32);
        const float* ga = GAb + (size_t)h * T_SEQ; const float* gb = GBb + (size_t)h * T_SEQ; const float* gc = GCb + (size_t)h * T_SEQ;
        const int vrow = (tid < 128) ? (tid >> 1) : ((tid - 128) & 63);
        v4u pk[2][4], pv[2]; bf16x8 pq[2][4], ps[2][2]; f32x4 pcm[2], pb[2]; float pa[2], pg[2], pamax[2];
#pragma unroll
        for (int z = 0; z < 2; ++z) { pv[z] = (v4u){0u, 0u, 0u, 0u}; pcm[z] = (f32x4){0.f, 0.f, 0.f, 0.f}; pb[z] = pcm[z]; ps[z][0] = (bf16x8){0, 0, 0, 0, 0, 0, 0, 0}; ps[z][1] = ps[z][0]; }
#define P8V2_FETCH(Z, T1) do { \
            _Pragma("unroll") for (int i = 0; i < 4; ++i) pk[Z][i] = __builtin_bit_cast(v4u, __builtin_amdgcn_raw_buffer_load_b128(rK, voffk, (T1) * 4096 + i * 65536, 0)); \
            if (tid < 128) pv[Z] = __builtin_bit_cast(v4u, __builtin_amdgcn_raw_buffer_load_b128(rV, voffv, (T1) * (NP * 2), 0)); \
            _Pragma("unroll") for (int i = 0; i < 4; ++i) pq[Z][i] = __builtin_bit_cast(bf16x8, __builtin_amdgcn_raw_buffer_load_b128(rQ, voffk, (T1) * 4096 + i * 65536, 0)); \
            if (w < 4) { _Pragma("unroll") for (int kk = 0; kk < 2; ++kk) ps[Z][kk] = __builtin_bit_cast(bf16x8, __builtin_amdgcn_raw_buffer_load_b128(rS, voffs, ((T1) >> 6) * 8192 + kk * 64, 0)); \
                pcm[Z] = *(const f32x4*)(gc + (T1) + j0 + quad * 4); pb[Z] = *(const f32x4*)(gb + (T1) + j0 + quad * 4); } \
            pa[Z] = ga[(T1) + vrow]; pg[Z] = gb[(T1) + 63]; pamax[Z] = gc[(T1) + 63]; } while (0)
        P8V2_FETCH(0, 0); P8V2_FETCH(1, 64);
        for (int ch2 = 0; ch2 < T_SEQ / 64; ch2 += 2) {
#pragma unroll
          for (int z = 0; z < 2; ++z) {
            const int ch = ch2 + z, t0 = ch * 64, cur = z, nxt = z ^ 1;
            const float M63 = fmaxf(m_prev, pamax[z]), decay = __expf(m_prev - M63), wg = __expf(pa[z] - M63);
            float rj[4], inj[4], enj[4];
#pragma unroll
            for (int i = 0; i < 4; ++i) { const float Mj = fmaxf(m_prev, pcm[z][i]); rj[i] = __expf(pcm[z][i] - Mj); inj[i] = __expf(m_prev - Mj); enj[i] = __expf(-(pb[z][i] + Mj)); }
            m_prev = pg[z] + M63;
#pragma unroll
            for (int i = 0; i < 4; ++i) { const int e = tid + 512 * i, rr = e >> 5, cc = e & 31; *(LAS v4u*)(L + O_KS + rr * QRS + cc * 16) = pk[z][i]; *(LAS bf16x8*)(L + O_QS + rr * QRS + cc * 16) = pq[z][i]; }
            if (tid < 128) { *(LAS v4u*)(L + O_VS + cur * 2048 + (tid >> 1) * 32 + (tid & 1) * 16) = pv[z]; f32x4 x0, x1; pg8::unpack8(pv[z], x0, x1); *(LAS v4u*)(L + O_VW + (tid >> 1) * 32 + (tid & 1) * 16) = pg8::pack8(x0 * wg, x1 * wg); }
            else if (nt == 2 && tid < 192) *(LAS unsigned short*)(L + O_VW1 + (tid - 128) * 32) = (unsigned short)(cvt_pk_bf16(wg, 0.f) & 0xffffu);
            bf16x8 aq[4], as2[2];
            as2[0] = ps[z][0]; as2[1] = ps[z][1];
            LDS_BARRIER();
#pragma unroll
            for (int k4 = 0; k4 < 4; ++k4) aq[k4] = *(const LAS bf16x8*)(L + O_QS + (j0 + r16) * QRS + ((sp_ * 4 + k4) * 32 + quad * 8) * 2);
            if (VAR != 1 && ch + 2 < T_SEQ / 64) P8V2_FETCH(z, t0 + 128);
            f32x4 hq[2];
            hq[0] = (f32x4){0.f, 0.f, 0.f, 0.f}; hq[1] = hq[0];
            { bf16x8 bc[2][4];
#pragma unroll
              for (int k4 = 0; k4 < 4; ++k4) { bc[0][k4] = *(const LAS bf16x8*)(L + O_CT + (cur * 2 + 0) * 8448 + r16 * QRS + ((sp_ * 4 + k4) * 32 + quad * 8) * 2);
                  if (nt == 2) bc[1][k4] = *(const LAS bf16x8*)(L + O_CT + (cur * 2 + 1) * 8448 + r16 * QRS + ((sp_ * 4 + k4) * 32 + quad * 8) * 2); }
#pragma unroll
              for (int k4 = 0; k4 < 4; ++k4) { hq[0] = __builtin_amdgcn_mfma_f32_16x16x32_bf16(aq[k4], bc[0][k4], hq[0], 0, 0, 0);
                  if (nt == 2) hq[1] = __builtin_amdgcn_mfma_f32_16x16x32_bf16(aq[k4], bc[1][k4], hq[1], 0, 0, 0); } }
            if (sp_ == 1) { *(LAS f32x4*)(L + O_HQX + cur * 8192 + ((jt * 2 + 0) * 64 + l) * 16) = hq[0]; if (nt == 2) *(LAS f32x4*)(L + O_HQX + cur * 8192 + ((jt * 2 + 1) * 64 + l) * 16) = hq[1]; }
            { bf16x8 ak[2][2], bvw[2][2];
#pragma unroll
              for (int dt = 0; dt < 2; ++dt)
#pragma unroll
                  for (int kk = 0; kk < 2; ++kk) { const LAS unsigned char* p0 = L + O_KS + (kk * 32 + 8 * quad + (r16 >> 2)) * QRS + ((2 * w + dt) * 16 + 4 * (r16 & 3)) * 2; ak[dt][kk] = tr_pair(p0, p0 + 4 * QRS); }
#pragma unroll
              for (int n = 0; n < 2; ++n) { if (n < nt) {
#pragma unroll
                  for (int kk = 0; kk < 2; ++kk) { const LAS unsigned char* p0 = L + (n ? O_VW1 : O_VW) + (kk * 32 + 8 * quad + (r16 >> 2)) * 32 + (r16 & 3) * 8; bvw[n][kk] = tr_pair(p0, p0 + 4 * 32); } } }
#pragma unroll
              for (int dt = 0; dt < 2; ++dt) { const int d0 = (2 * w + dt) * 16;
#pragma unroll
                  for (int n = 0; n < 2; ++n) { if (n < nt) {
                      f32x4 c = Cst[dt][n] * decay;
#pragma unroll
                      for (int kk = 0; kk < 2; ++kk) c = __builtin_amdgcn_mfma_f32_16x16x32_bf16(ak[dt][kk], bvw[n][kk], c, 0, 0, 0);
                      Cst[dt][n] = c;
                      v2u o; o.x = cvt_pk_bf16(c[0], c[1]); o.y = cvt_pk_bf16(c[2], c[3]);
                      *(LAS v2u*)(L + O_CT + (nxt * 2 + n) * 8448 + r16 * QRS + (d0 + quad * 4) * 2) = o; } } } }
            LDS_BARRIER();
            if (w < 4) {
#pragma unroll
                for (int n = 0; n < 2; ++n) { if (n < nt) {
                    const f32x4 hx = *(const LAS f32x4*)(L + O_HQX + cur * 8192 + ((jt * 2 + n) * 64 + l) * 16);
                    f32x4 x = (f32x4){0.f, 0.f, 0.f, 0.f};
                    const LAS unsigned char* vb = n ? (L + O_VS1) : (L + O_VS + cur * 2048);
#pragma unroll
                    for (int kk = 0; kk < 2; ++kk) { const LAS unsigned char* p0 = vb + (kk * 32 + 8 * quad + (r16 >> 2)) * 32 + (r16 & 3) * 8; x = __builtin_amdgcn_mfma_f32_16x16x32_bf16(as2[kk], tr_pair(p0, p0 + 4 * 32), x, 0, 0, 0); }
#pragma unroll
                    for (int i = 0; i < 4; ++i) x[i] = x[i] * rj[i] + inj[i] * (hq[n][i] + hx[i]);
                    if (n == 0) {
#pragma unroll
                        for (int i = 0; i < 4; ++i) __builtin_amdgcn_raw_buffer_store_b32(__float_as_uint(x[i]), rH, hoff, (t0 + i) * 16384, 0); }
                    else if (r16 == 0) {
#pragma unroll
                        for (int i = 0; i < 4; ++i) __builtin_amdgcn_raw_buffer_store_b32(__float_as_uint(fmaxf(fabsf(x[i]), enj[i])), rD, doff, (t0 + i) * 32, 0); } } }
            }
          }
        }
#undef P8V2_FETCH
    }
}
__device__ __forceinline__ void phase8_v3(Frame& F, int blk) {
    const bf16* QM = (const bf16*)(F.ws + WS_QM); const bf16* KM = (const bf16*)(F.ws + WS_KM); const bf16* P = (const bf16*)(F.ws + WS_P); const bf16* SP = (const bf16*)(F.ws + WS_SP);
    const float* GAb = (const float*)(F.ws + WS_GATES); const float* GBb = GAb + 8 * T_SEQ; const float* GCb = GBb + 8 * T_SEQ;
    float* HNUM = (float*)(F.ws + WS_HNUM); float* DEN = (float*)(F.ws + WS_DEN);
    constexpr int QRS = 528;
    constexpr int O_KS = 0, O_VS = 33792  , O_VW = 41984  , O_VS1 = 46080  , O_VW1 = 48128  , O_CT = 50176  , O_HQX = 100864  ;
    static_assert(O_HQX + 2 * 12288 <= RING_BYTES, "mLSTM v3 LDS map");
    LAS unsigned char* L = F.lds;
    const int tid = F.tid, w = F.wave, l = F.lane, quad = l >> 4, r16 = l & 15;
    const int jt = w & 3, sp_ = w >> 2, j0 = jt * 16;
    const int h = blk >> 4, c0 = (blk & 15) * 32; const int nt = (c0 == 0) ? 3 : 2;
    LDS_BARRIER();
    for (int i = tid; i < (6 * 8448) / 4; i += 512) ((LAS unsigned*)(L + O_CT))[i] = 0u;
    { const int i = tid; ((LAS unsigned*)(L + O_VS1))[i] = ((i & 7) == 0) ? 0x00003F80u : 0u; ((LAS unsigned*)(L + O_VW1))[i] = 0u; }
    f32x4 Cst[2][3];
#pragma unroll
    for (int a = 0; a < 2; ++a)
#pragma unroll
        for (int b = 0; b < 3; ++b) Cst[a][b] = (f32x4){0.f, 0.f, 0.f, 0.f};
    float m_prev = 0.f;
    const __amdgpu_buffer_rsrc_t rK = __builtin_amdgcn_make_buffer_rsrc((void*)(KM + h * 256), 0, T_SEQ * 4096, 0x00020000), rQ = __builtin_amdgcn_make_buffer_rsrc((void*)(QM + h * 256), 0, T_SEQ * 4096, 0x00020000),
                                 rV = __builtin_amdgcn_make_buffer_rsrc((void*)(P + PC_V + h * 512 + c0), 0, (int)((size_t)T_SEQ * NP * 2 - (size_t)(PC_V + h * 512 + c0) * 2), 0x00020000),
                                 rS = __builtin_amdgcn_make_buffer_rsrc((void*)(SP + (size_t)h * 128 * 4096), 0, 128 * 8192, 0x00020000),
                                 rH = __builtin_amdgcn_make_buffer_rsrc((void*)(HNUM + h * 512 + c0), 0, T_SEQ * 16384, 0x00020000), rD = __builtin_amdgcn_make_buffer_rsrc((void*)(DEN + h), 0, T_SEQ * 32, 0x00020000);
    const unsigned voffk = (unsigned)((tid >> 5) * 4096 + (tid & 31) * 16), voffv = (unsigned)((tid >> 2) * (NP * 2) + (tid & 3) * 16);
    const unsigned voffq = (unsigned)((j0 + r16) * 4096 + (sp_ * 128 + quad * 8) * 2), voffs = (unsigned)((j0 + r16) * 128 + quad * 16);
    const unsigned hoff = (unsigned)(((j0 + quad * 4) * 4096 + r16) * 4), doff = (unsigned)((j0 + quad * 4) * 32);
    const float* ga = GAb + (size_t)h * T_SEQ; const float* gb = GBb + (size_t)h * T_SEQ; const float* gc = GCb + (size_t)h * T_SEQ;
    const int vrow = (tid < 256) ? (tid >> 2) : ((tid - 256) & 63);
    v4u pk[4], pv = (v4u){0u, 0u, 0u, 0u}; bf16x8 pq[4], ps[2]; f32x4 pcm = (f32x4){0.f, 0.f, 0.f, 0.f}, pb = pcm; float pa = 0.f, pg = 0.f, pamax = 0.f;
    ps[0] = (bf16x8){0, 0, 0, 0, 0, 0, 0, 0}; ps[1] = ps[0];
#define P8V3_FETCH(T1) do { \
        _Pragma("unroll") for (int i = 0; i < 4; ++i) pk[i] = __builtin_bit_cast(v4u, __builtin_amdgcn_raw_buffer_load_b128(rK, voffk, (T1) * 4096 + i * 65536, 0)); \
        if (tid < 256) pv = __builtin_bit_cast(v4u, __builtin_amdgcn_raw_buffer_load_b128(rV, voffv, (T1) * (NP * 2), 0)); \
        _Pragma("unroll") for (int k4 = 0; k4 < 4; ++k4) pq[k4] = __builtin_bit_cast(bf16x8, __builtin_amdgcn_raw_buffer_load_b128(rQ, voffq, (T1) * 4096 + k4 * 64, 0)); \
        if (w < 4) { _Pragma("unroll") for (int kk = 0; kk < 2; ++kk) ps[kk] = __builtin_bit_cast(bf16x8, __builtin_amdgcn_raw_buffer_load_b128(rS, voffs, ((T1) >> 6) * 8192 + kk * 64, 0)); \
            pcm = *(const f32x4*)(gc + (T1) + j0 + quad * 4); pb = *(const f32x4*)(gb + (T1) + j0 + quad * 4); } \
        pa = ga[(T1) + vrow]; pg = gb[(T1) + 63]; pamax = gc[(T1) + 63]; } while (0)
    P8V3_FETCH(0);
    for (int ch = 0; ch < T_SEQ / 64; ++ch) {
        const int t0 = ch * 64, cur = ch & 1, nxt = cur ^ 1;
        const float M63 = fmaxf(m_prev, pamax), decay = __expf(m_prev - M63), wg = __expf(pa - M63);
        float rj[4], inj[4], enj[4];
#pragma unroll
        for (int i = 0; i < 4; ++i) { rj[i] = 1.f; inj[i] = 1.f; enj[i] = 1.f; }
        if (w < 4) {
#pragma unroll
            for (int i = 0; i < 4; ++i) { const float Mj = fmaxf(m_prev, pcm[i]); rj[i] = __expf(pcm[i] - Mj); inj[i] = __expf(m_prev - Mj); if (nt == 3) enj[i] = __expf(-(pb[i] + Mj)); } }
        m_prev = pg + M63;
#pragma unroll
        for (int i = 0; i < 4; ++i) { const int e = tid + 512 * i, rr = e >> 5, cc = e & 31; *(LAS v4u*)(L + O_KS + rr * QRS + cc * 16) = pk[i]; }
        if (tid < 256) { *(LAS v4u*)(L + O_VS + cur * 4096 + (tid >> 2) * 64 + (tid & 3) * 16) = pv; f32x4 x0, x1; pg8::unpack8(pv, x0, x1); *(LAS v4u*)(L + O_VW + (tid >> 2) * 64 + (tid & 3) * 16) = pg8::pack8(x0 * wg, x1 * wg); }
        else if (nt == 3 && tid < 320) *(LAS unsigned short*)(L + O_VW1 + (tid - 256) * 32) = (unsigned short)(cvt_pk_bf16(wg, 0.f) & 0xffffu);
        bf16x8 aq[4], as2[2];
#pragma unroll
        for (int k4 = 0; k4 < 4; ++k4) aq[k4] = pq[k4];
        as2[0] = ps[0]; as2[1] = ps[1];
        LDS_BARRIER();
        if (ch + 1 < T_SEQ / 64) P8V3_FETCH(t0 + 64);
        f32x4 hq[3];
        hq[0] = (f32x4){0.f, 0.f, 0.f, 0.f}; hq[1] = hq[0]; hq[2] = hq[0];
#pragma unroll
        for (int n = 0; n < 3; ++n) { if (n < nt) { bf16x8 bc[4];
#pragma unroll
            for (int k4 = 0; k4 < 4; ++k4) bc[k4] = *(const LAS bf16x8*)(L + O_CT + (cur * 3 + n) * 8448 + r16 * QRS + ((sp_ * 4 + k4) * 32 + quad * 8) * 2);
#pragma unroll
            for (int k4 = 0; k4 < 4; ++k4) hq[n] = __builtin_amdgcn_mfma_f32_16x16x32_bf16(aq[k4], bc[k4], hq[n], 0, 0, 0);
            if (sp_ == 1) *(LAS f32x4*)(L + O_HQX + cur * 12288 + ((jt * 3 + n) * 64 + l) * 16) = hq[n]; } }
        { bf16x8 ak[2][2];
#pragma unroll
          for (int dt = 0; dt < 2; ++dt)
#pragma unroll
              for (int kk = 0; kk < 2; ++kk) { const LAS unsigned char* p0 = L + O_KS + (kk * 32 + 8 * quad + (r16 >> 2)) * QRS + ((2 * w + dt) * 16 + 4 * (r16 & 3)) * 2; ak[dt][kk] = tr_pair(p0, p0 + 4 * QRS); }
#pragma unroll
          for (int n = 0; n < 3; ++n) { if (n < nt) { bf16x8 bvw[2];
#pragma unroll
              for (int kk = 0; kk < 2; ++kk) { const LAS unsigned char* p0 = (n == 2) ? (L + O_VW1 + (kk * 32 + 8 * quad + (r16 >> 2)) * 32 + (r16 & 3) * 8) : (L + O_VW + (kk * 32 + 8 * quad + (r16 >> 2)) * 64 + (n * 16 + 4 * (r16 & 3)) * 2);
                  bvw[kk] = tr_pair(p0, p0 + 4 * ((n == 2) ? 32 : 64)); }
#pragma unroll
              for (int dt = 0; dt < 2; ++dt) { const int d0 = (2 * w + dt) * 16;
                  f32x4 c = Cst[dt][n] * decay;
#pragma unroll
                  for (int kk = 0; kk < 2; ++kk) c = __builtin_amdgcn_mfma_f32_16x16x32_bf16(ak[dt][kk], bvw[kk], c, 0, 0, 0);
                  Cst[dt][n] = c;
                  v2u o; o.x = cvt_pk_bf16(c[0], c[1]); o.y = cvt_pk_bf16(c[2], c[3]);
                  *(LAS v2u*)(L + O_CT + (nxt * 3 + n) * 8448 + r16 * QRS + (d0 + quad * 4) * 2) = o; } } } }
        LDS_BARRIER();
        if (w < 4) {
#pragma unroll
            for (int n = 0; n < 3; ++n) { if (n < nt) {
                const f32x4 hx = *(const LAS f32x4*)(L + O_HQX + cur * 12288 + ((jt * 3 + n) * 64 + l) * 16);
                f32x4 x = (f32x4){0.f, 0.f, 0.f, 0.f};
#pragma unroll
                for (int kk = 0; kk < 2; ++kk) { const LAS unsigned char* p0 = (n == 2) ? (L + O_VS1 + (kk * 32 + 8 * quad + (r16 >> 2)) * 32 + (r16 & 3) * 8) : (L + O_VS + cur * 4096 + (kk * 32 + 8 * quad + (r16 >> 2)) * 64 + (n * 16 + 4 * (r16 & 3)) * 2);
                    x = __builtin_amdgcn_mfma_f32_16x16x32_bf16(as2[kk], tr_pair(p0, p0 + 4 * ((n == 2) ? 32 : 64)), x, 0, 0, 0); }
#pragma unroll
                for (int i = 0; i < 4; ++i) x[i] = x[i] * rj[i] + inj[i] * (hq[n][i] + hx[i]);
                if (n < 2) {
#pragma unroll
                    for (int i = 0; i < 4; ++i) __builtin_amdgcn_raw_buffer_store_b32(__float_as_uint(x[i]), rH, hoff, (t0 + i) * 16384 + n * 64, 0); }
                else if (r16 == 0) {
#pragma unroll
                    for (int i = 0; i < 4; ++i) __builtin_amdgcn_raw_buffer_store_b32(__float_as_uint(fmaxf(fabsf(x[i]), enj[i])), rD, doff, (t0 + i) * 32, 0); } } }
        }
    }
#undef P8V3_FETCH
    LDS_BARRIER();
}
__device__ __forceinline__ void phase8_v4(Frame& F, int blk) {
    const bf16* QM = (const bf16*)(F.ws + WS_QM); const bf16* KM = (const bf16*)(F.ws + WS_KM); const bf16* P = (const bf16*)(F.ws + WS_P); const bf16* SP = (const bf16*)(F.ws + WS_SP);
    const float* GAb = (const float*)(F.ws + WS_GATES); const float* GBb = GAb + 8 * T_SEQ; const float* GCb = GBb + 8 * T_SEQ;
    float* HNUM = (float*)(F.ws + WS_HNUM); float* DEN = (float*)(F.ws + WS_DEN);
    constexpr int QRS = 528, VRS = 144, NTM = 5;
    constexpr int O_KS = 0, O_VS = 33792  , O_VW = O_VS + 2 * 64 * VRS, O_VS1 = O_VW + 64 * VRS  , O_VW1 = O_VS1 + 2048  , O_CT = O_VW1 + 2048  , O_HQX = O_CT + NTM * 8448  ;
    static_assert(O_HQX + 4 * NTM * 1024 <= RING_BYTES, "mLSTM v4 LDS map");
    LAS unsigned char* L = F.lds;
    const int tid = F.tid, w = F.wave, l = F.lane, quad = l >> 4, r16 = l & 15;
    const int jt = w & 3, sp_ = w >> 2, j0 = jt * 16;
    const int h = blk >> 3, c0 = (blk & 7) * 64; const int nt = (c0 == 0) ? 5 : 4;
    LDS_BARRIER();
    for (int i = tid; i < (NTM * 8448) / 4; i += 512) ((LAS unsigned*)(L + O_CT))[i] = 0u;
    { const int i = tid; ((LAS unsigned*)(L + O_VS1))[i] = ((i & 7) == 0) ? 0x00003F80u : 0u; ((LAS unsigned*)(L + O_VW1))[i] = 0u; }
    f32x4 Cst[2][NTM];
#pragma unroll
    for (int a = 0; a < 2; ++a)
#pragma unroll
        for (int b = 0; b < NTM; ++b) Cst[a][b] = (f32x4){0.f, 0.f, 0.f, 0.f};
    float m_prev = 0.f;
    const __amdgpu_buffer_rsrc_t rK = __builtin_amdgcn_make_buffer_rsrc((void*)(KM + h * 256), 0, T_SEQ * 4096, 0x00020000), rQ = __builtin_amdgcn_make_buffer_rsrc((void*)(QM + h * 256), 0, T_SEQ * 4096, 0x00020000),
                                 rV = __builtin_amdgcn_make_buffer_rsrc((void*)(P + PC_V + h * 512 + c0), 0, (int)((size_t)T_SEQ * NP * 2 - (size_t)(PC_V + h * 512 + c0) * 2), 0x00020000),
                                 rS = __builtin_amdgcn_make_buffer_rsrc((void*)(SP + (size_t)h * 128 * 4096), 0, 128 * 8192, 0x00020000),
                                 rH = __builtin_amdgcn_make_buffer_rsrc((void*)(HNUM + h * 512 + c0), 0, T_SEQ * 16384, 0x00020000), rD = __builtin_amdgcn_make_buffer_rsrc((void*)(DEN + h), 0, T_SEQ * 32, 0x00020000);
    const unsigned voffk = (unsigned)((tid >> 5) * 4096 + (tid & 31) * 16), voffv = (unsigned)((tid >> 3) * (NP * 2) + (tid & 7) * 16);
    const unsigned voffq = (unsigned)((j0 + r16) * 4096 + (sp_ * 128 + quad * 8) * 2), voffs = (unsigned)((j0 + r16) * 128 + quad * 16);
    const unsigned hoff = (unsigned)(((j0 + quad * 4) * 4096 + r16) * 4), doff = (unsigned)((j0 + quad * 4) * 32);
    const float* ga = GAb + (size_t)h * T_SEQ; const float* gb = GBb + (size_t)h * T_SEQ; const float* gc = GCb + (size_t)h * T_SEQ;
    const int vrow = tid >> 3;
    const unsigned lvs = (unsigned)((tid >> 3) * VRS + (tid & 7) * 16);
    v4u pk[4], pv; bf16x8 pq[4], ps[2]; f32x4 pcm, pb; float pa = 0.f, pg = 0.f, pamax = 0.f;
#define P8V4_FETCH(T1) do { \
        _Pragma("unroll") for (int i = 0; i < 4; ++i) pk[i] = __builtin_bit_cast(v4u, __builtin_amdgcn_raw_buffer_load_b128(rK, voffk, (T1) * 4096 + i * 65536, 0)); \
        pv = __builtin_bit_cast(v4u, __builtin_amdgcn_raw_buffer_load_b128(rV, voffv, (T1) * (NP * 2), 0)); \
        _Pragma("unroll") for (int k4 = 0; k4 < 4; ++k4) pq[k4] = __builtin_bit_cast(bf16x8, __builtin_amdgcn_raw_buffer_load_b128(rQ, voffq, (T1) * 4096 + k4 * 64, 0)); \
        _Pragma("unroll") for (int kk = 0; kk < 2; ++kk) ps[kk] = __builtin_bit_cast(bf16x8, __builtin_amdgcn_raw_buffer_load_b128(rS, voffs, ((T1) >> 6) * 8192 + kk * 64, 0)); \
        pcm = *(const f32x4*)(gc + (T1) + j0 + quad * 4); pb = *(const f32x4*)(gb + (T1) + j0 + quad * 4); \
        pa = ga[(T1) + vrow]; pg = gb[(T1) + 63]; pamax = gc[(T1) + 63]; } while (0)
#define P8V4_MINE(n) (((n) == 4) ? (sp_ == 0) : (((n) >> 1) == sp_))
    P8V4_FETCH(0);
    for (int ch = 0; ch < T_SEQ / 64; ++ch) {
        const int t0 = ch * 64, cur = ch & 1;
        const float M63 = fmaxf(m_prev, pamax), decay = __expf(m_prev - M63), wg = __expf(pa - M63);
        float rj[4], inj[4], enj[4];
#pragma unroll
        for (int i = 0; i < 4; ++i) { const float Mj = fmaxf(m_prev, pcm[i]); rj[i] = __expf(pcm[i] - Mj); inj[i] = __expf(m_prev - Mj); enj[i] = (nt == 5 && sp_ == 0) ? __expf(-(pb[i] + Mj)) : 1.f; }
        m_prev = pg + M63;
#pragma unroll
        for (int i = 0; i < 4; ++i) { const int e = tid + 512 * i, rr = e >> 5, cc = e & 31; *(LAS v4u*)(L + O_KS + rr * QRS + cc * 16) = pk[i]; }
        { *(LAS v4u*)(L + O_VS + cur * (64 * VRS) + lvs) = pv; f32x4 x0, x1; pg8::unpack8(pv, x0, x1); *(LAS v4u*)(L + O_VW + lvs) = pg8::pack8(x0 * wg, x1 * wg); }
        if (nt == 5 && (tid & 7) == 0) *(LAS unsigned short*)(L + O_VW1 + (tid >> 3) * 32) = (unsigned short)(cvt_pk_bf16(wg, 0.f) & 0xffffu);
        bf16x8 aq[4], as2[2];
#pragma unroll
        for (int k4 = 0; k4 < 4; ++k4) aq[k4] = pq[k4];
        as2[0] = ps[0]; as2[1] = ps[1];
        if (ch + 1 < T_SEQ / 64) P8V4_FETCH(t0 + 64);
        LDS_BARRIER();
        f32x4 hq[NTM];
#pragma unroll
        for (int n = 0; n < NTM; ++n) hq[n] = (f32x4){0.f, 0.f, 0.f, 0.f};
#pragma unroll
        for (int n = 0; n < NTM; ++n) { if (n < nt) { bf16x8 bc[4];
#pragma unroll
            for (int k4 = 0; k4 < 4; ++k4) bc[k4] = *(const LAS bf16x8*)(L + O_CT + n * 8448 + r16 * QRS + ((sp_ * 4 + k4) * 32 + quad * 8) * 2);
#pragma unroll
            for (int k4 = 0; k4 < 4; ++k4) hq[n] = __builtin_amdgcn_mfma_f32_16x16x32_bf16(aq[k4], bc[k4], hq[n], 0, 0, 0);
            if (!P8V4_MINE(n)) *(LAS f32x4*)(L + O_HQX + ((jt * NTM + n) * 64 + l) * 16) = hq[n]; } }
        { bf16x8 ak[2][2];
#pragma unroll
          for (int dt = 0; dt < 2; ++dt)
#pragma unroll
              for (int kk = 0; kk < 2; ++kk) { const LAS unsigned char* p0 = L + O_KS + (kk * 32 + 8 * quad + (r16 >> 2)) * QRS + ((2 * w + dt) * 16 + 4 * (r16 & 3)) * 2; ak[dt][kk] = tr_pair(p0, p0 + 4 * QRS); }
#pragma unroll
          for (int n = 0; n < NTM; ++n) { if (n < nt) { bf16x8 bvw[2];
#pragma unroll
              for (int kk = 0; kk < 2; ++kk) { const LAS unsigned char* p0 = (n == 4) ? (L + O_VW1 + (kk * 32 + 8 * quad + (r16 >> 2)) * 32 + (r16 & 3) * 8) : (L + O_VW + (kk * 32 + 8 * quad + (r16 >> 2)) * VRS + (n * 16 + 4 * (r16 & 3)) * 2);
                  bvw[kk] = tr_pair(p0, p0 + 4 * ((n == 4) ? 32 : VRS)); }
#pragma unroll
              for (int dt = 0; dt < 2; ++dt) { f32x4 c = Cst[dt][n] * decay;
#pragma unroll
                  for (int kk = 0; kk < 2; ++kk) c = __builtin_amdgcn_mfma_f32_16x16x32_bf16(ak[dt][kk], bvw[kk], c, 0, 0, 0);
                  Cst[dt][n] = c; } } } }
        f32x4 xs[NTM];
#pragma unroll
        for (int n = 0; n < NTM; ++n) { xs[n] = (f32x4){0.f, 0.f, 0.f, 0.f}; if (n < nt && P8V4_MINE(n)) {
#pragma unroll
            for (int kk = 0; kk < 2; ++kk) { const LAS unsigned char* p0 = (n == 4) ? (L + O_VS1 + (kk * 32 + 8 * quad + (r16 >> 2)) * 32 + (r16 & 3) * 8) : (L + O_VS + cur * (64 * VRS) + (kk * 32 + 8 * quad + (r16 >> 2)) * VRS + (n * 16 + 4 * (r16 & 3)) * 2);
                xs[n] = __builtin_amdgcn_mfma_f32_16x16x32_bf16(as2[kk], tr_pair(p0, p0 + 4 * ((n == 4) ? 32 : VRS)), xs[n], 0, 0, 0); } } }
        LDS_BARRIER();
#pragma unroll
        for (int n = 0; n < NTM; ++n) { if (n < nt) {
#pragma unroll
            for (int dt = 0; dt < 2; ++dt) { const int d0 = (2 * w + dt) * 16; const f32x4 c = Cst[dt][n];
                v2u o; o.x = cvt_pk_bf16(c[0], c[1]); o.y = cvt_pk_bf16(c[2], c[3]);
                *(LAS v2u*)(L + O_CT + n * 8448 + r16 * QRS + (d0 + quad * 4) * 2) = o; } } }
#pragma unroll
        for (int n = 0; n < NTM; ++n) { if (n < nt && P8V4_MINE(n)) {
            const f32x4 hx = *(const LAS f32x4*)(L + O_HQX + ((jt * NTM + n) * 64 + l) * 16);
            f32x4 x = xs[n];
#pragma unroll
            for (int i = 0; i < 4; ++i) x[i] = x[i] * rj[i] + inj[i] * (hq[n][i] + hx[i]);
            if (n < 4) {
#pragma unroll
                for (int i = 0; i < 4; ++i) __builtin_amdgcn_raw_buffer_store_b32(__float_as_uint(x[i]), rH, hoff, (t0 + i) * 16384 + n * 64, 0); }
            else if (r16 == 0) {
#pragma unroll
                for (int i = 0; i < 4; ++i) __builtin_amdgcn_raw_buffer_store_b32(__float_as_uint(fmaxf(fabsf(x[i]), enj[i])), rD, doff, (t0 + i) * 32, 0); } } }
    }
#undef P8V4_FETCH
#undef P8V4_MINE
    LDS_BARRIER();
}
template <int VAR> __device__ __forceinline__ void phase5_fast(Frame& F) {
    const bf16* QA = (const bf16*)(F.ws + WS_QA); const bf16* KI = (const bf16*)(F.ws + WS_KI); const float* WI = (const float*)(F.ws + WS_WI); float* SC = (float*)(F.ws + (VAR ? WS_OLAT : WS_SC));
    constexpr int KRS = 144, KBUF = 128 * KRS;
    LAS unsigned char* L = F.lds;
    const int tid = F.tid, w = F.wave, lane = F.lane, r32 = lane & 31, hh = lane >> 5;
    const int pr0 = tid >> 3, pc0 = tid & 7;
    for (int pair = F.bid; pair < 256; pair += F.G) {
#pragma unroll 1
        for (int half = 0; half < 2; ++half) {
            const int ti = half ? (511 - pair) : pair, t0 = ti * 16;
            const int nkt = (t0 + 15) / 128 + 1;
            bf16x8 aq[2][4]; float wv[2][16];
#pragma unroll
            for (int q = 0; q < 2; ++q) { const int t = t0 + 2 * w + q;
#pragma unroll
                for (int ks = 0; ks < 4; ++ks) aq[q][ks] = *(const bf16x8*)(QA + (size_t)t * NQA + 16384 + r32 * 64 + ks * 16 + hh * 8);
#pragma unroll
                for (int i = 0; i < 16; ++i) wv[q][i] = WI[(size_t)t * 32 + (i & 3) + 8 * (i >> 2) + 4 * hh]; }
            LDS_BARRIER();
            { const v4u k0 = *(const v4u*)(KI + (size_t)pr0 * 64 + pc0 * 8), k1 = *(const v4u*)(KI + (size_t)(pr0 + 64) * 64 + pc0 * 8);
              *(LAS v4u*)(L + pr0 * KRS + pc0 * 16) = k0; *(LAS v4u*)(L + (pr0 + 64) * KRS + pc0 * 16) = k1; }
            LDS_BARRIER();
            v4u c0 = (v4u){0u, 0u, 0u, 0u}, c1 = c0;
            if (1 < nkt) { c0 = *(const v4u*)(KI + (size_t)(128 + pr0) * 64 + pc0 * 8); c1 = *(const v4u*)(KI + (size_t)(128 + pr0 + 64) * 64 + pc0 * 8); }
            for (int kt = 0; kt < nkt; ++kt) {
                const LAS unsigned char* kb_ = L + (kt & 1) * KBUF;
                v4u n0 = (v4u){0u, 0u, 0u, 0u}, n1 = n0;
                if (kt + 2 < nkt) { n0 = *(const v4u*)(KI + (size_t)((kt + 2) * 128 + pr0) * 64 + pc0 * 8); n1 = *(const v4u*)(KI + (size_t)((kt + 2) * 128 + pr0 + 64) * 64 + pc0 * 8); }
                if (kt * 128 + 127 <= t0 + 2 * w) {
#pragma unroll
                    for (int kp = 0; kp < 2; ++kp) {
                        bf16x8 bk[2][4];
#pragma unroll
                        for (int b2 = 0; b2 < 2; ++b2)
#pragma unroll
                            for (int ks = 0; ks < 4; ++ks) bk[b2][ks] = *(const LAS bf16x8*)(kb_ + ((kp * 2 + b2) * 32 + r32) * KRS + ks * 32 + hh * 16);
                        f32x16 acc[2][2];
#pragma unroll
                        for (int q = 0; q < 2; ++q)
#pragma unroll
                            for (int b2 = 0; b2 < 2; ++b2)
#pragma unroll
                                for (int i = 0; i < 16; ++i) acc[q][b2][i] = 0.f;
#pragma unroll
                        for (int ks = 0; ks < 4; ++ks)
#pragma unroll
                            for (int q = 0; q < 2; ++q)
#pragma unroll
                                for (int b2 = 0; b2 < 2; ++b2) { if (VAR == 4) {
                                    f32x4 t0 = (f32x4){acc[q][b2][0], acc[q][b2][1], acc[q][b2][2], acc[q][b2][3]}, t1 = (f32x4){acc[q][b2][4], acc[q][b2][5], acc[q][b2][6], acc[q][b2][7]};
                                    t0 = __builtin_amdgcn_mfma_f32_16x16x32_bf16(aq[q][ks], bk[b2][ks], t0, 0, 0, 0); t1 = __builtin_amdgcn_mfma_f32_16x16x32_bf16(aq[q][ks], bk[b2][ks], t1, 0, 0, 0);
                                    acc[q][b2][0] = t0[0]; acc[q][b2][1] = t0[1]; acc[q][b2][2] = t0[2]; acc[q][b2][3] = t0[3]; acc[q][b2][4] = t1[0]; acc[q][b2][5] = t1[1]; acc[q][b2][6] = t1[2]; acc[q][b2][7] = t1[3]; }
                                  else if (VAR != 2) acc[q][b2] = __builtin_amdgcn_mfma_f32_32x32x16_bf16(aq[q][ks], bk[b2][ks], acc[q][b2], 0, 0, 0); else acc[q][b2][ks] += __builtin_bit_cast(float, (int)bk[b2][ks][0]); }
#pragma unroll
                        for (int b2 = 0; b2 < 2; ++b2) { float sq[2];
#pragma unroll
                            for (int q = 0; q < 2; ++q) { float s = 0.f;
#pragma unroll
                                for (int i = 0; i < 16; ++i) { if (VAR != 1 || i == 0) s += wv[q][i] * __builtin_amdgcn_fmed3f(acc[q][b2][i], 0.f, __builtin_inff()); }
                                sq[q] = s; }
                            float a_ = sq[0], b_ = sq[1];
                            asm volatile("s_nop 1\n\tv_permlane32_swap_b32 %0, %1" : "+v"(a_), "+v"(b_));
                            const float tot = a_ + b_;
                            if (VAR != 3 || tot == 12345.f) SC[(size_t)(t0 + 2 * w + (lane >> 5)) * T_SEQ + kt * 128 + (kp * 2 + b2) * 32 + (lane & 31)] = tot; }
                    }
                } else {
#pragma unroll
                for (int kb4 = 0; kb4 < 4; ++kb4) {
                    const int key0 = kt * 128 + kb4 * 32;
                    if (key0 <= t0 + 2 * w + 1) {
                        bf16x8 bk[4];
#pragma unroll
                        for (int ks = 0; ks < 4; ++ks) bk[ks] = *(const LAS bf16x8*)(kb_ + (kb4 * 32 + r32) * KRS + ks * 32 + hh * 16);
#pragma unroll
                        for (int q = 0; q < 2; ++q) { const int t = t0 + 2 * w + q;
                            if (key0 <= t) {
                                f32x16 acc;
#pragma unroll
                                for (int i = 0; i < 16; ++i) acc[i] = 0.f;
#pragma unroll
                                for (int ks = 0; ks < 4; ++ks) acc = __builtin_amdgcn_mfma_f32_32x32x16_bf16(aq[q][ks], bk[ks], acc, 0, 0, 0);
                                float s = 0.f;
#pragma unroll
                                for (int i = 0; i < 16; ++i) s += wv[q][i] * __builtin_amdgcn_fmed3f(acc[i], 0.f, __builtin_inff());
                                s = xor32_allsum(s);
                                if (lane < 32) SC[(size_t)t * T_SEQ + key0 + lane] = s; } } } }
                }
                if (kt + 1 < nkt) { LAS unsigned char* nb = L + ((kt + 1) & 1) * KBUF; *(LAS v4u*)(nb + pr0 * KRS + pc0 * 16) = c0; *(LAS v4u*)(nb + (pr0 + 64) * KRS + pc0 * 16) = c1; }
                c0 = n0; c1 = n1;
                LDS_BARRIER();
            }
        }
    }
}
__device__ __forceinline__ float xor16_allsum(float v) {
    float a = v, b = v;
    asm volatile("s_nop 1\n\tv_permlane16_swap_b32 %0, %1" : "+v"(a), "+v"(b));
    return a + b;
}
struct IdxQ { bf16x8 a[2][2]; float w[8]; };
__device__ __forceinline__ void idx_load_q(IdxQ& q, const bf16* QA, const float* WI, int t, int quad, int r16) {
#pragma unroll
    for (int mt = 0; mt < 2; ++mt) {
#pragma unroll
        for (int ks = 0; ks < 2; ++ks) q.a[mt][ks] = *(const bf16x8*)(QA + (size_t)t * NQA + 16384 + (mt * 16 + r16) * 64 + ks * 32 + quad * 8);
        const f32x4 w4 = *(const f32x4*)(WI + (size_t)t * 32 + mt * 16 + quad * 4);
        q.w[mt * 4] = w4[0]; q.w[mt * 4 + 1] = w4[1]; q.w[mt * 4 + 2] = w4[2]; q.w[mt * 4 + 3] = w4[3]; }
}
__device__ __forceinline__ float idx_unit(const IdxQ& q, const bf16x8 (&bk)[2][2], int quad) {
    f32x4 acc[2][2];
#pragma unroll
    for (int mt = 0; mt < 2; ++mt)
#pragma unroll
        for (int n2 = 0; n2 < 2; ++n2) { acc[mt][n2] = __builtin_amdgcn_mfma_f32_16x16x32_bf16(q.a[mt][0], bk[n2][0], (f32x4){0.f, 0.f, 0.f, 0.f}, 0, 0, 0);
            acc[mt][n2] = __builtin_amdgcn_mfma_f32_16x16x32_bf16(q.a[mt][1], bk[n2][1], acc[mt][n2], 0, 0, 0); }
    float s[2];
#pragma unroll
    for (int n2 = 0; n2 < 2; ++n2) { float x = 0.f;
#pragma unroll
        for (int mt = 0; mt < 2; ++mt)
#pragma unroll
            for (int i = 0; i < 4; ++i) x += q.w[mt * 4 + i] * __builtin_amdgcn_fmed3f(acc[mt][n2][i], 0.f, __builtin_inff());
        s[n2] = x; }
    const float s0 = xor32_allsum(xor16_allsum(s[0])), s1 = xor32_allsum(xor16_allsum(s[1]));
    return (quad & 1) ? s1 : s0;
}
template <int VAR> __device__ __forceinline__ void phase5_v2(Frame& F) {
    const bf16* QA = (const bf16*)(F.ws + WS_QA); const bf16* KI = (const bf16*)(F.ws + WS_KI); const float* WI = (const float*)(F.ws + WS_WI); float* SC = (float*)(F.ws + (VAR ? WS_OLAT : WS_SC));
    constexpr int KRS = 144, KBUF = 128 * KRS;
    LAS unsigned char* L = F.lds;
    const int tid = F.tid, w = F.wave, lane = F.lane, quad = lane >> 4, r16 = lane & 15;
    const int pr0 = tid >> 3, pc0 = tid & 7;
    for (int pair = F.bid; pair < 256; pair += F.G) {
#pragma unroll 1
        for (int half = 0; half < 2; ++half) {
            const int ti = half ? (511 - pair) : pair, t0 = ti * 16;
            const int nkt = (t0 + 15) / 128 + 1;
            IdxQ q0, q1;
            idx_load_q(q0, QA, WI, t0 + 2 * w, quad, r16); idx_load_q(q1, QA, WI, t0 + 2 * w + 1, quad, r16);
            LDS_BARRIER();
            { const v4u k0 = *(const v4u*)(KI + (size_t)pr0 * 64 + pc0 * 8), k1 = *(const v4u*)(KI + (size_t)(pr0 + 64) * 64 + pc0 * 8);
              *(LAS v4u*)(L + pr0 * KRS + pc0 * 16) = k0; *(LAS v4u*)(L + (pr0 + 64) * KRS + pc0 * 16) = k1; }
            LDS_BARRIER();
            v4u c0 = (v4u){0u, 0u, 0u, 0u}, c1 = c0;
            if (1 < nkt) { c0 = *(const v4u*)(KI + (size_t)(128 + pr0) * 64 + pc0 * 8); c1 = *(const v4u*)(KI + (size_t)(128 + pr0 + 64) * 64 + pc0 * 8); }
            for (int kt = 0; kt < nkt; ++kt) {
                const LAS unsigned char* kb_ = L + (kt & 1) * KBUF;
                v4u n0 = (v4u){0u, 0u, 0u, 0u}, n1 = n0;
                if (kt + 2 < nkt) { n0 = *(const v4u*)(KI + (size_t)((kt + 2) * 128 + pr0) * 64 + pc0 * 8); n1 = *(const v4u*)(KI + (size_t)((kt + 2) * 128 + pr0 + 64) * 64 + pc0 * 8); }
                const bool full = (kt * 128 + 127 <= t0 + 2 * w);
#pragma unroll
                for (int kb4 = 0; kb4 < 4; ++kb4) {
                    const int key0 = kt * 128 + kb4 * 32;
                    if (full || key0 <= t0 + 2 * w + 1) {
                        bf16x8 bk[2][2];
#pragma unroll
                        for (int n2 = 0; n2 < 2; ++n2)
#pragma unroll
                            for (int ks = 0; ks < 2; ++ks) bk[n2][ks] = *(const LAS bf16x8*)(kb_ + (kb4 * 32 + n2 * 16 + r16) * KRS + ks * 64 + quad * 16);
                        if (full || key0 <= t0 + 2 * w) { const float s = idx_unit(q0, bk, quad); if (lane < 32) SC[(size_t)(t0 + 2 * w) * T_SEQ + key0 + lane] = s; }
                        { const float s = idx_unit(q1, bk, quad); if (lane < 32) SC[(size_t)(t0 + 2 * w + 1) * T_SEQ + key0 + lane] = s; }
                    }
                }
                if (kt + 1 < nkt) { LAS unsigned char* nb = L + ((kt + 1) & 1) * KBUF; *(LAS v4u*)(nb + pr0 * KRS + pc0 * 16) = c0; *(LAS v4u*)(nb + (pr0 + 64) * KRS + pc0 * 16) = c1; }
                c0 = n0; c1 = n1;
                LDS_BARRIER();
            }
        }
    }
}
template <int NB>
__device__ __forceinline__ unsigned p6_find_bin(const LAS unsigned* hist, unsigned& kth, unsigned& cnt, int lane) {
    unsigned hb[NB]; unsigned tot = 0u;
#pragma unroll
    for (int q = 0; q < NB / 4; ++q) { const v4u h4 = *(const LAS v4u*)(hist + lane * NB + q * 4); hb[q * 4] = h4.x; hb[q * 4 + 1] = h4.y; hb[q * 4 + 2] = h4.z; hb[q * 4 + 3] = h4.w; tot += h4.x + h4.y + h4.z + h4.w; }
    const unsigned inc_ = wave_scan_add_u32(tot);
    unsigned above = lane63_u32(inc_) - inc_;
    unsigned fbin = 0u, fk = 0u, fc = 0u; bool found = false;
#pragma unroll
    for (int b = NB - 1; b >= 0; --b) { if (!found && above < kth && kth <= above + hb[b]) { found = true; fbin = (unsigned)(lane * NB + b); fk = kth - above; fc = hb[b]; } above += hb[b]; }
    const unsigned long long fm = __ballot(found); const int src = (int)__ffsll((long long)fm) - 1;
    kth = (unsigned)__builtin_amdgcn_readlane((int)fk, src); cnt = (unsigned)__builtin_amdgcn_readlane((int)fc, src);
    return (unsigned)__builtin_amdgcn_readlane((int)fbin, src);
}
__device__ __forceinline__ void phase6a_select(Frame& F) {
    const float* SC = (const float*)(F.ws + WS_SC); int* IDX = (int*)(F.ws + WS_IDX); int* CNT = (int*)(F.ws + WS_CNT);
    LAS unsigned* hist = (LAS unsigned*)(F.lds + F.wave * 16384);
    LAS unsigned* cand = hist + 2048;
    constexpr unsigned CAP = 2048u;
    const int gw = F.bid * NWAVES + F.wave, NGW = F.G * NWAVES, lane = F.lane;
    const unsigned long long lt_mask = (1ull << lane) - 1ull;
    for (int qi = gw; qi < T_SEQ; qi += NGW) {
        const int grp = qi / NGW, jj = qi % NGW; int t;
        if (NGW * 4 == T_SEQ) t = (grp == 0) ? jj : (grp == 1) ? (T_SEQ / 2 - 1 - jj) : (grp == 2) ? (T_SEQ / 2 + jj) : (T_SEQ - 1 - jj); else t = qi;
        const int n = t + 1; int* out = IDX + (size_t)t * TOPK;
        if (lane == 0) CNT[t] = n < TOPK ? n : TOPK;
        if (n <= TOPK) {
#pragma unroll
            for (int e = 0; e < 4; ++e) { const int i = lane + 64 * e; out[i] = i < n ? i : 0; }
            continue;
        }
        const float* row = SC + (size_t)t * T_SEQ;
        unsigned kth = TOPK, cnt1 = 0u, cnt2 = 0u;
#pragma unroll
        for (int q = 0; q < 8; ++q) *(LAS v4u*)(hist + q * 256 + lane * 4) = (v4u){0u, 0u, 0u, 0u};
        f32x4 vn[4];
#pragma unroll
        for (int u = 0; u < 4; ++u) vn[u] = *(const f32x4*)(row + u * 256 + lane * 4);
        for (int base = 0; base < n; base += 1024) {
            f32x4 v[4];
#pragma unroll
            for (int u = 0; u < 4; ++u) v[u] = vn[u];
            if (base + 1024 < n) {
#pragma unroll
                for (int u = 0; u < 4; ++u) vn[u] = *(const f32x4*)(row + base + 1024 + u * 256 + lane * 4); }
#pragma unroll
            for (int u = 0; u < 4; ++u)
#pragma unroll
                for (int e = 0; e < 4; ++e) { const unsigned k = f2key(v[u][e]); if (base + u * 256 + lane * 4 + e < n) __hip_atomic_fetch_add(&hist[k >> 21], 1u, __ATOMIC_RELAXED, __HIP_MEMORY_SCOPE_WORKGROUP); }
        }
        const unsigned bin1 = p6_find_bin<32>(hist, kth, cnt1, lane);
#pragma unroll
        for (int q = 0; q < 8; ++q) *(LAS v4u*)(hist + q * 256 + lane * 4) = (v4u){0u, 0u, 0u, 0u};
        const bool fits = cnt1 <= CAP; unsigned nc = 0u;
#pragma unroll
        for (int u = 0; u < 4; ++u) vn[u] = *(const f32x4*)(row + u * 256 + lane * 4);
        for (int base = 0; base < n; base += 1024) {
            f32x4 v[4];
#pragma unroll
            for (int u = 0; u < 4; ++u) v[u] = vn[u];
            if (base + 1024 < n) {
#pragma unroll
                for (int u = 0; u < 4; ++u) vn[u] = *(const f32x4*)(row + base + 1024 + u * 256 + lane * 4); }
#pragma unroll
            for (int u = 0; u < 4; ++u)
#pragma unroll
                for (int e = 0; e < 4; ++e) { const unsigned k = f2key(v[u][e]); const bool m = (base + u * 256 + lane * 4 + e < n) && (k >> 21) == bin1;
                    if (m) __hip_atomic_fetch_add(&hist[(k >> 10) & 2047u], 1u, __ATOMIC_RELAXED, __HIP_MEMORY_SCOPE_WORKGROUP);
                    const unsigned long long mm = __ballot(m);
                    if (fits) { if (m) cand[nc + (unsigned)__popcll(mm & lt_mask)] = k; }
                    nc += (unsigned)__popcll(mm); }
        }
        const unsigned bin2 = p6_find_bin<32>(hist, kth, cnt2, lane);
        const unsigned pre22 = (bin1 << 11) | bin2;
#pragma unroll
        for (int q = 0; q < 4; ++q) *(LAS v4u*)(hist + q * 256 + lane * 4) = (v4u){0u, 0u, 0u, 0u};
        if (fits) { for (unsigned i = (unsigned)lane; i < cnt1; i += 64u) { const unsigned k = cand[i]; if ((k >> 10) == pre22) __hip_atomic_fetch_add(&hist[k & 1023u], 1u, __ATOMIC_RELAXED, __HIP_MEMORY_SCOPE_WORKGROUP); } }
        else { for (int i = lane; i < n; i += 64) { const unsigned k = f2key(row[i]); if ((k >> 10) == pre22) __hip_atomic_fetch_add(&hist[k & 1023u], 1u, __ATOMIC_RELAXED, __HIP_MEMORY_SCOPE_WORKGROUP); } }
        unsigned cnt3 = 0u;
        const unsigned bin3 = p6_find_bin<16>(hist, kth, cnt3, lane);
        const unsigned prefix = (pre22 << 10) | bin3;
        unsigned run = 0u, ties = 0u;
#pragma unroll
        for (int u = 0; u < 4; ++u) vn[u] = *(const f32x4*)(row + u * 256 + lane * 4);
        for (int base = 0; base < n; base += 1024) {
            f32x4 v[4];
#pragma unroll
            for (int u = 0; u < 4; ++u) v[u] = vn[u];
            if (base + 1024 < n) {
#pragma unroll
                for (int u = 0; u < 4; ++u) vn[u] = *(const f32x4*)(row + base + 1024 + u * 256 + lane * 4); }
#pragma unroll
            for (int u = 0; u < 4; ++u) {
                unsigned gtm = 0u, eqm = 0u;
#pragma unroll
                for (int e = 0; e < 4; ++e) { const unsigned k = f2key(v[u][e]); const bool in = base + u * 256 + lane * 4 + e < n; if (in && k > prefix) gtm |= 1u << e; if (in && k == prefix) eqm |= 1u << e; }
                const unsigned ce = (unsigned)__popc(eqm); unsigned selm = gtm;
                if (__ballot(ce != 0u)) {
                    const unsigned inc = wave_scan_add_u32(ce);
                    unsigned rk = ties + inc - ce;
#pragma unroll
                    for (int e = 0; e < 4; ++e) { if ((eqm >> e) & 1u) { if (rk < kth) selm |= 1u << e; ++rk; } }
                    ties += lane63_u32(inc);
                }
                const unsigned cs = (unsigned)__popc(selm); const unsigned inc2 = wave_scan_add_u32(cs);
                unsigned pos = run + inc2 - cs;
#pragma unroll
                for (int e = 0; e < 4; ++e) { if ((selm >> e) & 1u) { if (pos < (unsigned)TOPK) out[pos] = base + u * 256 + lane * 4 + e; ++pos; } }
                run += lane63_u32(inc2);
            }
        }
    }
}

__device__ __forceinline__ float p6_swap_max32(float v) { float a = v, b = v; asm volatile("s_nop 1\n\tv_permlane32_swap_b32 %0, %1\n\ts_nop 1" : "+v"(a), "+v"(b)); return fmaxf(a, b); }
__device__ __forceinline__ float p6_swap_max16(float v) { float a = v, b = v; asm volatile("s_nop 1\n\tv_permlane16_swap_b32 %0, %1\n\ts_nop 1" : "+v"(a), "+v"(b)); return fmaxf(a, b); }
__device__ __forceinline__ float p6_swap_sum32(float v) { float a = v, b = v; asm volatile("s_nop 1\n\tv_permlane32_swap_b32 %0, %1\n\ts_nop 1" : "+v"(a), "+v"(b)); return a + b; }
__device__ __forceinline__ float p6_swap_sum16(float v) { float a = v, b = v; asm volatile("s_nop 1\n\tv_permlane16_swap_b32 %0, %1\n\ts_nop 1" : "+v"(a), "+v"(b)); return a + b; }
__device__ __forceinline__ int p6_query_of(int qn, int G, int bid) { const int rnd = qn / G; return (rnd & 1) ? (T_SEQ - 1 - (rnd >> 1) * G - bid) : ((rnd >> 1) * G + bid); }
template <int VAR> __device__ __forceinline__ void phase6b_attn(Frame& F, int kstart, int kcount, int kstride, int extra = -1) {
    const bf16* QA = (const bf16*)(F.ws + WS_QA); const bf16* CKV = (const bf16*)(F.ws + WS_CKV); const int* IDX = (const int*)(F.ws + WS_IDX); const int* CNT = (const int*)(F.ws + WS_CNT); bf16* OLAT = (bf16*)(F.ws + (VAR ? WS_SC : WS_OLAT));
    constexpr int KRS = 1040, PRS = 144;
    constexpr int O_KV = 0, O_IDX = 66560, O_DIST = 68608, O_AL = 70656, O_LINV = 70784, O_P = 70912, O_EX = 75520, O_OT = 70912;
    LAS unsigned char* L = F.lds;
    LAS float* lal = (LAS float*)(L + O_AL); LAS float* linv = (LAS float*)(L + O_LINV);
    const int tid = F.tid, w = F.wave, l = F.lane, quad = l >> 4, r16 = l & 15, r32 = l & 31, hh = l >> 5;
    const int mt = w & 1, kq = w >> 1;
    const float slope = exp2f(-0.25f * (float)(mt * 16 + r16 + 1));
    const int ktotal = kcount + (extra >= 0 ? 1 : 0);
    if (ktotal <= 0) return;
    const __amdgpu_buffer_rsrc_t rKV = __builtin_amdgcn_make_buffer_rsrc((void*)CKV, 0, T_SEQ * 1024, 0x00020000);
    int t = T_SEQ - 1 - ((kcount > 0) ? kstart : extra); int cnt = CNT[t];
    LDS_BARRIER();
    if (tid < 256) { const int id = IDX[(size_t)t * TOPK + tid]; ((LAS int*)(L + O_IDX))[tid] = id; ((LAS float*)(L + O_DIST))[tid] = (float)(t - id); }
    bf16x8 aq[4];
#pragma unroll
    for (int ks = 0; ks < 4; ++ks) aq[ks] = *(const bf16x8*)(QA + (size_t)t * NQA + (mt * 16 + r16) * 512 + kq * 128 + ks * 32 + quad * 8);
    LDS_BARRIER();
    v4u st[8];
#pragma unroll
    for (int j = 0; j < 8; ++j) { const int id = ((LAS int*)(L + O_IDX))[w * 8 + j]; st[j] = __builtin_bit_cast(v4u, __builtin_amdgcn_raw_buffer_load_b128(rKV, (unsigned)(l * 16), __builtin_amdgcn_readfirstlane(id) * 1024, 0)); }
    int buf = 0;
    for (int qi = 0; qi < ktotal; ++qi) {
        const int nch = (cnt + 63) >> 6;
        LAS int* lidx = (LAS int*)(L + O_IDX + buf * 1024); LAS float* ldist = (LAS float*)(L + O_DIST + buf * 1024);
        LAS int* nidx = (LAS int*)(L + O_IDX + (buf ^ 1) * 1024); LAS float* ndist = (LAS float*)(L + O_DIST + (buf ^ 1) * 1024);
        const bool has_next = qi + 1 < ktotal; const int tn = has_next ? (T_SEQ - 1 - ((qi + 1 < kcount) ? (kstart + (qi + 1) * kstride) : extra)) : t;
        int cnt_n = cnt, nid = 0;
        if (has_next) { cnt_n = CNT[tn]; if (tid < 256) nid = IDX[(size_t)tn * TOPK + tid]; }
        f32x16 oacc[2];
#pragma unroll
        for (int c = 0; c < 2; ++c)
#pragma unroll
            for (int i = 0; i < 16; ++i) oacc[c][i] = 0.f;
        float m_i = -INFINITY, l_i = 0.f;
        for (int c = 0; c < nch; ++c) {
            if (VAR != 5 && VAR != 6) {
#pragma unroll
            for (int j = 0; j < 8; ++j) *(LAS v4u*)(L + O_KV + (w * 8 + j) * KRS + l * 16) = st[j]; }
            if (c == nch - 1 && has_next && tid < 256) { nidx[tid] = nid; ndist[tid] = (float)(tn - nid); }
            LDS_BARRIER();
            {
                const bool last = (c == nch - 1);
                if (VAR != 1 && (!last || has_next)) { const LAS int* srcidx = last ? nidx : (lidx + (c + 1) * 64);
#pragma unroll
                    for (int j = 0; j < 8; ++j) { const int id = srcidx[w * 8 + j]; st[j] = __builtin_bit_cast(v4u, __builtin_amdgcn_raw_buffer_load_b128(rKV, (unsigned)(l * 16), __builtin_amdgcn_readfirstlane(id) * 1024, 0)); } }
 }
            f32x4 lg[4];
#pragma unroll
            for (int nt = 0; nt < 4; ++nt) lg[nt] = (f32x4){0.f, 0.f, 0.f, 0.f};
            if (VAR != 3 && VAR != 5 && VAR != 7) {
#pragma unroll
            for (int kb2 = 0; kb2 < 2; ++kb2) { bf16x8 bk[4][2];
#pragma unroll
                for (int nt = 0; nt < 4; ++nt)
#pragma unroll
                    for (int k1 = 0; k1 < 2; ++k1) bk[nt][k1] = *(const LAS bf16x8*)(L + O_KV + (nt * 16 + r16) * KRS + (kq * 128 + (kb2 * 2 + k1) * 32 + quad * 8) * 2);
                __builtin_amdgcn_sched_barrier(0);
#pragma unroll
                for (int k1 = 0; k1 < 2; ++k1)
#pragma unroll
                    for (int nt = 0; nt < 4; ++nt) lg[nt] = __builtin_amdgcn_mfma_f32_16x16x32_bf16(bk[nt][k1], aq[kb2 * 2 + k1], lg[nt], 0, 0, 0);
                __builtin_amdgcn_sched_barrier(0); }
            if (kq > 0) {
#pragma unroll
                for (int nt = 0; nt < 4; ++nt) *(LAS f32x4*)(L + O_EX + ((((kq - 1) * 2 + mt) * 4 + nt) * 64 + l) * 16) = lg[nt]; }
            }
            LDS_BARRIER();
            if (c == nch - 1 && has_next) {
#pragma unroll
                for (int ks = 0; ks < 4; ++ks) aq[ks] = *(const bf16x8*)(QA + (size_t)tn * NQA + (mt * 16 + r16) * 512 + kq * 128 + ks * 32 + quad * 8); }
            if (VAR != 2 && VAR != 5 && w < 2) {
                float pmax = -INFINITY;
#pragma unroll
                for (int nh = 0; nh < 2; ++nh) { f32x4 ex[2][3]; f32x4 d4[2];
#pragma unroll
                    for (int n2 = 0; n2 < 2; ++n2) {
#pragma unroll
                        for (int k2 = 0; k2 < 3; ++k2) ex[n2][k2] = *(const LAS f32x4*)(L + O_EX + (((k2 * 2 + mt) * 4 + nh * 2 + n2) * 64 + l) * 16);
                        d4[n2] = *(const LAS f32x4*)(ldist + c * 64 + (nh * 2 + n2) * 16 + quad * 4); }
                    __builtin_amdgcn_sched_barrier(0);
#pragma unroll
                    for (int n2 = 0; n2 < 2; ++n2) { const int nt = nh * 2 + n2;
                        lg[nt] += ex[n2][0] + ex[n2][1] + ex[n2][2];
                        const int slot0 = c * 64 + nt * 16 + quad * 4;
#pragma unroll
                        for (int i = 0; i < 4; ++i) {
                            const float v = (slot0 + i < cnt) ? (lg[nt][i] * 0.08838834764831845f - slope * d4[n2][i]) : -INFINITY; lg[nt][i] = v; pmax = fmaxf(pmax, v); } }
                    __builtin_amdgcn_sched_barrier(0); }
                pmax = p6_swap_max32(p6_swap_max16(pmax));
                const float mn = fmaxf(m_i, pmax), alpha = __expf(m_i - mn); m_i = mn;
                float rs = 0.f;
#pragma unroll
                for (int nt = 0; nt < 4; ++nt) { float pe[4];
#pragma unroll
                    for (int i = 0; i < 4; ++i) pe[i] = __expf(lg[nt][i] - mn);
                    v2u pw; pw.x = cvt_pk_bf16(pe[0], pe[1]); pw.y = cvt_pk_bf16(pe[2], pe[3]);
                    rs += (bf_lo(pw.x) + bf_hi(pw.x)) + (bf_lo(pw.y) + bf_hi(pw.y));
                    *(LAS v2u*)(L + O_P + (mt * 16 + r16) * PRS + (nt * 16 + quad * 4) * 2) = pw; }
                rs = p6_swap_sum32(p6_swap_sum16(rs));
                l_i = l_i * alpha + rs;
                if (quad == 0) { lal[mt * 16 + r16] = alpha; if (c == nch - 1) linv[mt * 16 + r16] = __builtin_amdgcn_rcpf(l_i); }
            }
            LDS_BARRIER();
            { float al[16];
#pragma unroll
              for (int g = 0; g < 4; ++g) { const f32x4 a4 = *(const LAS f32x4*)(lal + 8 * g + 4 * hh); al[4 * g] = a4[0]; al[4 * g + 1] = a4[1]; al[4 * g + 2] = a4[2]; al[4 * g + 3] = a4[3]; }
#pragma unroll
              for (int cc = 0; cc < 2; ++cc)
#pragma unroll
                  for (int i = 0; i < 16; ++i) oacc[cc][i] *= al[i]; }
            if (VAR != 4 && VAR != 5 && VAR != 7) {
#pragma unroll
            for (int kb2 = 0; kb2 < 2; ++kb2) { bf16x8 ap[2], bv[2][2];
#pragma unroll
                for (int k1 = 0; k1 < 2; ++k1) { const int ks = kb2 * 2 + k1; ap[k1] = *(const LAS bf16x8*)(L + O_P + r32 * PRS + (ks * 16 + hh * 8) * 2);
#pragma unroll
                    for (int cc = 0; cc < 2; ++cc) { const LAS unsigned char* p0 = L + O_KV + (ks * 16 + 8 * hh + ((l & 15) >> 2)) * KRS + (w * 64 + cc * 32 + 16 * ((l >> 4) & 1) + 4 * (l & 3)) * 2; bv[k1][cc] = tr_pair(p0, p0 + 4 * KRS); } }
                __builtin_amdgcn_sched_barrier(0);
#pragma unroll
                for (int k1 = 0; k1 < 2; ++k1)
#pragma unroll
                    for (int cc = 0; cc < 2; ++cc) oacc[cc] = __builtin_amdgcn_mfma_f32_32x32x16_bf16(ap[k1], bv[k1][cc], oacc[cc], 0, 0, 0);
                __builtin_amdgcn_sched_barrier(0); }
            }
            LDS_BARRIER();
        }
        { float li[16];
#pragma unroll
          for (int g = 0; g < 4; ++g) { const f32x4 a4 = *(const LAS f32x4*)(linv + 8 * g + 4 * hh); li[4 * g] = a4[0]; li[4 * g + 1] = a4[1]; li[4 * g + 2] = a4[2]; li[4 * g + 3] = a4[3]; }
#pragma unroll
          for (int cc = 0; cc < 2; ++cc)
#pragma unroll
              for (int i = 0; i < 16; ++i) { const int head = (i & 3) + 8 * (i >> 2) + 4 * hh;
                  *(LAS unsigned short*)(L + O_OT + head * KRS + (w * 64 + cc * 32 + r32) * 2) = (unsigned short)(cvt_pk_bf16(oacc[cc][i] * li[i], 0.f) & 0xffffu); } }
        LDS_BARRIER();
#pragma unroll
        for (int i = 0; i < 4; ++i) { const int pc = tid + 512 * i, head = pc >> 6, ch16 = pc & 63;
            *(v4u*)(OLAT + (size_t)t * 16384 + head * 512 + ch16 * 8) = *(const LAS v4u*)(L + O_OT + head * KRS + ch16 * 16); }
        t = tn; cnt = cnt_n; buf ^= 1;
    }
}
template <int VAR> __device__ __forceinline__ void phase6b_attn4(Frame& F, int kstart, int kcount, int kstride) {
    constexpr int extra = -1;
    const bf16* QA = (const bf16*)(F.ws + WS_QA); const bf16* CKV = (const bf16*)(F.ws + WS_CKV); const int* IDX = (const int*)(F.ws + WS_IDX); const int* CNT = (const int*)(F.ws + WS_CNT); bf16* OLAT = (bf16*)(F.ws + (VAR ? WS_SC : WS_OLAT));
    constexpr int KRS = 1040, PRS = 144;
    constexpr int O_KV = 0, O_IDX = 66560, O_DIST = 68608, O_AL = 70656, O_LINV = 70784, O_P = 70912, O_EX = 75520, O_OT = 70912;
    LAS unsigned char* L = F.lds;
    LAS float* lal = (LAS float*)(L + O_AL); LAS float* linv = (LAS float*)(L + O_LINV);
    const int tid = F.tid, w = F.wave, l = F.lane, quad = l >> 4, r16 = l & 15, r32 = l & 31, hh = l >> 5;
    const int mt = w & 1, kq = w >> 1;
    const float slope = exp2f(-0.25f * (float)(mt * 16 + r16 + 1));
    const int ktotal = kcount + (extra >= 0 ? 1 : 0);
    if (ktotal <= 0) return;
    const __amdgpu_buffer_rsrc_t rKV = __builtin_amdgcn_make_buffer_rsrc((void*)CKV, 0, T_SEQ * 1024, 0x00020000);
    int t = T_SEQ - 1 - ((kcount > 0) ? kstart : extra); int cnt = CNT[t];
    LDS_BARRIER();
    if (tid < 256) { const int id = IDX[(size_t)t * TOPK + tid]; ((LAS int*)(L + O_IDX))[tid] = id; ((LAS float*)(L + O_DIST))[tid] = (float)(t - id); }
    bf16x8 aq[4];
#pragma unroll
    for (int ks = 0; ks < 4; ++ks) aq[ks] = *(const bf16x8*)(QA + (size_t)t * NQA + (mt * 16 + r16) * 512 + kq * 128 + ks * 32 + quad * 8);
    LDS_BARRIER();
    v4u st[2][8];
#pragma unroll
    for (int s2 = 0; s2 < 2; ++s2)
#pragma unroll
        for (int j = 0; j < 8; ++j) { const int id = ((LAS int*)(L + O_IDX))[s2 * 64 + w * 8 + j]; st[s2][j] = __builtin_bit_cast(v4u, __builtin_amdgcn_raw_buffer_load_b128(rKV, (unsigned)(l * 16), __builtin_amdgcn_readfirstlane(id) * 1024, 0)); }
    int buf = 0;
    for (int qi = 0; qi < ktotal; ++qi) {
        constexpr int nch = 4;
        LAS int* lidx = (LAS int*)(L + O_IDX + buf * 1024); LAS float* ldist = (LAS float*)(L + O_DIST + buf * 1024);
        LAS int* nidx = (LAS int*)(L + O_IDX + (buf ^ 1) * 1024); LAS float* ndist = (LAS float*)(L + O_DIST + (buf ^ 1) * 1024);
        const bool has_next = qi + 1 < ktotal; const int tn = has_next ? (T_SEQ - 1 - ((qi + 1 < kcount) ? (kstart + (qi + 1) * kstride) : extra)) : t;
        int cnt_n = cnt, nid = 0;
        if (has_next) { cnt_n = CNT[tn]; if (tid < 256) nid = IDX[(size_t)tn * TOPK + tid]; }
        f32x16 oacc[2];
#pragma unroll
        for (int c = 0; c < 2; ++c)
#pragma unroll
            for (int i = 0; i < 16; ++i) oacc[c][i] = 0.f;
        float m_i = -INFINITY, l_i = 0.f;
#pragma unroll
        for (int c = 0; c < 4; ++c) {
            if (VAR != 5 && VAR != 6) {
#pragma unroll
            for (int j = 0; j < 8; ++j) *(LAS v4u*)(L + O_KV + (w * 8 + j) * KRS + l * 16) = st[c & 1][j]; }
            if (c == 2 && has_next && tid < 256) { nidx[tid] = nid; ndist[tid] = (float)(tn - nid); }
            LDS_BARRIER();
            {
                const bool nextq = (c >= 2);
                if (VAR != 1 && (!nextq || has_next)) { const LAS int* srcidx = nextq ? (nidx + (c - 2) * 64) : (lidx + (c + 2) * 64);
#pragma unroll
                    for (int j = 0; j < 8; ++j) { const int id = srcidx[w * 8 + j]; st[c & 1][j] = __builtin_bit_cast(v4u, __builtin_amdgcn_raw_buffer_load_b128(rKV, (unsigned)(l * 16), __builtin_amdgcn_readfirstlane(id) * 1024, 0)); } } }
            f32x4 lg[4];
#pragma unroll
            for (int nt = 0; nt < 4; ++nt) lg[nt] = (f32x4){0.f, 0.f, 0.f, 0.f};
            if (VAR != 3 && VAR != 5 && VAR != 7) {
#pragma unroll
            for (int kb2 = 0; kb2 < 2; ++kb2) { bf16x8 bk[4][2];
#pragma unroll
                for (int nt = 0; nt < 4; ++nt)
#pragma unroll
                    for (int k1 = 0; k1 < 2; ++k1) bk[nt][k1] = *(const LAS bf16x8*)(L + O_KV + (nt * 16 + r16) * KRS + (kq * 128 + (kb2 * 2 + k1) * 32 + quad * 8) * 2);
                __builtin_amdgcn_sched_barrier(0);
#pragma unroll
                for (int k1 = 0; k1 < 2; ++k1)
#pragma unroll
                    for (int nt = 0; nt < 4; ++nt) lg[nt] = __builtin_amdgcn_mfma_f32_16x16x32_bf16(bk[nt][k1], aq[kb2 * 2 + k1], lg[nt], 0, 0, 0);
                __builtin_amdgcn_sched_barrier(0); }
            if (kq > 0) {
#pragma unroll
                for (int nt = 0; nt < 4; ++nt) *(LAS f32x4*)(L + O_EX + ((((kq - 1) * 2 + mt) * 4 + nt) * 64 + l) * 16) = lg[nt]; }
            }
            LDS_BARRIER();
            if (c == nch - 1 && has_next) {
#pragma unroll
                for (int ks = 0; ks < 4; ++ks) aq[ks] = *(const bf16x8*)(QA + (size_t)tn * NQA + (mt * 16 + r16) * 512 + kq * 128 + ks * 32 + quad * 8); }
            if (VAR != 2 && VAR != 5 && w < 2) {
                float pmax = -INFINITY;
#pragma unroll
                for (int nh = 0; nh < 2; ++nh) { f32x4 ex[2][3]; f32x4 d4[2];
#pragma unroll
                    for (int n2 = 0; n2 < 2; ++n2) {
#pragma unroll
                        for (int k2 = 0; k2 < 3; ++k2) ex[n2][k2] = *(const LAS f32x4*)(L + O_EX + (((k2 * 2 + mt) * 4 + nh * 2 + n2) * 64 + l) * 16);
                        d4[n2] = *(const LAS f32x4*)(ldist + c * 64 + (nh * 2 + n2) * 16 + quad * 4); }
                    __builtin_amdgcn_sched_barrier(0);
#pragma unroll
                    for (int n2 = 0; n2 < 2; ++n2) { const int nt = nh * 2 + n2;
                        lg[nt] += ex[n2][0] + ex[n2][1] + ex[n2][2];
                        const int slot0 = c * 64 + nt * 16 + quad * 4;
#pragma unroll
                        for (int i = 0; i < 4; ++i) {
                            const float v = (slot0 + i < cnt) ? (lg[nt][i] * 0.08838834764831845f - slope * d4[n2][i]) : -INFINITY; lg[nt][i] = v; pmax = fmaxf(pmax, v); } }
                    __builtin_amdgcn_sched_barrier(0); }
                pmax = p6_swap_max32(p6_swap_max16(pmax));
                const float mn = fmaxf(m_i, pmax), alpha = __expf(m_i - mn); m_i = mn;
                float rs = 0.f;
#pragma unroll
                for (int nt = 0; nt < 4; ++nt) { float pe[4];
#pragma unroll
                    for (int i = 0; i < 4; ++i) pe[i] = __expf(lg[nt][i] - mn);
                    v2u pw; pw.x = cvt_pk_bf16(pe[0], pe[1]); pw.y = cvt_pk_bf16(pe[2], pe[3]);
                    rs += (bf_lo(pw.x) + bf_hi(pw.x)) + (bf_lo(pw.y) + bf_hi(pw.y));
                    *(LAS v2u*)(L + O_P + (mt * 16 + r16) * PRS + (nt * 16 + quad * 4) * 2) = pw; }
                rs = p6_swap_sum32(p6_swap_sum16(rs));
                l_i = l_i * alpha + rs;
                if (quad == 0) { lal[mt * 16 + r16] = alpha; if (c == nch - 1) linv[mt * 16 + r16] = __builtin_amdgcn_rcpf(l_i); }
            }
            LDS_BARRIER();
            { float al[16];
#pragma unroll
              for (int g = 0; g < 4; ++g) { const f32x4 a4 = *(const LAS f32x4*)(lal + 8 * g + 4 * hh); al[4 * g] = a4[0]; al[4 * g + 1] = a4[1]; al[4 * g + 2] = a4[2]; al[4 * g + 3] = a4[3]; }
#pragma unroll
              for (int cc = 0; cc < 2; ++cc)
#pragma unroll
                  for (int i = 0; i < 16; ++i) oacc[cc][i] *= al[i]; }
            if (VAR != 4 && VAR != 5 && VAR != 7) {
#pragma unroll
            for (int kb2 = 0; kb2 < 2; ++kb2) { bf16x8 ap[2], bv[2][2];
#pragma unroll
                for (int k1 = 0; k1 < 2; ++k1) { const int ks = kb2 * 2 + k1; ap[k1] = *(const LAS bf16x8*)(L + O_P + r32 * PRS + (ks * 16 + hh * 8) * 2);
#pragma unroll
                    for (int cc = 0; cc < 2; ++cc) { const LAS unsigned char* p0 = L + O_KV + (ks * 16 + 8 * hh + ((l & 15) >> 2)) * KRS + (w * 64 + cc * 32 + 16 * ((l >> 4) & 1) + 4 * (l & 3)) * 2; bv[k1][cc] = tr_pair(p0, p0 + 4 * KRS); } }
                __builtin_amdgcn_sched_barrier(0);
#pragma unroll
                for (int k1 = 0; k1 < 2; ++k1)
#pragma unroll
                    for (int cc = 0; cc < 2; ++cc) oacc[cc] = __builtin_amdgcn_mfma_f32_32x32x16_bf16(ap[k1], bv[k1][cc], oacc[cc], 0, 0, 0);
                __builtin_amdgcn_sched_barrier(0); }
            }
            LDS_BARRIER();
        }
        { float li[16];
#pragma unroll
          for (int g = 0; g < 4; ++g) { const f32x4 a4 = *(const LAS f32x4*)(linv + 8 * g + 4 * hh); li[4 * g] = a4[0]; li[4 * g + 1] = a4[1]; li[4 * g + 2] = a4[2]; li[4 * g + 3] = a4[3]; }
#pragma unroll
          for (int cc = 0; cc < 2; ++cc)
#pragma unroll
              for (int i = 0; i < 16; ++i) { const int head = (i & 3) + 8 * (i >> 2) + 4 * hh;
                  *(LAS unsigned short*)(L + O_OT + head * KRS + (w * 64 + cc * 32 + r32) * 2) = (unsigned short)(cvt_pk_bf16(oacc[cc][i] * li[i], 0.f) & 0xffffu); } }
        LDS_BARRIER();
#pragma unroll
        for (int i = 0; i < 4; ++i) { const int pc = tid + 512 * i, head = pc >> 6, ch16 = pc & 63;
            *(v4u*)(OLAT + (size_t)t * 16384 + head * 512 + ch16 * 8) = *(const LAS v4u*)(L + O_OT + head * KRS + ch16 * 16); }
        t = tn; cnt = cnt_n; buf ^= 1;
    }
}
template <int VAR> __device__ __forceinline__ void phase6c_attn(Frame& F, int kstart, int kcount, int kstride) {
    const bf16* QA = (const bf16*)(F.ws + WS_QA); const bf16* CKV = (const bf16*)(F.ws + WS_CKV); const int* IDX = (const int*)(F.ws + WS_IDX); const int* CNT = (const int*)(F.ws + WS_CNT); bf16* OLAT = (bf16*)(F.ws + (VAR ? WS_SC : WS_OLAT));
    constexpr int KRS = 1040, PRS = 144;
    constexpr int O_KV = 0, O_IDX = 66560, O_DIST = 68608, O_AL = 70656, O_MX = 70784  , O_LP = 71296  , O_P = 71808, O_OT = 71808;
    LAS unsigned char* L = F.lds;
    LAS float* lal = (LAS float*)(L + O_AL); LAS float* lmx = (LAS float*)(L + O_MX); LAS float* llp = (LAS float*)(L + O_LP);
    const int tid = F.tid, w = F.wave, l = F.lane, quad = l >> 4, r16 = l & 15, r32 = l & 31, hh = l >> 5;
    const int mt = w & 1, nq = w >> 1;
    float slope4[4];
#pragma unroll
    for (int i = 0; i < 4; ++i) slope4[i] = exp2f(-0.25f * (float)(mt * 16 + quad * 4 + i + 1));
    if (kcount <= 0) return;
    const __amdgpu_buffer_rsrc_t rKV = __builtin_amdgcn_make_buffer_rsrc((void*)CKV, 0, T_SEQ * 1024, 0x00020000);
    int t = T_SEQ - 1 - kstart; int cnt = CNT[t];
    LDS_BARRIER();
    if (tid < 256) { const int id = IDX[(size_t)t * TOPK + tid]; ((LAS int*)(L + O_IDX))[tid] = id; ((LAS float*)(L + O_DIST))[tid] = (float)(t - id); }
    bf16x8 aq[16];
#pragma unroll
    for (int ks = 0; ks < 16; ++ks) aq[ks] = *(const bf16x8*)(QA + (size_t)t * NQA + (mt * 16 + r16) * 512 + ks * 32 + quad * 8);
    LDS_BARRIER();
    v4u st[8];
#pragma unroll
    for (int j = 0; j < 8; ++j) { const int id = ((LAS int*)(L + O_IDX))[w * 8 + j]; st[j] = __builtin_bit_cast(v4u, __builtin_amdgcn_raw_buffer_load_b128(rKV, (unsigned)(l * 16), __builtin_amdgcn_readfirstlane(id) * 1024, 0)); }
    int buf = 0;
    for (int qi = 0; qi < kcount; ++qi) {
        const int nch = (cnt + 63) >> 6;
        LAS int* lidx = (LAS int*)(L + O_IDX + buf * 1024); LAS float* ldist = (LAS float*)(L + O_DIST + buf * 1024);
        LAS int* nidx = (LAS int*)(L + O_IDX + (buf ^ 1) * 1024); LAS float* ndist = (LAS float*)(L + O_DIST + (buf ^ 1) * 1024);
        const bool has_next = qi + 1 < kcount; const int tn = has_next ? (T_SEQ - 1 - (kstart + (qi + 1) * kstride)) : t;
        int cnt_n = cnt, nid = 0;
        if (has_next) { cnt_n = CNT[tn]; if (tid < 256) nid = IDX[(size_t)tn * TOPK + tid]; }
        f32x16 oacc[2];
#pragma unroll
        for (int c = 0; c < 2; ++c)
#pragma unroll
            for (int i = 0; i < 16; ++i) oacc[c][i] = 0.f;
        float m_i[4] = {-INFINITY, -INFINITY, -INFINITY, -INFINITY}, l_i[4] = {0.f, 0.f, 0.f, 0.f};
        for (int c = 0; c < nch; ++c) {
            if (VAR != 5 && VAR != 6) {
#pragma unroll
            for (int j = 0; j < 8; ++j) *(LAS v4u*)(L + O_KV + (w * 8 + j) * KRS + l * 16) = st[j]; }
            if (c == nch - 1 && has_next && tid < 256) { nidx[tid] = nid; ndist[tid] = (float)(tn - nid); }
            LDS_BARRIER();
            f32x4 lg = (f32x4){0.f, 0.f, 0.f, 0.f};
            { f32x4 lg2 = lg;
#pragma unroll
              for (int kb = 0; kb < 2; ++kb) { bf16x8 bk[8];
#pragma unroll
                  for (int k1 = 0; k1 < 8; ++k1) bk[k1] = *(const LAS bf16x8*)(L + O_KV + (nq * 16 + r16) * KRS + ((kb * 8 + k1) * 32 + quad * 8) * 2);
                  __builtin_amdgcn_sched_barrier(0);
#pragma unroll
                  for (int k1 = 0; k1 < 8; k1 += 2) { lg = __builtin_amdgcn_mfma_f32_16x16x32_bf16(aq[kb * 8 + k1], bk[k1], lg, 0, 0, 0); lg2 = __builtin_amdgcn_mfma_f32_16x16x32_bf16(aq[kb * 8 + k1 + 1], bk[k1 + 1], lg2, 0, 0, 0); }
                  __builtin_amdgcn_sched_barrier(0); }
              lg += lg2; }
            { const int slot = c * 64 + nq * 16 + r16; const float dist = ldist[slot]; const bool valid = slot < cnt;
#pragma unroll
              for (int i = 0; i < 4; ++i) { const float v = valid ? (lg[i] * 0.08838834764831845f - slope4[i] * dist) : -INFINITY; lg[i] = v;
                  float mx = v; mx = fmaxf(mx, __shfl_xor(mx, 1)); mx = fmaxf(mx, __shfl_xor(mx, 2)); mx = fmaxf(mx, __shfl_xor(mx, 4)); mx = fmaxf(mx, __shfl_xor(mx, 8));
                  if (r16 == 0) lmx[nq * 32 + mt * 16 + quad * 4 + i] = mx; } }
            LDS_BARRIER();
            {
                const bool last = (c == nch - 1);
                if (VAR != 1 && (!last || has_next)) { const LAS int* srcidx = last ? nidx : (lidx + (c + 1) * 64);
#pragma unroll
                    for (int j = 0; j < 8; ++j) { const int id = srcidx[w * 8 + j]; st[j] = __builtin_bit_cast(v4u, __builtin_amdgcn_raw_buffer_load_b128(rKV, (unsigned)(l * 16), __builtin_amdgcn_readfirstlane(id) * 1024, 0)); } }
                if (last && has_next) {
#pragma unroll
                    for (int ks = 0; ks < 16; ++ks) aq[ks] = *(const bf16x8*)(QA + (size_t)tn * NQA + (mt * 16 + r16) * 512 + ks * 32 + quad * 8); } }
            {
                const f32x4 m0 = *(const LAS f32x4*)(lmx + 0 * 32 + mt * 16 + quad * 4), m1 = *(const LAS f32x4*)(lmx + 1 * 32 + mt * 16 + quad * 4), m2 = *(const LAS f32x4*)(lmx + 2 * 32 + mt * 16 + quad * 4), m3 = *(const LAS f32x4*)(lmx + 3 * 32 + mt * 16 + quad * 4);
#pragma unroll
                for (int i = 0; i < 4; ++i) { const float cm = fmaxf(fmaxf(m0[i], m1[i]), fmaxf(m2[i], m3[i]));
                    const float mn = fmaxf(m_i[i], cm); const float alpha = __expf(m_i[i] - mn); m_i[i] = mn;
                    const float p = __expf(lg[i] - mn); const unsigned pb = cvt_pk_bf16(p, 0.f) & 0xffffu;
                    *(LAS unsigned short*)(L + O_P + (mt * 16 + quad * 4 + i) * PRS + (nq * 16 + r16) * 2) = (unsigned short)pb;
                    float s = bf_lo(pb); s += __shfl_xor(s, 1); s += __shfl_xor(s, 2); s += __shfl_xor(s, 4); s += __shfl_xor(s, 8);
                    l_i[i] = l_i[i] * alpha + s;
                    if (r16 == 0) { if (nq == 0) lal[mt * 16 + quad * 4 + i] = alpha; if (c == nch - 1) llp[nq * 32 + mt * 16 + quad * 4 + i] = l_i[i]; } }
            }
            LDS_BARRIER();
            { float al[16];
#pragma unroll
              for (int g = 0; g < 4; ++g) { const f32x4 a4 = *(const LAS f32x4*)(lal + 8 * g + 4 * hh); al[4 * g] = a4[0]; al[4 * g + 1] = a4[1]; al[4 * g + 2] = a4[2]; al[4 * g + 3] = a4[3]; }
#pragma unroll
              for (int cc = 0; cc < 2; ++cc)
#pragma unroll
                  for (int i = 0; i < 16; ++i) oacc[cc][i] *= al[i]; }
            if (VAR != 4 && VAR != 5 && VAR != 7) {
#pragma unroll
            for (int kb2 = 0; kb2 < 2; ++kb2) { bf16x8 ap[2], bv[2][2];
#pragma unroll
                for (int k1 = 0; k1 < 2; ++k1) { const int ks = kb2 * 2 + k1; ap[k1] = *(const LAS bf16x8*)(L + O_P + r32 * PRS + (ks * 16 + hh * 8) * 2);
#pragma unroll
                    for (int cc = 0; cc < 2; ++cc) { const LAS unsigned char* p0 = L + O_KV + (ks * 16 + 8 * hh + ((l & 15) >> 2)) * KRS + (w * 64 + cc * 32 + 16 * ((l >> 4) & 1) + 4 * (l & 3)) * 2; bv[k1][cc] = tr_pair(p0, p0 + 4 * KRS); } }
                __builtin_amdgcn_sched_barrier(0);
#pragma unroll
                for (int k1 = 0; k1 < 2; ++k1)
#pragma unroll
                    for (int cc = 0; cc < 2; ++cc) oacc[cc] = __builtin_amdgcn_mfma_f32_32x32x16_bf16(ap[k1], bv[k1][cc], oacc[cc], 0, 0, 0);
                __builtin_amdgcn_sched_barrier(0); }
            }
            LDS_BARRIER();
        }
        { float li[16];
#pragma unroll
          for (int g = 0; g < 4; ++g) { const f32x4 a4 = *(const LAS f32x4*)(llp + 8 * g + 4 * hh) + *(const LAS f32x4*)(llp + 32 + 8 * g + 4 * hh) + *(const LAS f32x4*)(llp + 64 + 8 * g + 4 * hh) + *(const LAS f32x4*)(llp + 96 + 8 * g + 4 * hh);
              li[4 * g] = __builtin_amdgcn_rcpf(a4[0]); li[4 * g + 1] = __builtin_amdgcn_rcpf(a4[1]); li[4 * g + 2] = __builtin_amdgcn_rcpf(a4[2]); li[4 * g + 3] = __builtin_amdgcn_rcpf(a4[3]); }
#pragma unroll
          for (int cc = 0; cc < 2; ++cc)
#pragma unroll
              for (int i = 0; i < 16; ++i) { const int head = (i & 3) + 8 * (i >> 2) + 4 * hh;
                  *(LAS unsigned short*)(L + O_OT + head * KRS + (w * 64 + cc * 32 + r32) * 2) = (unsigned short)(cvt_pk_bf16(oacc[cc][i] * li[i], 0.f) & 0xffffu); } }
        LDS_BARRIER();
#pragma unroll
        for (int i = 0; i < 4; ++i) { const int pc = tid + 512 * i, head = pc >> 6, ch16 = pc & 63;
            *(v4u*)(OLAT + (size_t)t * 16384 + head * 512 + ch16 * 8) = *(const LAS v4u*)(L + O_OT + head * KRS + ch16 * 16); }
        t = tn; cnt = cnt_n; buf ^= 1;
    }
}
__device__ __forceinline__ void phase6d_attn(Frame& F, int kstart, int kcount, int kstride) {
    const bf16* QA = (const bf16*)(F.ws + WS_QA); const bf16* CKV = (const bf16*)(F.ws + WS_CKV); const int* IDX = (const int*)(F.ws + WS_IDX); const int* CNT = (const int*)(F.ws + WS_CNT); bf16* OLAT = (bf16*)(F.ws + WS_OLAT);
    constexpr int KRS = 1040, PRS = 80;
    constexpr int G_KV = 0, G_IDX = 33280  , G_DIST = 35328  , G_AL = 37376, G_LINV = 37504, G_P = 37632  , G_EX = 40192  , GSZ = 44288;
    static_assert(2 * GSZ <= RING_BYTES, "attention LDS map");
    const int tid = F.tid, w = F.wave, l = F.lane, quad = l >> 4, r16 = l & 15, r32 = l & 31, hh = l >> 5;
    const int g = w >> 2, wl = w & 3, mt = wl & 1, kh = wl >> 1, gt = tid & 255;
    LAS unsigned char* L = F.lds + g * GSZ;
    LAS float* lal = (LAS float*)(L + G_AL); LAS float* linv = (LAS float*)(L + G_LINV);
    float slope4[4];
#pragma unroll
    for (int i = 0; i < 4; ++i) slope4[i] = exp2f(-0.25f * (float)(mt * 16 + quad * 4 + i + 1));
    if (kcount <= 0) return;
    const __amdgpu_buffer_rsrc_t rKV = __builtin_amdgcn_make_buffer_rsrc((void*)CKV, 0, T_SEQ * 1024, 0x00020000);
    const int npair = (kcount + 1) >> 1;
#define P6D_TICKET(p) (kstart + (((2 * (p) + g) < kcount) ? (2 * (p) + g) : (kcount - 1)) * kstride)
    int t = T_SEQ - 1 - P6D_TICKET(0);
    int cntA = CNT[T_SEQ - 1 - (kstart)], cntB = CNT[T_SEQ - 1 - (kstart + ((1 < kcount) ? 1 : 0) * kstride)];
    int cnt = g ? cntB : cntA;
    LDS_BARRIER();
    { const int id = IDX[(size_t)t * TOPK + gt]; ((LAS int*)(L + G_IDX))[gt] = id; ((LAS float*)(L + G_DIST))[gt] = (float)(t - id); }
    bf16x8 aq[8];
#pragma unroll
    for (int ks = 0; ks < 8; ++ks) aq[ks] = *(const bf16x8*)(QA + (size_t)t * NQA + (mt * 16 + r16) * 512 + kh * 256 + ks * 32 + quad * 8);
    LDS_BARRIER();
    v4u st[8];
#pragma unroll
    for (int j = 0; j < 8; ++j) { const int id = ((LAS int*)(L + G_IDX))[wl * 8 + j]; st[j] = __builtin_bit_cast(v4u, __builtin_amdgcn_raw_buffer_load_b128(rKV, (unsigned)(l * 16), __builtin_amdgcn_readfirstlane(id) * 1024, 0)); }
    int buf = 0;
    for (int p = 0; p < npair; ++p) {
        const int nch = (((cntA > cntB) ? cntA : cntB) + 31) >> 5;
        LAS int* lidx = (LAS int*)(L + G_IDX + buf * 1024); LAS float* ldist = (LAS float*)(L + G_DIST + buf * 1024);
        LAS int* nidx = (LAS int*)(L + G_IDX + (buf ^ 1) * 1024); LAS float* ndist = (LAS float*)(L + G_DIST + (buf ^ 1) * 1024);
        const bool has_next = p + 1 < npair; const int tn = has_next ? (T_SEQ - 1 - P6D_TICKET(p + 1)) : t;
        int cntA_n = cntA, cntB_n = cntB, nid = 0;
        if (has_next) { const int ka = kstart + (2 * (p + 1)) * kstride, kb = kstart + (((2 * (p + 1) + 1) < kcount) ? (2 * (p + 1) + 1) : (kcount - 1)) * kstride;
            cntA_n = CNT[T_SEQ - 1 - ka]; cntB_n = CNT[T_SEQ - 1 - kb]; nid = IDX[(size_t)tn * TOPK + gt]; }
        f32x16 oacc[4];
#pragma unroll
        for (int c = 0; c < 4; ++c)
#pragma unroll
            for (int i = 0; i < 16; ++i) oacc[c][i] = 0.f;
        float m_i[4] = {-INFINITY, -INFINITY, -INFINITY, -INFINITY}, l_i[4] = {0.f, 0.f, 0.f, 0.f};
        for (int c = 0; c < nch; ++c) {
#pragma unroll
            for (int j = 0; j < 8; ++j) *(LAS v4u*)(L + G_KV + (wl * 8 + j) * KRS + l * 16) = st[j];
            if (c == nch - 1 && has_next) { nidx[gt] = nid; ndist[gt] = (float)(tn - nid); }
            LDS_BARRIER();
            f32x4 lg[2];
            lg[0] = (f32x4){0.f, 0.f, 0.f, 0.f}; lg[1] = lg[0];
#pragma unroll
            for (int kb2 = 0; kb2 < 2; ++kb2) { bf16x8 bk[2][4];
#pragma unroll
                for (int nt = 0; nt < 2; ++nt)
#pragma unroll
                    for (int k1 = 0; k1 < 4; ++k1) bk[nt][k1] = *(const LAS bf16x8*)(L + G_KV + (nt * 16 + r16) * KRS + (kh * 256 + (kb2 * 4 + k1) * 32 + quad * 8) * 2);
                __builtin_amdgcn_sched_barrier(0);
#pragma unroll
                for (int k1 = 0; k1 < 4; ++k1)
#pragma unroll
                    for (int nt = 0; nt < 2; ++nt) lg[nt] = __builtin_amdgcn_mfma_f32_16x16x32_bf16(aq[kb2 * 4 + k1], bk[nt][k1], lg[nt], 0, 0, 0);
                __builtin_amdgcn_sched_barrier(0); }
            if (kh == 1) {
#pragma unroll
                for (int nt = 0; nt < 2; ++nt) *(LAS f32x4*)(L + G_EX + ((mt * 2 + nt) * 64 + l) * 16) = lg[nt]; }
            LDS_BARRIER();
            {
                const bool last = (c == nch - 1);
                if (!last || has_next) { const LAS int* srcidx = last ? nidx : (lidx + (c + 1) * 32);
#pragma unroll
                    for (int j = 0; j < 8; ++j) { const int id = srcidx[wl * 8 + j]; st[j] = __builtin_bit_cast(v4u, __builtin_amdgcn_raw_buffer_load_b128(rKV, (unsigned)(l * 16), __builtin_amdgcn_readfirstlane(id) * 1024, 0)); } }
                if (last && has_next) {
#pragma unroll
                    for (int ks = 0; ks < 8; ++ks) aq[ks] = *(const bf16x8*)(QA + (size_t)tn * NQA + (mt * 16 + r16) * 512 + kh * 256 + ks * 32 + quad * 8); } }
            if (kh == 0) {
                float pmax[4] = {-INFINITY, -INFINITY, -INFINITY, -INFINITY};
#pragma unroll
                for (int nt = 0; nt < 2; ++nt) {
                    lg[nt] += *(const LAS f32x4*)(L + G_EX + ((mt * 2 + nt) * 64 + l) * 16);
                    const int slot = c * 32 + nt * 16 + r16; const float dist = ldist[slot]; const bool valid = slot < cnt;
#pragma unroll
                    for (int i = 0; i < 4; ++i) { const float v = valid ? (lg[nt][i] * 0.08838834764831845f - slope4[i] * dist) : -INFINITY; lg[nt][i] = v; pmax[i] = fmaxf(pmax[i], v); } }
                float alpha[4], rs[4];
#pragma unroll
                for (int i = 0; i < 4; ++i) { const float mx = row16_allmax(pmax[i]);
                    const float mn = fmaxf(m_i[i], mx); alpha[i] = (mn == -INFINITY) ? 1.0f : __expf(m_i[i] - mn); m_i[i] = mn; rs[i] = 0.f; }
#pragma unroll
                for (int nt = 0; nt < 2; ++nt)
#pragma unroll
                    for (int i = 0; i < 4; ++i) { const float pv_ = (m_i[i] == -INFINITY) ? 0.f : __expf(lg[nt][i] - m_i[i]); const unsigned pb = cvt_pk_bf16(pv_, 0.f) & 0xffffu; rs[i] += bf_lo(pb);
                        *(LAS unsigned short*)(L + G_P + (mt * 16 + quad * 4 + i) * PRS + (nt * 16 + r16) * 2) = (unsigned short)pb; }
#pragma unroll
                for (int i = 0; i < 4; ++i) { const float s = row16_allsum(rs[i]);
                    l_i[i] = l_i[i] * alpha[i] + s;
                    if (r16 == 0) { lal[mt * 16 + quad * 4 + i] = alpha[i]; if (c == nch - 1) linv[mt * 16 + quad * 4 + i] = __builtin_amdgcn_rcpf(l_i[i]); } }
            }
            LDS_BARRIER();
            { float al[16];
#pragma unroll
              for (int q4 = 0; q4 < 4; ++q4) { const f32x4 a4 = *(const LAS f32x4*)(lal + 8 * q4 + 4 * hh); al[4 * q4] = a4[0]; al[4 * q4 + 1] = a4[1]; al[4 * q4 + 2] = a4[2]; al[4 * q4 + 3] = a4[3]; }
#pragma unroll
              for (int cc = 0; cc < 4; ++cc)
#pragma unroll
                  for (int i = 0; i < 16; ++i) oacc[cc][i] *= al[i]; }
#pragma unroll
            for (int ks = 0; ks < 2; ++ks) { bf16x8 bv[4];
                const bf16x8 ap = *(const LAS bf16x8*)(L + G_P + r32 * PRS + (ks * 16 + hh * 8) * 2);
#pragma unroll
                for (int cc = 0; cc < 4; ++cc) { const LAS unsigned char* p0 = L + G_KV + (ks * 16 + 8 * hh + ((l & 15) >> 2)) * KRS + (wl * 128 + cc * 32 + 16 * ((l >> 4) & 1) + 4 * (l & 3)) * 2; bv[cc] = tr_pair(p0, p0 + 4 * KRS); }
                __builtin_amdgcn_sched_barrier(0);
#pragma unroll
                for (int cc = 0; cc < 4; ++cc) oacc[cc] = __builtin_amdgcn_mfma_f32_32x32x16_bf16(ap, bv[cc], oacc[cc], 0, 0, 0);
                __builtin_amdgcn_sched_barrier(0); }
            LDS_BARRIER();
        }
        { float li[16];
#pragma unroll
          for (int q4 = 0; q4 < 4; ++q4) { const f32x4 a4 = *(const LAS f32x4*)(linv + 8 * q4 + 4 * hh); li[4 * q4] = a4[0]; li[4 * q4 + 1] = a4[1]; li[4 * q4 + 2] = a4[2]; li[4 * q4 + 3] = a4[3]; }
#pragma unroll
          for (int cc = 0; cc < 4; ++cc)
#pragma unroll
              for (int i = 0; i < 16; ++i) { const int head = (i & 3) + 8 * (i >> 2) + 4 * hh;
                  *(LAS unsigned short*)(L + G_KV + head * KRS + (wl * 128 + cc * 32 + r32) * 2) = (unsigned short)(cvt_pk_bf16(oacc[cc][i] * li[i], 0.f) & 0xffffu); } }
        LDS_BARRIER();
#pragma unroll
        for (int i = 0; i < 8; ++i) { const int pc = gt + 256 * i, head = pc >> 6, ch16 = pc & 63;
            *(v4u*)(OLAT + (size_t)t * 16384 + head * 512 + ch16 * 8) = *(const LAS v4u*)(L + G_KV + head * KRS + ch16 * 16); }
        LDS_BARRIER();
        t = tn; cntA = cntA_n; cntB = cntB_n; cnt = g ? cntB : cntA; buf ^= 1;
    }
#undef P6D_TICKET
}
constexpr int N_PHASES = 14;
constexpr int CW_BAR = 4096;
__global__ void __launch_bounds__(NWAVES * 64, 2) hybrid_fwd(Args args) {
    extern __shared__ __attribute__((aligned(16))) unsigned char lds[];
    Frame F;
    F.lds = (LAS unsigned char*)lds;
    F.tid = threadIdx.x; F.lane = F.tid & 63; F.wave = __builtin_amdgcn_readfirstlane(F.tid >> 6);
    F.G = gridDim.x; F.bid = blockIdx.x;
    F.p_I_X = args.in[0]; F.p_I_C = args.in[1]; F.p_I_WADA = args.in[2]; F.p_I_BADA = args.in[3]; F.p_I_WIN = args.in[4]; F.p_I_BIN = args.in[5]; F.p_I_GQ = args.in[6]; F.p_I_GKV = args.in[7]; F.p_I_WUQ = args.in[8]; F.p_I_WIQ = args.in[9]; F.p_I_WUK = args.in[10]; F.p_I_WUV = args.in[11]; F.p_I_GKIDX = args.in[12]; F.p_I_BKIDX = args.in[13]; F.p_I_CONVW = args.in[14]; F.p_I_CONVB = args.in[15]; F.p_I_GMH = args.in[16]; F.p_I_WAO = args.in[17]; F.p_I_WMO = args.in[18]; F.p_I_WOUT = args.in[19]; F.p_I_LNG = args.in[20]; F.p_I_LNB = args.in[21];
    F.out = args.out; F.ws = args.ws;
    volatile LAS unsigned* MISCW = (volatile LAS unsigned*)(F.lds + MISC_OFF);
    for (int u = F.tid; u < (LDS_BYTES - LDSCTL_OFF) / 4; u += NWAVES * 64) ((LAS unsigned*)(F.lds + LDSCTL_OFF))[u] = 0u;
    __syncthreads();
    const int lo = args.ph_lo, hi = args.ph_hi;
    XcdBarrier bar; bar.bar = (unsigned*)(args.ws + WS_CTL) + CW_BAR + args.li * XCD_BAR_WORDS; bar.x = 0; bar.st = nullptr;
    if (hi - lo > 1) bar = xcd_barrier_post((unsigned*)(args.ws + WS_CTL) + CW_BAR + args.li * XCD_BAR_WORDS, MISCW + 8);
#ifndef PROBE_DUP_MASK
#define PROBE_DUP_MASK 0
#endif
#define DUP(k) ((PROBE_DUP_MASK >> (k)) & 1)
#ifndef PROBE_VAR
#define PROBE_VAR 0
#endif
#ifndef MK_ATT_NB
#define MK_ATT_NB 42
#endif
#ifndef MK_ATT_S0
#define MK_ATT_S0 4
#endif
#define IN(k) (lo <= (k) && (k) < hi)
#define FRESH() do { int t_ = threadIdx.x; asm volatile("" : "+v"(t_)); F.tid = t_; F.lane = t_ & 63; F.wave = __builtin_amdgcn_readfirstlane(t_ >> 6); } while (0)
#define SEAM(k) do { if (IN(k) && IN((k) + 1)) xcd_barrier(bar); } while (0)

    if (IN(0)) { FRESH(); phase0(F); if (DUP(0)) { __syncthreads(); phase0(F); } SEAM(0); }
    if (IN(1)) { FRESH(); phase1(F); if (DUP(1)) { __syncthreads(); phase1(F); } SEAM(1); }
    if (IN(2)) {
        { pg8::Gemm g{(const bf16*)(F.ws + WS_U), (const bf16*)(F.ws + WS_WINT), T_SEQ, 1792, 4096, 4096, 4096, 0};
          pg8::StaticOrder S; S.init(T_SEQ, 1792, F.G, F.bid);
          pg8::EpiProj E{(bf16*)(F.ws + WS_P), (float*)(F.ws + WS_MISC), (const float*)(F.ws + WS_MOD) + 16384, 0};
          pg8::gemm_phase<pg8::EpiProj, pg8::StaticOrder, PG8_ALIGN, PG8_SP2, false>(F.lds + RING_OFF, g, S, E); }
        { pg8::Gemm g{(const bf16*)(F.ws + WS_U8), (const bf16*)(F.ws + WS_WINT8), T_SEQ, NP - 1792, 2048, 2048, 2048, 0, 0x79797979u};
          pg8::StaticOrder S; S.init(T_SEQ, NP - 1792, F.G, F.bid);
          pg8::EpiProj E{(bf16*)(F.ws + WS_P), (float*)(F.ws + WS_MISC), (const float*)(F.ws + WS_MOD) + 16384, 7};
          pg8::gemm_phase<pg8::EpiProj, pg8::StaticOrder, PG8_ALIGN, PG8_SP2, true>(F.lds + RING_OFF, g, S, E); }
        SEAM(2);
    }
    if (IN(3)) { FRESH(); phase3(F); if (DUP(3)) { __syncthreads(); phase3(F); } SEAM(3); }
    if (IN(4)) {
        { pg8::Gemm g{(const bf16*)(F.ws + WS_CQ8), (const bf16*)(F.ws + WS_WQT), T_SEQ, 16384, 512, 512, 512, 0, 0x79797979u, 0x7F7F7F7Fu};
          pg8::StaticOrder S; S.init(T_SEQ, 16384, F.G, F.bid);
          pg8::EpiPlain E{(bf16*)(F.ws + WS_QA), NQA};
          pg8::gemm_phase<pg8::EpiPlain, pg8::StaticOrder, PG8_ALIGN, PG8_SP2, true>(F.lds + RING_OFF, g, S, E); }
        { pg8::Gemm g{(const bf16*)(F.ws + WS_CQ), (const bf16*)(F.ws + WS_WIQT), T_SEQ, 2048, 1024, 1024, 1024, 0};
          pg8::StaticOrder S; S.init(T_SEQ, 2048, F.G, F.bid);
          pg8::EpiPlain E{(bf16*)(F.ws + WS_QA) + 16384, NQA};
          pg8::gemm_phase<pg8::EpiPlain, pg8::StaticOrder, PG8_ALIGN, PG8_SP2, false>(F.lds + RING_OFF, g, S, E); }
        SEAM(4);
    }
    if (IN(5)) { FRESH(); phase5_fast<0>(F); if (DUP(5)) { __syncthreads(); phase5_fast<PROBE_VAR>(F); } SEAM(5); }
    if (IN(6)) { FRESH(); { const int gwi = F.bid * NWAVES + F.wave; for (int it = gwi; it < 1024; it += F.G * NWAVES) mlstm_pre_item(F, it); } LDS_BARRIER(); phase6a_select(F); if (DUP(6)) { __syncthreads(); phase6a_select(F); } SEAM(6); }
    if (IN(7)) {
        FRESH();
        constexpr int ATT_NB = MK_ATT_NB;
        if (F.G == 256) {
            constexpr int ATT_MB = (T_SEQ - 192 * ATT_NB) / 64; static_assert(192 * ATT_NB + 64 * ATT_MB == T_SEQ && ATT_MB >= 0, "ticket split");
            if (F.bid < 64) { phase8_v4(F, F.bid); FRESH();
                 phase6b_attn<0>(F, 192 * ATT_NB + F.bid, ATT_MB, 64); }
            else { constexpr int ATT_N4 = (ATT_NB < 41) ? ATT_NB : 41; static_assert(192 * ATT_N4 <= T_SEQ - TOPK, "the two-chunks-ahead form needs full 256-key rows");
                phase6b_attn4<0>(F, F.bid - 64, ATT_N4, 192);
                if (ATT_NB > ATT_N4) { FRESH(); phase6b_attn<0>(F, F.bid - 64 + 192 * ATT_N4, ATT_NB - ATT_N4, 192); } }
            if (DUP(7)) { __syncthreads(); if (F.bid >= 64) phase6b_attn<PROBE_VAR>(F, F.bid - 64, ATT_NB, 192); }
        } else {
            for (int b = F.bid; b < 64; b += F.G) { phase8_v4(F, b); FRESH(); }
            phase6b_attn<0>(F, F.bid, (T_SEQ - F.bid + F.G - 1) / F.G, F.G);
        }
        SEAM(7);
    }
    if (IN(8)) {
        pg8::Gemm g{(const bf16*)(F.ws + WS_OLAT), (const bf16*)(F.ws + WS_WUVT), T_SEQ, 4096, 1024, 16384, 1024, 1024};
        pg8::StaticOrder S; S.init(T_SEQ, 4096, F.G, F.bid);
        pg8::EpiGate<0, true> E{(void*)(F.ws + WS_OG), 4096, (const bf16*)(F.ws + WS_P) + PC_ZA, NP, nullptr, 16.0f};
        pg8::gemm_phase<pg8::EpiGate<0, true>, pg8::StaticOrder, PG8_ALIGN, PG8_SP2>(F.lds + RING_OFF, g, S, E);
    }
    if (IN(10)) { FRESH(); phase9(F); if (DUP(10)) { __syncthreads(); phase9(F); } SEAM(10); }
    if (IN(11)) {
        { pg8::Gemm g{(const bf16*)(F.ws + WS_OG), (const bf16*)(F.ws + WS_WAOT), T_SEQ, 4096, 2048, 2048, 2048, 0, 0x79797979u, 0x7B7B7B7Bu};
          pg8::StaticOrder S; S.init(T_SEQ, 4096, F.G, F.bid);
          pg8::EpiGate<0, false> E{(void*)(F.ws + WS_TMP), 4096, (const bf16*)(F.ws + WS_P) + PC_GA, NP, nullptr, 1.0f};
          pg8::gemm_phase<pg8::EpiGate<0, false>, pg8::StaticOrder, PG8_ALIGN, PG8_SP2, true>(F.lds + RING_OFF, g, S, E); }
        VM_WAIT(); __syncthreads();
        { pg8::Gemm g{(const bf16*)(F.ws + WS_HG), (const bf16*)(F.ws + WS_WMOT), T_SEQ, 4096, 2048, 2048, 2048, 0, 0x79797979u, 0x7D7D7D7Du};
          pg8::StaticOrder S; S.init(T_SEQ, 4096, F.G, F.bid);
          pg8::EpiGate<1, true> E{(void*)(F.ws + WS_MERGED), 4096, (const bf16*)(F.ws + WS_P) + PC_GM, NP, (const bf16*)(F.ws + WS_TMP), 8.0f};
          pg8::gemm_phase<pg8::EpiGate<1, true>, pg8::StaticOrder, PG8_ALIGN, PG8_SP2, true>(F.lds + RING_OFF, g, S, E); }
        SEAM(11);
    }
    if (IN(12)) {
        pg8::Gemm g{(const bf16*)(F.ws + WS_MERGED), (const bf16*)(F.ws + WS_WOT), T_SEQ, 4096, 2048, 2048, 2048, 0, 0x79797979u, 0x7C7C7C7Cu};
        pg8::StaticOrder S; S.init(T_SEQ, 4096, F.G, F.bid);
        pg8::EpiOut E{(bf16*)(F.ws + WS_TMP), F.p_I_X, (const float*)(F.ws + WS_MOD) + 8192, DN_ALPHA};
        pg8::gemm_phase<pg8::EpiOut, pg8::StaticOrder, PG8_ALIGN, PG8_SP2, true>(F.lds + RING_OFF, g, S, E);
        SEAM(12);
    }
    if (IN(13)) { FRESH(); phase12(F); }
#undef IN
#undef SEAM
}

#ifndef MK_PER_PHASE
#define MK_PER_PHASE 0
#endif
extern "C" void kernel_launch(void* const* d_in, const int* in_sizes, int n_in, void* d_out, int out_size, void* d_ws, size_t ws_size, hipStream_t stream) {
    static int grid = 0;
    if (grid == 0) {
        if (n_in != 22 || out_size != T_SEQ * DM || ws_size < WS_END) { fprintf(stderr, "kernel_launch: unexpected shapes (n_in %d out %d ws %zu need %zu)\n", n_in, out_size, ws_size, (size_t)WS_END); grid = -1; return; }
        int dev = 0, cus = 0, per_cu = 0;
        if (hipGetDevice(&dev) != hipSuccess || hipDeviceGetAttribute(&cus, hipDeviceAttributeMultiprocessorCount, dev) != hipSuccess) { grid = -1; return; }
        if (hipFuncSetAttribute((const void*)hybrid_fwd, hipFuncAttributeMaxDynamicSharedMemorySize, LDS_BYTES) != hipSuccess) { fprintf(stderr, "kernel_launch: hipFuncSetAttribute failed\n"); grid = -1; return; }
        if (hipOccupancyMaxActiveBlocksPerMultiprocessor(&per_cu, (const void*)hybrid_fwd, NWAVES * 64, LDS_BYTES) != hipSuccess || per_cu < 1) fprintf(stderr, "kernel_launch: occupancy query reports %d\n", per_cu);
        (void)hipGetLastError();
        grid = cus;
    }
    if (grid < 0) return;
    if (hipMemsetAsync((char*)d_ws + WS_CTL, 0, CTL_ZERO_BYTES, stream) != hipSuccess) return;
    Args a{};
    for (int i = 0; i < 22; ++i) a.in[i] = (const float*)d_in[i];
    a.out = (float*)d_out; a.ws = (unsigned char*)d_ws; a.pad = 0;
#if MK_PER_PHASE
    for (int p = 0; p < N_PHASES; ++p) { a.ph_lo = p; a.ph_hi = p + 1; a.li = 0; hipLaunchKernelGGL(hybrid_fwd, dim3(grid), dim3(NWAVES * 64), LDS_BYTES, stream, a); }
#else
    a.ph_lo = 0; a.ph_hi = N_PHASES; a.li = 0;
    hipLaunchKernelGGL(hybrid_fwd, dim3(grid), dim3(NWAVES * 64), LDS_BYTES, stream, a);
#endif
}
```

```cpp
#include <hip/hip_runtime.h>
#include <cstdio>
#include <cstdint>
constexpr int T_SEQ = 8192, DM = 4096;
constexpr int NSRC = 30320;
constexpr int NP = 30464;
constexpr int NQA = 18432;
constexpr int NHEAD = 32, KVR = 512, QLR = 1024, IDXD = 64, TOPK = 256;
constexpr int MH = 8, MDK = 256, MDV = 512, MCH = 64;
constexpr int PC_QLAT = 0, PC_KV = 1024, PC_MISC = 1536, PC_ZA = 1792, PC_QK = 5888, PC_V = 9984, PC_O = 14080, PC_ZM = 18176, PC_GA = 22272, PC_GM = 26368;
constexpr float NORM_EPS = 1e-6f;
constexpr float DN_ALPHA = 1.189207115002721f;
constexpr float SOFTCAP = 15.0f;

constexpr size_t MiB = 1u << 20;
constexpr size_t WS_CTL = 0, CTL_ZERO_BYTES = 1 * MiB;
constexpr size_t WS_MOD = 1 * MiB;
constexpr size_t WS_WQT = 2 * MiB;
constexpr size_t WS_WUVT = 38 * MiB;
constexpr size_t WS_WAOT = 46 * MiB, WS_WMOT = 78 * MiB, WS_WOT = 110 * MiB;
constexpr size_t WS_CQ = 142 * MiB;
constexpr size_t WS_CKV = 158 * MiB;
constexpr size_t WS_KI = 166 * MiB;
constexpr size_t WS_WI = 167 * MiB;
constexpr size_t WS_IG = 168 * MiB;
constexpr size_t WS_LF = 168 * MiB + 256 * 1024;
constexpr size_t WS_DEN = 168 * MiB + 512 * 1024;
constexpr size_t WS_MISC = 169 * MiB;
constexpr size_t WS_QM = 177 * MiB, WS_KM = 209 * MiB;
constexpr size_t WS_OG = 241 * MiB;
constexpr size_t WS_MERGED = 305 * MiB;
constexpr size_t WS_CQ8 = 337 * MiB;
constexpr size_t WS_WIQT = 18 * MiB;
constexpr size_t WS_WINT = 369 * MiB;
constexpr size_t WS_WINT8 = 385 * MiB;
constexpr size_t WS_U8 = 503 * MiB;
constexpr size_t WS_U = 607 * MiB;
constexpr size_t WS_SC = 369 * MiB;
constexpr size_t WS_P = 671 * MiB;
constexpr size_t WS_QA = 1147 * MiB;
constexpr size_t WS_HNUM = 1709 * MiB;
constexpr size_t WS_HG = 1275 * MiB;
constexpr size_t WS_TMP = 1339 * MiB;
constexpr size_t WS_OLAT = 1435 * MiB;
constexpr size_t WS_IDX = 1691 * MiB;
constexpr size_t WS_CNT = 1699 * MiB;
constexpr size_t WS_SP = 1700 * MiB;
constexpr size_t WS_GATES = 1708 * MiB;
constexpr size_t WS_END = 1837 * MiB;
static_assert(WS_WINT + (size_t)NP * 4096 * 2 <= WS_U && WS_U + (size_t)T_SEQ * 4096 * 2 <= WS_P && WS_SC + (size_t)T_SEQ * T_SEQ * 4 <= WS_P, "ws map 1");
static_assert(WS_P + (size_t)T_SEQ * NP * 2 <= WS_QA && WS_QA + (size_t)T_SEQ * NQA * 2 <= WS_OLAT && WS_TMP + (size_t)T_SEQ * 4096 * 2 <= WS_OLAT, "ws map 2");
static_assert(WS_WQT + (size_t)NQA * 1024 * 2 <= WS_WUVT, "ws map 3");
namespace pg8 {
#define PG8_LAS __attribute__((address_space(3)))
typedef unsigned short bf16_t;
typedef short bf16x8 __attribute__((ext_vector_type(8)));
typedef float f32x4 __attribute__((ext_vector_type(4)));
typedef unsigned u32x4 __attribute__((ext_vector_type(4)));
typedef int v4i_t __attribute__((ext_vector_type(4)));
typedef int v8i_t __attribute__((ext_vector_type(8)));
constexpr int BM = 256, BK = 64, HALF = 128, HTB = HALF * BK * 2  , STAGE_BYTES = 8 * HTB, NXCD = 8, WGM = 8;

__host__ __device__ __forceinline__ int lds_byte(int r, int c) { const int st = (r >> 4) * 2 + (c >> 5), rr = r & 15, cc = c & 31, ob = rr * 64 + cc * 2; return st * 1024 + (ob ^ (((ob >> 9) & 1) << 5)); }
__host__ __device__ __forceinline__ void stage_rc(int b, int& R, int& C) { const int st = b / 1024, sb = b % 1024, swz = sb ^ (((sb >> 9) & 1) << 5); R = (st >> 1) * 16 + swz / 64; C = (st & 1) * 32 + (swz % 64) / 2; }
__host__ __device__ __forceinline__ int perm32(int rho) { const int n = rho >> 4, i = rho & 15; return 8 * (i >> 2) + 4 * n + (i & 3); }

struct Unit { int pm, pn; };
struct Gemm { const bf16_t* A; const bf16_t* Bt; int M, N, K; int lda, ldb; long a_pn_off; unsigned wscale = 0x7F7F7F7Fu, ascale = 0x7F7F7F7Fu; };

struct StaticOrder {
    int nM, nN, nwg, G, c;
    __host__ __device__ void init(int M, int N, int G_, int c_) { nM = M / BM; nN = N / BM; nwg = nM * nN; G = G_; c = c_; }
    __host__ __device__ bool next(int i, Unit& u) const {
        const long L = (long)i * G + c; if (L >= nwg) return false;
        int wgid = (int)L; { const int q = nwg / NXCD, r = nwg % NXCD, xcd = wgid % NXCD, off = wgid / NXCD; wgid = (xcd < r ? xcd * (q + 1) : r * (q + 1) + (xcd - r) * q) + off; }
        const int nig = WGM * nN, gid = wgid / nig, fm = gid * WGM, gsz = (nM - fm) < WGM ? (nM - fm) : WGM;
        u.pm = fm + ((wgid % nig) % gsz); u.pn = (wgid % nig) / gsz; return true;
    }
    __device__ __forceinline__ void a_ready(const Unit&) const {}
    __device__ __forceinline__ void done(const Unit&) const {}
};

typedef float f32x2_t __attribute__((ext_vector_type(2)));
typedef __bf16 bf16x2_t __attribute__((ext_vector_type(2)));
__device__ __forceinline__ unsigned cvt_pk_bf16(float lo, float hi) { const f32x2_t v = {lo, hi}; const bf16x2_t b = __builtin_convertvector(v, bf16x2_t); return __builtin_bit_cast(unsigned, b); }
__device__ __forceinline__ float bf_lo(unsigned w) { return __uint_as_float(w << 16); }
__device__ __forceinline__ float bf_hi(unsigned w) { return __uint_as_float(w & 0xffff0000u); }
__device__ __forceinline__ float sigmoid_f(float x) { return __builtin_amdgcn_rcpf(1.0f + __expf(-x)); }
__device__ __forceinline__ float silu_f(float x) { return x * sigmoid_f(x); }
__device__ __forceinline__ u32x4 pack8(const f32x4& v0, const f32x4& v1) { u32x4 w; w.x = cvt_pk_bf16(v0[0], v0[1]); w.y = cvt_pk_bf16(v0[2], v0[3]); w.z = cvt_pk_bf16(v1[0], v1[1]); w.w = cvt_pk_bf16(v1[2], v1[3]); return w; }
__device__ __forceinline__ void unpack8(const u32x4& w, f32x4& v0, f32x4& v1) { v0 = (f32x4){bf_lo(w.x), bf_hi(w.x), bf_lo(w.y), bf_hi(w.y)}; v1 = (f32x4){bf_lo(w.z), bf_hi(w.z), bf_lo(w.w), bf_hi(w.w)}; }

typedef unsigned u32x2 __attribute__((ext_vector_type(2)));
__device__ __forceinline__ float clamp448(float x) { return fminf(fmaxf(x, -448.f), 448.f); }
__device__ __forceinline__ u32x2 pack_fp8x8(const float (&x)[8]) {
    int p0 = __builtin_amdgcn_cvt_pk_fp8_f32(clamp448(x[0]), clamp448(x[1]), 0, false); p0 = __builtin_amdgcn_cvt_pk_fp8_f32(clamp448(x[2]), clamp448(x[3]), p0, true);
    int p1 = __builtin_amdgcn_cvt_pk_fp8_f32(clamp448(x[4]), clamp448(x[5]), 0, false); p1 = __builtin_amdgcn_cvt_pk_fp8_f32(clamp448(x[6]), clamp448(x[7]), p1, true);
    return (u32x2){(unsigned)p0, (unsigned)p1};
}
struct EpiProj {
    static constexpr bool PERM = true, AFTER_DRAIN = false;
    bf16_t* P; float* MISC; const float* bias; int tile0;
    __device__ __forceinline__ void operator()(const f32x4 (&acc)[2][2][4][2], const Unit& u, int wr, int wc, int fr, int fq) const {
        const int tile = u.pn + tile0;
        int mode;
        if (tile < 6) mode = 0; else if (tile == 6) mode = 3; else if (tile < 23) mode = 1; else if (tile < 55) mode = 0; else if (tile < 71) mode = 2; else if (tile < 87) mode = 1; else mode = 2;
        const int cin = wc * 32 + 8 * fq, col0 = tile * BM + cin;
        const __amdgpu_buffer_rsrc_t rP = __builtin_amdgcn_make_buffer_rsrc((void*)P, 0, 0x7fffffff, 0x00020000), rM = __builtin_amdgcn_make_buffer_rsrc((void*)MISC, 0, 8192 * 256 * 4, 0x00020000);
        const unsigned voffP = (unsigned)(wr * 64 + fr) * (unsigned)(NP * 2) + (unsigned)cin * 2u, voffM = (unsigned)(wr * 64 + fr) * 1024u + (unsigned)cin * 4u;
        const int sP = u.pm * BM * (NP * 2) + tile * (BM * 2), sM = u.pm * BM * 1024;
        f32x4 bv[2][2];
#pragma unroll
        for (int bj = 0; bj < 2; ++bj)
#pragma unroll
            for (int n = 0; n < 2; ++n) bv[bj][n] = *(const f32x4*)(bias + col0 + bj * HALF + 4 * n);
#pragma unroll
        for (int ai = 0; ai < 2; ++ai)
#pragma unroll
            for (int m = 0; m < 4; ++m) { const int rloc = ai * HALF + m * 16;
#pragma unroll
                for (int bj = 0; bj < 2; ++bj) { f32x4 v0 = acc[ai][bj][m][0] + bv[bj][0], v1 = acc[ai][bj][m][1] + bv[bj][1];
                    if (mode == 3) { __builtin_amdgcn_raw_buffer_store_b128(__builtin_bit_cast(u32x4, v0), rM, voffM, sM + rloc * 1024 + bj * 512, 0); __builtin_amdgcn_raw_buffer_store_b128(__builtin_bit_cast(u32x4, v1), rM, voffM, sM + rloc * 1024 + bj * 512 + 16, 0); }
                    else {
                        if (mode == 1) {
#pragma unroll
                            for (int j = 0; j < 4; ++j) { v0[j] = silu_f(v0[j]); v1[j] = silu_f(v1[j]); } }
                        else if (mode == 2) {
#pragma unroll
                            for (int j = 0; j < 4; ++j) { v0[j] = sigmoid_f(v0[j]); v1[j] = sigmoid_f(v1[j]); } }
                        __builtin_amdgcn_raw_buffer_store_b128(pack8(v0, v1), rP, voffP, sP + rloc * (NP * 2) + bj * 256, 0); } } }
    }
};
struct EpiPlain {
    static constexpr bool PERM = true, AFTER_DRAIN = false;
    bf16_t* O; int ldc;
    __device__ __forceinline__ void operator()(const f32x4 (&acc)[2][2][4][2], const Unit& u, int wr, int wc, int fr, int fq) const {
        const int row0 = u.pm * BM + wr * 64 + fr, col0 = u.pn * BM + wc * 32 + 8 * fq;
#pragma unroll
        for (int ai = 0; ai < 2; ++ai)
#pragma unroll
            for (int m = 0; m < 4; ++m) { bf16_t* rowp = O + (size_t)(row0 + ai * HALF + m * 16) * ldc + col0;
#pragma unroll
                for (int bj = 0; bj < 2; ++bj) *(u32x4*)(rowp + bj * HALF) = pack8(acc[ai][bj][m][0], acc[ai][bj][m][1]); }
    }
};
template <int MODE, bool OUT8> struct EpiGate {
    static constexpr bool PERM = true, AFTER_DRAIN = false;
    void* O; int ldc; const bf16_t* G; int ldg; const bf16_t* Tm; float oscale;
    __device__ __forceinline__ void operator()(const f32x4 (&acc)[2][2][4][2], const Unit& u, int wr, int wc, int fr, int fq) const {
        const int row0 = u.pm * BM + wr * 64 + fr, col0 = u.pn * BM + wc * 32 + 8 * fq;
#pragma unroll
        for (int ai = 0; ai < 2; ++ai)
#pragma unroll
            for (int m = 0; m < 4; ++m) { const size_t row = (size_t)(row0 + ai * HALF + m * 16);
#pragma unroll
                for (int bj = 0; bj < 2; ++bj) {
                    const u32x4 gw = *(const u32x4*)(G + row * ldg + col0 + bj * HALF); f32x4 g0, g1; unpack8(gw, g0, g1);
                    f32x4 v0 = acc[ai][bj][m][0] * g0, v1 = acc[ai][bj][m][1] * g1;
                    if (MODE == 1) { const u32x4 tw = *(const u32x4*)(Tm + row * ldc + col0 + bj * HALF); f32x4 t0, t1; unpack8(tw, t0, t1); v0 += t0; v1 += t1; }
                    if (OUT8) { const float x[8] = {v0[0] * oscale, v0[1] * oscale, v0[2] * oscale, v0[3] * oscale, v1[0] * oscale, v1[1] * oscale, v1[2] * oscale, v1[3] * oscale};
                        *(u32x2*)((unsigned char*)O + row * ldc + col0 + bj * HALF) = pack_fp8x8(x); }
                    else *(u32x4*)((bf16_t*)O + row * ldc + col0 + bj * HALF) = pack8(v0, v1); } }
    }
};
struct EpiOut {
    static constexpr bool PERM = false, AFTER_DRAIN = false;
    bf16_t* Y; const float* X; const float* gate; float alpha;
    __device__ __forceinline__ void operator()(const f32x4 (&acc)[2][2][4][2], const Unit& u, int wr, int wc, int fr, int fq) const {
        const int row0 = u.pm * BM + wr * 64 + fr, col0 = u.pn * BM + wc * 32 + 4 * fq;
        f32x4 gv[2][2];
#pragma unroll
        for (int bj = 0; bj < 2; ++bj)
#pragma unroll
            for (int n = 0; n < 2; ++n) gv[bj][n] = *(const f32x4*)(gate + col0 + bj * HALF + n * 16);
#pragma unroll
        for (int ai = 0; ai < 2; ++ai)
#pragma unroll
            for (int m = 0; m < 4; ++m) { const size_t off = (size_t)(row0 + ai * HALF + m * 16) * DM + col0;
#pragma unroll
                for (int bj = 0; bj < 2; ++bj)
#pragma unroll
                    for (int n = 0; n < 2; ++n) { const f32x4 xv = *(const f32x4*)(X + off + bj * HALF + n * 16); const f32x4 y = xv * alpha + gv[bj][n] * acc[ai][bj][m][n];
                        u32x2 o; o.x = cvt_pk_bf16(y[0], y[1]); o.y = cvt_pk_bf16(y[2], y[3]); *(u32x2*)(Y + off + bj * HALF + n * 16) = o; } }
    }
};

template <class Epi, class Sched, bool ALIGN_EPI = false, bool SP2 = false, bool FP8 = false>
__device__ __forceinline__ void gemm_phase(PG8_LAS unsigned char* lds, const Gemm g, const Sched& S, const Epi& E) {
    int tid = threadIdx.x; asm volatile("" : "+v"(tid));
    const int wid = __builtin_amdgcn_readfirstlane(tid >> 6), lane = tid & 63, wr = wid >> 2, wc = wid & 3, fr = lane & 15, fq = lane >> 4;
    const int K = g.K, nt = K / BK;
    unsigned voffA[2], voffB[2];
#pragma unroll
    for (int i = 0; i < 2; ++i) { int R, C; stage_rc(tid * 16 + i * 8192, R, C); const int Rb = Epi::PERM ? ((R & ~31) + perm32(R & 31)) : R;
        voffA[i] = (unsigned)(R * g.lda + C) * 2u; voffB[i] = (unsigned)(Rb * g.ldb + C) * 2u; }
    const size_t kstep = (size_t)(BK * 2);
    const size_t hstepA = (size_t)HALF * g.lda * 2, hstepB = (size_t)HALF * g.ldb * 2;
    const size_t tstepA = 2 * hstepA, tstepB = 2 * hstepB, pnA = (size_t)g.a_pn_off * 2;
    const unsigned ldsw = (unsigned)wid * 1024u;
    const int aoff = lds_byte(wr * 64 + fr, fq * 8), boff = lds_byte(wc * 32 + fr, fq * 8);
#define PG8_SA(b, h) (((b) * 2 + (h)) * HTB)
#define PG8_SB(b, h) ((4 + (b) * 2 + (h)) * HTB)
#define PG8_STAGE(bufoff, gbase, voff) do { _Pragma("unroll") for (int _i = 0; _i < 2; ++_i) \
        __builtin_amdgcn_global_load_lds((const unsigned*)((const char*)(gbase) + (voff)[_i]), (PG8_LAS unsigned*)(lds + (bufoff) + ldsw + _i * 8192), 16, 0, 0); } while (0)
#define PG8_LDA(dst, b, h) do { _Pragma("unroll") for (int m = 0; m < 4; ++m) { \
        const bf16x8 _l0 = *(const PG8_LAS bf16x8*)(lds + PG8_SA(b, h) + aoff + m * 2048), _l1 = *(const PG8_LAS bf16x8*)(lds + PG8_SA(b, h) + aoff + m * 2048 + 1024); \
        if constexpr (FP8) dst##8[m] = __builtin_shufflevector(__builtin_bit_cast(v4i_t, _l0), __builtin_bit_cast(v4i_t, _l1), 0, 1, 2, 3, 4, 5, 6, 7); else { dst[m][0] = _l0; dst[m][1] = _l1; } } } while (0)
#define PG8_LDB(dst, b, h) do { _Pragma("unroll") for (int n = 0; n < 2; ++n) { \
        const bf16x8 _l0 = *(const PG8_LAS bf16x8*)(lds + PG8_SB(b, h) + boff + n * 2048), _l1 = *(const PG8_LAS bf16x8*)(lds + PG8_SB(b, h) + boff + n * 2048 + 1024); \
        if constexpr (FP8) dst##8[n] = __builtin_shufflevector(__builtin_bit_cast(v4i_t, _l0), __builtin_bit_cast(v4i_t, _l1), 0, 1, 2, 3, 4, 5, 6, 7); else { dst[n][0] = _l0; dst[n][1] = _l1; } } } while (0)
#define PG8_MMA(ai, bj, At, Bt) do { __builtin_amdgcn_s_setprio(1); \
        if constexpr (FP8) { _Pragma("unroll") for (int m = 0; m < 4; ++m) _Pragma("unroll") for (int n = 0; n < 2; ++n) \
            asm volatile("v_mfma_scale_f32_16x16x128_f8f6f4 %0, %1, %2, %0, %3, %4 op_sel_hi:[0,0,0]" : "+v"(acc[ai][bj][m][n]) : "v"(Bt##8[n]), "v"(At##8[m]), "v"(f8_ws), "v"(f8_one)); } \
        else { _Pragma("unroll") for (int m = 0; m < 4; ++m) _Pragma("unroll") for (int n = 0; n < 2; ++n) _Pragma("unroll") for (int k = 0; k < 2; ++k) \
            acc[ai][bj][m][n] = __builtin_amdgcn_mfma_f32_16x16x32_bf16(Bt[n][k], At[m][k], acc[ai][bj][m][n], 0, 0, 0); } \
        __builtin_amdgcn_s_setprio(0); } while (0)
#define PG8_WAIT_V(n) asm volatile("s_waitcnt vmcnt(" #n ")" ::: "memory")
#define PG8_WAIT_L(n) asm volatile("s_waitcnt lgkmcnt(" #n ")" ::: "memory")
#define PG8_BAR __builtin_amdgcn_s_barrier()
#define PG8_SCHED __builtin_amdgcn_sched_barrier(0)
    Unit cur, nxt; int ui = 0;
    if (!S.next(0, cur)) return;
    f32x4 acc[2][2][4][2];
#pragma unroll
    for (int a = 0; a < 2; ++a)
#pragma unroll
        for (int b = 0; b < 2; ++b)
#pragma unroll
            for (int m = 0; m < 4; ++m)
#pragma unroll
                for (int n = 0; n < 2; ++n) acc[a][b][m][n] = (f32x4){0.f, 0.f, 0.f, 0.f};
    const int f8_ws = (int)g.wscale, f8_one = (int)g.ascale;
    bf16x8 At[4][2], B0[2][2], B1[2][2]; v8i_t At8[4], B08[2], B18[2];
    const char* cA = (const char*)g.A + (size_t)cur.pm * tstepA + (size_t)cur.pn * pnA; const char* cB = (const char*)g.Bt + (size_t)cur.pn * tstepB;
    S.a_ready(cur);
    if constexpr (SP2) {
        PG8_STAGE(PG8_SB(0, 0), cB, voffB); PG8_STAGE(PG8_SB(0, 1), cB + hstepB, voffB); PG8_STAGE(PG8_SA(0, 0), cA, voffA); PG8_STAGE(PG8_SA(0, 1), cA + hstepA, voffA);
        if (wr == 1) PG8_BAR;
        PG8_WAIT_V(2); PG8_BAR;
        PG8_STAGE(PG8_SB(1, 0), cB + kstep, voffB); PG8_STAGE(PG8_SA(1, 0), cA + kstep, voffA); PG8_STAGE(PG8_SB(1, 1), cB + hstepB + kstep, voffB);
        PG8_WAIT_V(6); PG8_BAR;
    } else {
        PG8_STAGE(PG8_SB(0, 0), cB, voffB); PG8_STAGE(PG8_SA(0, 0), cA, voffA); PG8_STAGE(PG8_SB(0, 1), cB + hstepB, voffB); PG8_STAGE(PG8_SA(0, 1), cA + hstepA, voffA);
        if (wr == 1) PG8_BAR;
        PG8_WAIT_V(4); PG8_BAR;
        PG8_STAGE(PG8_SB(1, 0), cB + kstep, voffB); PG8_STAGE(PG8_SA(1, 0), cA + kstep, voffA); PG8_STAGE(PG8_SB(1, 1), cB + hstepB + kstep, voffB);
        PG8_WAIT_V(6); PG8_BAR;
    }
    for (;;) {
        const bool has_next = S.next(ui + 1, nxt);
        const char* nA = has_next ? (const char*)g.A + (size_t)nxt.pm * tstepA + (size_t)nxt.pn * pnA : cA; const char* nB = has_next ? (const char*)g.Bt + (size_t)nxt.pn * tstepB : cB;
        for (int t = 0; t < nt; t += 2) {
            const bool last = (t == nt - 2);
            const char* a1 = cA + (size_t)(t + 1) * kstep;
            const char* a2 = last ? nA : cA + (size_t)(t + 2) * kstep; const char* b2 = last ? nB : cB + (size_t)(t + 2) * kstep;
            const char* a3 = a2 + kstep; const char* b3 = b2 + kstep;
            if (last && has_next) S.a_ready(nxt);
            if constexpr (SP2) {
            PG8_LDB(B0, 0, 0); PG8_LDB(B1, 0, 1); PG8_SCHED; PG8_LDA(At, 0, 0); PG8_STAGE(PG8_SA(1, 1), a1 + hstepA, voffA);
            PG8_WAIT_V(8); PG8_WAIT_L(0); PG8_BAR; PG8_MMA(0, 0, At, B0); PG8_MMA(0, 1, At, B1); PG8_BAR; PG8_SCHED;
            PG8_LDA(At, 0, 1); PG8_STAGE(PG8_SB(0, 0), b2, voffB); PG8_STAGE(PG8_SB(0, 1), b2 + hstepB, voffB); PG8_STAGE(PG8_SA(0, 0), a2, voffA);
            PG8_WAIT_V(8); PG8_WAIT_L(0); PG8_BAR; PG8_MMA(1, 0, At, B0); PG8_MMA(1, 1, At, B1); PG8_BAR; PG8_SCHED;
            PG8_LDB(B0, 1, 0); PG8_LDB(B1, 1, 1); PG8_SCHED; PG8_LDA(At, 1, 0); PG8_STAGE(PG8_SA(0, 1), a2 + hstepA, voffA);
            PG8_WAIT_V(8); PG8_WAIT_L(0); PG8_BAR; PG8_MMA(0, 0, At, B0); PG8_MMA(0, 1, At, B1); PG8_BAR; PG8_SCHED;
            PG8_LDA(At, 1, 1); PG8_STAGE(PG8_SB(1, 0), b3, voffB); PG8_STAGE(PG8_SB(1, 1), b3 + hstepB, voffB); PG8_STAGE(PG8_SA(1, 0), a3, voffA);
            PG8_WAIT_V(8); PG8_WAIT_L(0); PG8_BAR; PG8_MMA(1, 0, At, B0); PG8_MMA(1, 1, At, B1); PG8_BAR; PG8_SCHED;
            } else {
            PG8_LDB(B0, 0, 0); PG8_SCHED; PG8_LDA(At, 0, 0); PG8_STAGE(PG8_SA(1, 1), a1 + hstepA, voffA);
            PG8_WAIT_L(8); PG8_BAR; PG8_WAIT_L(0); PG8_MMA(0, 0, At, B0); PG8_BAR; PG8_SCHED;
            PG8_LDB(B1, 0, 1); PG8_STAGE(PG8_SB(0, 0), b2, voffB);
            PG8_BAR; PG8_WAIT_L(0); PG8_MMA(0, 1, At, B1); PG8_BAR;
            PG8_LDA(At, 0, 1); PG8_STAGE(PG8_SA(0, 0), a2, voffA);
            PG8_BAR; PG8_WAIT_L(0); PG8_MMA(1, 0, At, B0); PG8_BAR; PG8_SCHED;
            PG8_STAGE(PG8_SB(0, 1), b2 + hstepB, voffB);
            PG8_WAIT_V(6); PG8_BAR; PG8_MMA(1, 1, At, B1); PG8_BAR;
            PG8_LDB(B0, 1, 0); PG8_SCHED; PG8_LDA(At, 1, 0); PG8_STAGE(PG8_SA(0, 1), a2 + hstepA, voffA);
            PG8_WAIT_L(8); PG8_BAR; PG8_WAIT_L(0); PG8_MMA(0, 0, At, B0); PG8_BAR; PG8_SCHED;
            PG8_LDB(B1, 1, 1); PG8_STAGE(PG8_SB(1, 0), b3, voffB);
            PG8_BAR; PG8_WAIT_L(0); PG8_MMA(0, 1, At, B1); PG8_BAR;
            PG8_LDA(At, 1, 1); PG8_STAGE(PG8_SA(1, 0), a3, voffA);
            PG8_BAR; PG8_WAIT_L(0); PG8_MMA(1, 0, At, B0); PG8_BAR; PG8_SCHED;
            PG8_STAGE(PG8_SB(1, 1), b3 + hstepB, voffB);
            PG8_WAIT_V(6); PG8_BAR; PG8_MMA(1, 1, At, B1); PG8_BAR;
            }
        }
        if constexpr (ALIGN_EPI) { if (wr == 0) PG8_BAR; }
        if constexpr (!Epi::AFTER_DRAIN) { E(acc, cur, wr, wc, fr, fq); S.done(cur); }
        if (!has_next) break;
#pragma unroll
        for (int a = 0; a < 2; ++a)
#pragma unroll
            for (int b = 0; b < 2; ++b)
#pragma unroll
                for (int m = 0; m < 4; ++m)
#pragma unroll
                    for (int n = 0; n < 2; ++n) acc[a][b][m][n] = (f32x4){0.f, 0.f, 0.f, 0.f};
        cur = nxt; cA = nA; cB = nB; ++ui;
        if constexpr (ALIGN_EPI) { if (wr == 1) PG8_BAR; }
    }
    PG8_WAIT_V(0);
    if constexpr (!ALIGN_EPI) { if (wr == 0) PG8_BAR; }
    PG8_BAR;
    if constexpr (Epi::AFTER_DRAIN) { E.fused(acc, cur, wr, wc, fr, fq, lds, wid, lane); S.done(cur); }
#undef PG8_SA
#undef PG8_SB
#undef PG8_STAGE
#undef PG8_LDA
#undef PG8_LDB
#undef PG8_MMA
#undef PG8_WAIT_V
#undef PG8_WAIT_L
#undef PG8_BAR
#undef PG8_SCHED
}
}
#ifndef PG8_SP2
#define PG8_SP2 true
#endif
#ifndef PG8_ALIGN
#define PG8_ALIGN true
#endif

constexpr int NWAVES = 8;
constexpr int RING_OFF = 0, RING_BYTES = 131072;
constexpr int LDSCTL_OFF = RING_BYTES, MISC_OFF = LDSCTL_OFF + 320;
constexpr int LDS_BYTES = 147456;
static_assert(MISC_OFF + 128 <= LDS_BYTES, "LDS map");

#define GAS __attribute__((address_space(1)))
#define LAS __attribute__((address_space(3)))
typedef unsigned short bf16;
typedef unsigned v4u __attribute__((ext_vector_type(4)));
typedef unsigned v2u __attribute__((ext_vector_type(2)));
typedef float f32x4 __attribute__((ext_vector_type(4)));
typedef float f32x16 __attribute__((ext_vector_type(16)));
typedef short bf16x8 __attribute__((ext_vector_type(8)));
typedef short s16x4 __attribute__((ext_vector_type(4)));
typedef GAS unsigned gu32;
#define RLX_AGENT __ATOMIC_RELAXED, __HIP_MEMORY_SCOPE_AGENT
#define LDS_WAIT() asm volatile("s_waitcnt lgkmcnt(0)" ::: "memory")
#define VM_WAIT() asm volatile("s_waitcnt vmcnt(0)" ::: "memory")
#define LDS_BARRIER() do { asm volatile("s_waitcnt lgkmcnt(0)" ::: "memory"); __builtin_amdgcn_s_barrier(); asm volatile("" ::: "memory"); } while (0)
using pg8::pack_fp8x8; using pg8::clamp448; using pg8::cvt_pk_bf16; using pg8::bf_lo; using pg8::bf_hi; using pg8::sigmoid_f; using pg8::silu_f;
#define FR_DPP(v, ctrl) __builtin_bit_cast(float, __builtin_amdgcn_update_dpp(__builtin_bit_cast(int, (float)(v)), __builtin_bit_cast(int, (float)(v)), (ctrl), 0xf, 0xf, false))
#define FR_LANE(v, k) __builtin_bit_cast(float, __builtin_amdgcn_readlane(__builtin_bit_cast(int, (float)(v)), (k)))
__device__ __forceinline__ float wave_sum(float v) {
    v += FR_DPP(v, 0x128); v += FR_DPP(v, 0x124); v += FR_DPP(v, 0x122); v += FR_DPP(v, 0x121);
    return (FR_LANE(v, 0) + FR_LANE(v, 16)) + (FR_LANE(v, 32) + FR_LANE(v, 48));
}
__device__ __forceinline__ float wave_max(float v) {
    v = fmaxf(v, FR_DPP(v, 0x128)); v = fmaxf(v, FR_DPP(v, 0x124)); v = fmaxf(v, FR_DPP(v, 0x122)); v = fmaxf(v, FR_DPP(v, 0x121));
    return fmaxf(fmaxf(FR_LANE(v, 0), FR_LANE(v, 16)), fmaxf(FR_LANE(v, 32), FR_LANE(v, 48)));
}
#define XB_TMO      128
#define XB_XCNT(j)  (256  + 64 * (j))
#define XB_XSUB(j)  (1280 + 64 * (j))
#define XB_XGEN(j)  (2304 + 64 * (j))
#define XB_TOP      3328
#define XB_TOPGEN   3392
#define XCD_BAR_WORDS 3456
#define XB_SPIN_CAP (1u << 18)

__device__ __forceinline__ unsigned xb_ld(unsigned* p)              { return __hip_atomic_load(p, __ATOMIC_RELAXED, __HIP_MEMORY_SCOPE_AGENT); }
__device__ __forceinline__ unsigned xb_add(unsigned* p, unsigned v) { return __hip_atomic_fetch_add(p, v, __ATOMIC_RELAXED, __HIP_MEMORY_SCOPE_AGENT); }
__device__ __forceinline__ unsigned xb_xcc_id() { return (unsigned)__builtin_amdgcn_s_getreg((3 << 11) | 20) & 0xFu; }
#define XB_SPIN(cond, bar) do { unsigned _sp = 0; while (cond) { __builtin_amdgcn_s_sleep(1); \
    if ((++_sp & 255u) == 0u) { if (xb_ld(&(bar)[XB_TMO])) break; if (_sp > XB_SPIN_CAP) { atomicAdd(&(bar)[XB_TMO], 1u); break; } } } } while (0)

struct XcdBarrier {
    unsigned* bar; unsigned x;
    volatile LAS unsigned* st;
};

__device__ __forceinline__ XcdBarrier xcd_barrier_post(unsigned* bar, volatile LAS unsigned* st) {
    XcdBarrier b; b.bar = bar; b.x = xb_xcc_id(); b.st = st;
    if (threadIdx.x == 0) (void)xb_add(&bar[XB_XCNT(b.x)], 1u);
    return b;
}
__device__ __forceinline__ void xcd_barrier_complete(unsigned* bar, unsigned x, unsigned& nloc, unsigned& nx) {
    const unsigned G = gridDim.x * gridDim.y * gridDim.z;
    unsigned sum, cnt, mine, sp = 0u;
    for (;;) {
        sum = 0u; cnt = 0u; mine = 0u;
#pragma unroll
        for (unsigned j = 0; j < 16; ++j) { const unsigned c = xb_ld(&bar[XB_XCNT(j)]); sum += c; cnt += (c > 0u) ? 1u : 0u; mine = (j == x) ? c : mine; }
        if (sum == G) break;
        __builtin_amdgcn_s_sleep(1);
        if ((++sp & 255u) == 0u) { if (xb_ld(&bar[XB_TMO])) break; if (sp > XB_SPIN_CAP) { atomicAdd(&bar[XB_TMO], 1u); break; } }
    }
    nloc = mine > 0u ? mine : 1u; nx = cnt > 0u ? cnt : 1u;
}

__device__ __forceinline__ void xcd_barrier(const XcdBarrier& b) {
    asm volatile("s_waitcnt vmcnt(0)" ::: "memory");
    __syncthreads();
    if (threadIdx.x == 0) {
        unsigned* bar = b.bar;
        __builtin_amdgcn_s_waitcnt(0);
        unsigned nloc = b.st[0], nx = b.st[1];
        if (nloc == 0u) { xcd_barrier_complete(bar, b.x, nloc, nx); b.st[0] = nloc; b.st[1] = nx; }
        const unsigned old = xb_add(&bar[XB_XSUB(b.x)], 1u);
        const unsigned gen = old / nloc;
        if (old + 1u == (gen + 1u) * nloc) {
            __builtin_amdgcn_fence(__ATOMIC_RELEASE, "agent");
            asm volatile("s_waitcnt vmcnt(0)" ::: "memory");
            const unsigned og = xb_add(&bar[XB_TOP], 1u);
            const unsigned tg = og / nx;
            if (og + 1u == (tg + 1u) * nx) xb_add(&bar[XB_TOPGEN], 1u);
            else XB_SPIN(xb_ld(&bar[XB_TOPGEN]) == tg, bar);
            __builtin_amdgcn_fence(__ATOMIC_ACQUIRE, "agent");
            xb_add(&bar[XB_XGEN(b.x)], 1u);
            asm volatile("s_waitcnt vmcnt(0)" ::: "memory");
        } else {
            XB_SPIN(xb_ld(&bar[XB_XGEN(b.x)]) == gen, bar);
            __builtin_amdgcn_fence(__ATOMIC_ACQUIRE, "agent");
            asm volatile("s_waitcnt vmcnt(0)" ::: "memory");
        }
    }
    __syncthreads();
}
struct Args { const float* in[22]; float* out; unsigned char* ws; int ph_lo, ph_hi, li, pad; };
enum { I_X = 0, I_C, I_WADA, I_BADA, I_WIN, I_BIN, I_GQ, I_GKV, I_WUQ, I_WIQ, I_WUK, I_WUV, I_GKIDX, I_BKIDX, I_CONVW, I_CONVB, I_GMH, I_WAO, I_WMO, I_WOUT, I_LNG, I_LNB };

__device__ __forceinline__ void tr_item(const float* src, int src_ld, int nvalid, bf16* dst, int dst_ld, LAS float* scr, int lane) {
    const int n = lane & 31;
#pragma unroll 8
    for (int i = 0; i < 32; ++i) { const int kk = 2 * i + (lane >> 5); scr[kk * 33 + n] = (n < nvalid) ? src[(size_t)kk * src_ld + n] : 0.f; }
    LDS_WAIT(); asm volatile("" ::: "memory");
    const int c = lane & 7;
#pragma unroll
    for (int j = 0; j < 4; ++j) { const int nn = (lane >> 3) + 8 * j; const LAS float* s = scr + (8 * c) * 33 + nn;
        v4u o; o.x = cvt_pk_bf16(s[0 * 33], s[1 * 33]); o.y = cvt_pk_bf16(s[2 * 33], s[3 * 33]); o.z = cvt_pk_bf16(s[4 * 33], s[5 * 33]); o.w = cvt_pk_bf16(s[6 * 33], s[7 * 33]);
        *(v4u*)(dst + (size_t)nn * dst_ld + 8 * c) = o; }
    LDS_WAIT(); asm volatile("" ::: "memory");
}
__device__ __forceinline__ void tr_item64(const float* src_k0, int src_ld, int srccol, bf16* dst_n0k0, int dst_ld, LAS unsigned char* scr, int lane) {
    f32x4 v[16];
    const float* sp = src_k0 + (size_t)(lane >> 4) * src_ld + (srccol >= 0 ? srccol : 0);
#pragma unroll
    for (int i = 0; i < 16; ++i) v[i] = *(const f32x4*)(sp + (size_t)(4 * i) * src_ld);
    const bool pad = srccol < 0;
#pragma unroll
    for (int i = 0; i < 16; ++i) { v2u o; o.x = cvt_pk_bf16(v[i][0], v[i][1]); o.y = cvt_pk_bf16(v[i][2], v[i][3]); if (pad) { o.x = 0u; o.y = 0u; }
        *(LAS v2u*)(scr + (4 * i + (lane >> 4)) * 136 + (lane & 15) * 8) = o; }
    LDS_WAIT(); asm volatile("" ::: "memory");
    const int g = lane >> 4, q = (lane & 15) >> 2, p = lane & 3;
#pragma unroll
    for (int c = 0; c < 4; ++c)
#pragma unroll
        for (int ks = 0; ks < 2; ++ks) { const LAS unsigned char* p0 = scr + (32 * ks + 8 * g + q) * 136 + (16 * c + 4 * p) * 2;
            const s16x4 a = __builtin_amdgcn_ds_read_tr16_b64_v4i16((LAS s16x4*)p0), b = __builtin_amdgcn_ds_read_tr16_b64_v4i16((LAS s16x4*)(p0 + 4 * 136));
            const bf16x8 o = (bf16x8){a[0], a[1], a[2], a[3], b[0], b[1], b[2], b[3]};
            *(bf16x8*)(dst_n0k0 + (size_t)(16 * c + (lane & 15)) * dst_ld + 32 * ks + 8 * g) = o; }
    LDS_WAIT(); asm volatile("" ::: "memory");
}
__device__ __forceinline__ void tr_item64_f8(const float* src_k0, int src_ld, int srccol, unsigned char* dst_n0k0, int dst_ld, float scale, LAS unsigned char* scr, int lane) {
    f32x4 v[16];
    const float* sp = src_k0 + (size_t)(lane >> 4) * src_ld + (srccol >= 0 ? srccol : 0);
#pragma unroll
    for (int i = 0; i < 16; ++i) v[i] = *(const f32x4*)(sp + (size_t)(4 * i) * src_ld);
    const bool pad = srccol < 0;
#pragma unroll
    for (int i = 0; i < 16; ++i) { v2u o; o.x = cvt_pk_bf16(v[i][0] * scale, v[i][1] * scale); o.y = cvt_pk_bf16(v[i][2] * scale, v[i][3] * scale); if (pad) { o.x = 0u; o.y = 0u; }
        *(LAS v2u*)(scr + (4 * i + (lane >> 4)) * 136 + (lane & 15) * 8) = o; }
    LDS_WAIT(); asm volatile("" ::: "memory");
    const int g = lane >> 4, q = (lane & 15) >> 2, p = lane & 3;
#pragma unroll
    for (int c = 0; c < 4; ++c)
#pragma unroll
        for (int ks = 0; ks < 2; ++ks) { const LAS unsigned char* p0 = scr + (32 * ks + 8 * g + q) * 136 + (16 * c + 4 * p) * 2;
            const s16x4 a = __builtin_amdgcn_ds_read_tr16_b64_v4i16((LAS s16x4*)p0), b = __builtin_amdgcn_ds_read_tr16_b64_v4i16((LAS s16x4*)(p0 + 4 * 136));
            const float x[8] = {bf_lo((unsigned)(unsigned short)a[0]), bf_lo((unsigned)(unsigned short)a[1]), bf_lo((unsigned)(unsigned short)a[2]), bf_lo((unsigned)(unsigned short)a[3]),
                                bf_lo((unsigned)(unsigned short)b[0]), bf_lo((unsigned)(unsigned short)b[1]), bf_lo((unsigned)(unsigned short)b[2]), bf_lo((unsigned)(unsigned short)b[3])};
            *(v2u*)(dst_n0k0 + (size_t)(16 * c + (lane & 15)) * dst_ld + 32 * ks + 8 * g) = pack_fp8x8(x); }
    LDS_WAIT(); asm volatile("" ::: "memory");
}
__device__ __forceinline__ int win_src_col(int nd, int& nvalid) {
    nvalid = 32;
    if (nd < PC_MISC) return nd;
    if (nd < PC_ZA) { const int j = (nd - PC_MISC) >> 5; if (j < 2) return 1536 + 32 * j; if (j == 2) return 1600; if (j == 3) { nvalid = 16; return 18016; } nvalid = 0; return 0; }
    if (nd < PC_ZM) return 1632 + (nd - PC_ZA);
    return 18032 + (nd - PC_ZM);
}
__device__ __forceinline__ int win_src_col1(int nd) {
    if (nd < PC_MISC) return nd;
    if (nd < PC_ZA) { const int j = nd - PC_MISC; if (j < 64) return 1536 + j; if (j < 96) return 1600 + (j - 64); if (j < 112) return 18016 + (j - 96); return -1; }
    if (nd < PC_ZM) return 1632 + (nd - PC_ZA);
    return 18032 + (nd - PC_ZM);
}

constexpr int TRI_IN = 64 * (NP / 64), TRI_IQ = 16 * 32, TRI_UV = 32 * 8 * 2, TRI_SQ = 64 * 64, TRI_N = TRI_IN + TRI_IQ + TRI_UV + 3 * TRI_SQ;
__device__ __forceinline__ void tri_load16(f32x4 (&v)[16], int it, bool& pad, int lane, const float* pWIN, const float* pWIQ, const float* pWUV, const float* pWAO, const float* pWMO, const float* pWOUT) {
    const int lc = (lane & 15) * 4; const float* sp; int ld, col; int r = it;
    if (r < TRI_IN) { const int nb = r >> 6, kb = r & 63; sp = pWIN + (size_t)(kb * 64) * NSRC; ld = NSRC; col = win_src_col1(nb * 64 + lc); }
    else { r -= TRI_IN;
        if (r < TRI_IQ) { const int nb = r >> 4, kb = r & 15; sp = pWIQ + (size_t)(kb * 64) * 2048; ld = 2048; col = nb * 64 + lc; }
        else { r -= TRI_IQ;
            if (r < TRI_UV) { const int h = r >> 4, kb = (r >> 1) & 7, nb = r & 1; sp = pWUV + (size_t)h * 65536 + (size_t)(kb * 64) * 128; ld = 128; col = nb * 64 + lc; }
            else { r -= TRI_UV; const int wsel = r / TRI_SQ; r -= wsel * TRI_SQ; const int nb = r >> 6, kb = r & 63;
                sp = (wsel == 0 ? pWAO : (wsel == 1 ? pWMO : pWOUT)) + (size_t)(kb * 64) * 4096; ld = 4096; col = nb * 64 + lc; } } }
    pad = col < 0;
    const float* q = sp + (size_t)(lane >> 4) * ld + (col >= 0 ? col : 0);
#pragma unroll
    for (int i = 0; i < 16; ++i) v[i] = *(const f32x4*)(q + (size_t)(4 * i) * ld);
}
__device__ __forceinline__ void tri_finish(f32x4 (&v)[16], int it, bool pad, int lane, unsigned char* wsb, LAS unsigned char* scr) {
    int r = it; bool f8 = false; unsigned char* dst; int dld;
    if (r < TRI_IN) { const int nb = r >> 6, kb = r & 63; if (nb < 28) { dst = wsb + WS_WINT + ((size_t)(nb * 64) * 4096 + kb * 64) * 2; dld = 4096; } else { f8 = true; dst = wsb + WS_WINT8 + (size_t)(nb * 64 - 1792) * 4096 + kb * 64; dld = 4096; } }
    else { r -= TRI_IN;
        if (r < TRI_IQ) { const int nb = r >> 4, kb = r & 15; dst = wsb + WS_WIQT + ((size_t)(nb * 64) * 1024 + kb * 64) * 2; dld = 1024; }
        else { r -= TRI_IQ;
            if (r < TRI_UV) { const int h = r >> 4, kb = (r >> 1) & 7, nb = r & 1; dst = wsb + WS_WUVT + ((size_t)(256 * (h >> 1) + 128 * (h & 1) + nb * 64) * 1024 + 512 * (h & 1) + kb * 64) * 2; dld = 1024; }
            else { r -= TRI_UV; const int wsel = r / TRI_SQ; r -= wsel * TRI_SQ; const int nb = r >> 6, kb = r & 63; f8 = true;
                dst = wsb + (wsel == 0 ? WS_WAOT : (wsel == 1 ? WS_WMOT : WS_WOT)) + (size_t)(nb * 64) * 4096 + kb * 64; dld = 4096; } } }
    const float scale = f8 ? 64.0f : 1.0f;
#pragma unroll
    for (int i = 0; i < 16; ++i) { v2u o; o.x = cvt_pk_bf16(v[i][0] * scale, v[i][1] * scale); o.y = cvt_pk_bf16(v[i][2] * scale, v[i][3] * scale); if (pad) { o.x = 0u; o.y = 0u; }
        *(LAS v2u*)(scr + (4 * i + (lane >> 4)) * 136 + (lane & 15) * 8) = o; }
    LDS_WAIT(); asm volatile("" ::: "memory");
    const int g = lane >> 4, q = (lane & 15) >> 2, pp = lane & 3;
#pragma unroll
    for (int c = 0; c < 4; ++c)
#pragma unroll
        for (int ks = 0; ks < 2; ++ks) { const LAS unsigned char* p0 = scr + (32 * ks + 8 * g + q) * 136 + (16 * c + 4 * pp) * 2;
            const s16x4 a = __builtin_amdgcn_ds_read_tr16_b64_v4i16((LAS s16x4*)p0), b = __builtin_amdgcn_ds_read_tr16_b64_v4i16((LAS s16x4*)(p0 + 4 * 136));
            const size_t eo = (size_t)(16 * c + (lane & 15)) * dld + 32 * ks + 8 * g;
            if (f8) { const float x[8] = {bf_lo((unsigned)(unsigned short)a[0]), bf_lo((unsigned)(unsigned short)a[1]), bf_lo((unsigned)(unsigned short)a[2]), bf_lo((unsigned)(unsigned short)a[3]),
                                          bf_lo((unsigned)(unsigned short)b[0]), bf_lo((unsigned)(unsigned short)b[1]), bf_lo((unsigned)(unsigned short)b[2]), bf_lo((unsigned)(unsigned short)b[3])};
                *(v2u*)(dst + eo) = pack_fp8x8(x); }
            else *(bf16x8*)(dst + eo * 2) = (bf16x8){a[0], a[1], a[2], a[3], b[0], b[1], b[2], b[3]}; }
    LDS_WAIT(); asm volatile("" ::: "memory");
}
struct Frame {
    LAS unsigned char* lds; int tid, lane, wave, G, bid;
    const float *p_I_X, *p_I_C, *p_I_WADA, *p_I_BADA, *p_I_WIN, *p_I_BIN, *p_I_GQ, *p_I_GKV, *p_I_WUQ, *p_I_WIQ, *p_I_WUK, *p_I_WUV, *p_I_GKIDX, *p_I_BKIDX, *p_I_CONVW, *p_I_CONVB, *p_I_GMH, *p_I_WAO, *p_I_WMO, *p_I_WOUT, *p_I_LNG, *p_I_LNB;
    float* out; unsigned char* ws;
};

__device__ __forceinline__ void phase0(Frame& F) {
    float* MOD = (float*)(F.ws + WS_MOD); float* BIASP = MOD + 16384;
    {
        LAS float* red = (LAS float*)F.lds;
        LAS float* sc_ = (LAS float*)(F.lds + 8192);
        const float* w_ada = F.p_I_WADA; const float* cvec = F.p_I_C; const float* b_ada = F.p_I_BADA;
        for (int k = F.tid; k < 4096; k += 512) { const float cv = cvec[k]; sc_[k] = cv / (1.0f + __expf(-cv)); }
        __syncthreads();
        for (int cb = F.bid; cb < 256; cb += F.G) {
            if (F.tid < 384) {
                const int kg = F.tid / 12, c4 = F.tid % 12;
                const float* w = w_ada + (size_t)(kg * 128) * 12288 + cb * 48 + c4 * 4; const LAS float* cc = sc_ + kg * 128;
                f32x4 acc = (f32x4){0.f, 0.f, 0.f, 0.f};
#pragma unroll 16
                for (int k = 0; k < 128; ++k) { const f32x4 wv = *(const f32x4*)(w + (size_t)k * 12288); acc += wv * cc[k]; }
                *(LAS f32x4*)(red + kg * 48 + c4 * 4) = acc;
            }
            __syncthreads();
            if (F.tid < 48) { float s = b_ada[cb * 48 + F.tid];
                for (int g = 0; g < 32; ++g) s += red[g * 48 + F.tid];
                MOD[cb * 48 + F.tid] = s; }
            __syncthreads();
        }
    }
    const bool qabs_late = (F.wave & 1) != 0;
    for (int pass = 0; pass < 2; ++pass) {
    if ((pass == 0) != qabs_late)
    {
        const float* w_uq = F.p_I_WUQ; const float* w_uk = F.p_I_WUK; bf16* WQT = (bf16*)(F.ws + WS_WQT);
        const int gw = F.bid * NWAVES + F.wave, NGW = F.G * NWAVES, quad = F.lane >> 4, r16 = F.lane & 15;
        for (int it = gw; it < 2048; it += NGW) {
            const int h = it >> 6, rt = (it >> 1) & 31, kh = it & 1;
            bf16x8 ah[4], al[4];
#pragma unroll
            for (int ks = 0; ks < 4; ++ks) { float x[8]; unsigned hi[4], lo[4];
#pragma unroll
                for (int j = 0; j < 8; ++j) x[j] = w_uk[(size_t)h * 65536 + (size_t)(ks * 32 + quad * 8 + j) * 512 + rt * 16 + r16];
#pragma unroll
                for (int j = 0; j < 4; ++j) { hi[j] = cvt_pk_bf16(x[2 * j], x[2 * j + 1]); lo[j] = cvt_pk_bf16(x[2 * j] - bf_lo(hi[j]), x[2 * j + 1] - bf_hi(hi[j])); }
                ah[ks] = __builtin_bit_cast(bf16x8, (v4u){hi[0], hi[1], hi[2], hi[3]}); al[ks] = __builtin_bit_cast(bf16x8, (v4u){lo[0], lo[1], lo[2], lo[3]}); }
#pragma unroll 2
            for (int nt = 0; nt < 32; ++nt) {
                const float* bp = w_uq + (size_t)(kh * 512 + nt * 16 + r16) * 4096 + h * 128 + quad * 8;
                f32x4 acc = (f32x4){0.f, 0.f, 0.f, 0.f};
#pragma unroll
                for (int ks = 0; ks < 4; ++ks) { const f32x4 b0 = *(const f32x4*)(bp + ks * 32), b1 = *(const f32x4*)(bp + ks * 32 + 4);
                    unsigned hi[4], lo[4];
                    hi[0] = cvt_pk_bf16(b0[0], b0[1]); hi[1] = cvt_pk_bf16(b0[2], b0[3]); hi[2] = cvt_pk_bf16(b1[0], b1[1]); hi[3] = cvt_pk_bf16(b1[2], b1[3]);
                    lo[0] = cvt_pk_bf16(b0[0] - bf_lo(hi[0]), b0[1] - bf_hi(hi[0])); lo[1] = cvt_pk_bf16(b0[2] - bf_lo(hi[1]), b0[3] - bf_hi(hi[1]));
                    lo[2] = cvt_pk_bf16(b1[0] - bf_lo(hi[2]), b1[1] - bf_hi(hi[2])); lo[3] = cvt_pk_bf16(b1[2] - bf_lo(hi[3]), b1[3] - bf_hi(hi[3]));
                    const bf16x8 bh = __builtin_bit_cast(bf16x8, (v4u){hi[0], hi[1], hi[2], hi[3]}), bl = __builtin_bit_cast(bf16x8, (v4u){lo[0], lo[1], lo[2], lo[3]});
                    acc = __builtin_amdgcn_mfma_f32_16x16x32_bf16(ah[ks], bh, acc, 0, 0, 0);
                    acc = __builtin_amdgcn_mfma_f32_16x16x32_bf16(ah[ks], bl, acc, 0, 0, 0);
                    acc = __builtin_amdgcn_mfma_f32_16x16x32_bf16(al[ks], bh, acc, 0, 0, 0); }
#pragma unroll
                for (int i = 0; i < 4; ++i) ((unsigned char*)WQT)[(size_t)(h * 512 + rt * 16 + quad * 4 + i) * 1024 + kh * 512 + nt * 16 + r16] = (unsigned char)(__builtin_amdgcn_cvt_pk_fp8_f32(clamp448(acc[i] * 64.0f), 0.f, 0, false) & 0xff);
            }
        }
    }
    if (pass == 0)
    {
        LAS unsigned char* scr = F.lds + F.wave * 16384;
        const int gw = F.bid * NWAVES + F.wave, NGW = F.G * NWAVES, lane = F.lane;
        bf16* WUVT = (bf16*)(F.ws + WS_WUVT);
        const float* const pWIN = F.p_I_WIN; const float* const pWIQ = F.p_I_WIQ; const float* const pWUV = F.p_I_WUV; const float* const pWAO = F.p_I_WAO; const float* const pWMO = F.p_I_WMO; const float* const pWOUT = F.p_I_WOUT;
        unsigned char* const wsb = F.ws;
        f32x4 vA[16], vB[16]; bool padA = false, padB = false;
        int it = gw;
        if (it < TRI_N) tri_load16(vA, it, padA, lane, pWIN, pWIQ, pWUV, pWAO, pWMO, pWOUT);
        for (; it < TRI_N; it += 2 * NGW) {
            if (it + NGW < TRI_N) tri_load16(vB, it + NGW, padB, lane, pWIN, pWIQ, pWUV, pWAO, pWMO, pWOUT);
            tri_finish(vA, it, padA, lane, wsb, scr);
            if (it + 2 * NGW < TRI_N) tri_load16(vA, it + 2 * NGW, padA, lane, pWIN, pWIQ, pWUV, pWAO, pWMO, pWOUT);
            if (it + NGW < TRI_N) tri_finish(vB, it + NGW, padB, lane, wsb, scr);
        }
        for (int n = gw; n < 4096; n += NGW) { const int hsel = (n >> 7) & 1; *(v4u*)(WUVT + (size_t)n * 1024 + 512 * (1 - hsel) + F.lane * 8) = (v4u){0u, 0u, 0u, 0u}; }
        const float* b_in = F.p_I_BIN;
        for (int n = gw * 64 + F.lane; n < NP; n += NGW * 64) { const int s = win_src_col1(n); BIASP[n] = s >= 0 ? b_in[s] : 0.f; }
    }
    }
}

__device__ __forceinline__ void phase1(Frame& F) {
    const float* MOD = (const float*)(F.ws + WS_MOD); const float* x = F.p_I_X; bf16* U = (bf16*)(F.ws + WS_U);
    const size_t nvec = (size_t)T_SEQ * DM / 8;
    const int col = F.tid * 8;
    const f32x4 sh0 = *(const f32x4*)(MOD + col), sh1 = *(const f32x4*)(MOD + col + 4), sc0 = *(const f32x4*)(MOD + 4096 + col) + 1.0f, sc1 = *(const f32x4*)(MOD + 4096 + col + 4) + 1.0f;
#pragma unroll 4
    for (size_t i = (size_t)F.bid * 512 + F.tid; i < nvec; i += (size_t)F.G * 512) {
        const f32x4 x0 = *(const f32x4*)(x + i * 8), x1 = *(const f32x4*)(x + i * 8 + 4);
        const f32x4 u0 = x0 * sc0 + sh0, u1 = x1 * sc1 + sh1;
        *(v4u*)(U + i * 8) = pg8::pack8(u0, u1);
        { const float xx[8] = {u0[0], u0[1], u0[2], u0[3], u1[0], u1[1], u1[2], u1[3]}; *(v2u*)(F.ws + WS_U8 + i * 8) = pack_fp8x8(xx); }
    }
}

__device__ __forceinline__ void phase3(Frame& F) {
    const bf16* P = (const bf16*)(F.ws + WS_P); const float* MISC = (const float*)(F.ws + WS_MISC);
    bf16* CQ = (bf16*)(F.ws + WS_CQ); bf16* CKV = (bf16*)(F.ws + WS_CKV); bf16* KI = (bf16*)(F.ws + WS_KI); float* WI = (float*)(F.ws + WS_WI);
    float* IG = (float*)(F.ws + WS_IG); float* LF = (float*)(F.ws + WS_LF); bf16* QM = (bf16*)(F.ws + WS_QM); bf16* KM = (bf16*)(F.ws + WS_KM);
    const float* g_q = F.p_I_GQ; const float* g_kv = F.p_I_GKV; const float* g_kidx = F.p_I_GKIDX; const float* b_kidx = F.p_I_BKIDX;
    const float* conv_w = F.p_I_CONVW; const float* conv_b = F.p_I_CONVB;
    const int gw = F.bid * NWAVES + F.wave, NGW = F.G * NWAVES, lane = F.lane;
    f32x4 gq_[4]; const f32x4 gkv0 = *(const f32x4*)(g_kv + lane * 8), gkv1 = *(const f32x4*)(g_kv + lane * 8 + 4); const float gki = g_kidx[lane], bki = b_kidx[lane];
#pragma unroll
    for (int j = 0; j < 2; ++j) { gq_[2 * j] = *(const f32x4*)(g_q + j * 512 + lane * 8); gq_[2 * j + 1] = *(const f32x4*)(g_q + j * 512 + lane * 8 + 4); }
    for (int t = gw; t < T_SEQ; t += NGW) {
        const bf16* prow = P + (size_t)t * NP;
        { f32x4 a[4]; float ss = 0.f;
#pragma unroll
          for (int j = 0; j < 2; ++j) { const v4u w = *(const v4u*)(prow + PC_QLAT + j * 512 + lane * 8); pg8::unpack8(w, a[2 * j], a[2 * j + 1]); }
#pragma unroll
          for (int j = 0; j < 4; ++j) ss += (a[j][0] * a[j][0] + a[j][1] * a[j][1]) + (a[j][2] * a[j][2] + a[j][3] * a[j][3]);
          const float rstd = rsqrtf(wave_sum(ss) * (1.0f / 1024.0f) + NORM_EPS);
#pragma unroll
          for (int j = 0; j < 2; ++j) { const int c = j * 512 + lane * 8; const f32x4 g0 = gq_[2 * j], g1 = gq_[2 * j + 1];
              const f32x4 y0 = a[2 * j] * rstd * g0, y1 = a[2 * j + 1] * rstd * g1;
              *(v4u*)(CQ + (size_t)t * 1024 + c) = pg8::pack8(y0, y1);
              { const float x[8] = {y0[0], y0[1], y0[2], y0[3], y1[0], y1[1], y1[2], y1[3]}; *(v2u*)(F.ws + WS_CQ8 + (size_t)t * 1024 + c) = pack_fp8x8(x); } } }
        { f32x4 a0, a1; const v4u w = *(const v4u*)(prow + PC_KV + lane * 8); pg8::unpack8(w, a0, a1);
          const float ss = (a0[0] * a0[0] + a0[1] * a0[1]) + (a0[2] * a0[2] + a0[3] * a0[3]) + (a1[0] * a1[0] + a1[1] * a1[1]) + (a1[2] * a1[2] + a1[3] * a1[3]);
          const float rstd = rsqrtf(wave_sum(ss) * (1.0f / 512.0f) + NORM_EPS);
          *(v4u*)(CKV + (size_t)t * 512 + lane * 8) = pg8::pack8(a0 * rstd * gkv0, a1 * rstd * gkv1); }
        { const float* mrow = MISC + (size_t)t * 256;
          const float kv = mrow[lane]; const float mu = wave_sum(kv) * (1.0f / 64.0f); const float dlt = kv - mu; const float var = wave_sum(dlt * dlt) * (1.0f / 64.0f);
          const float y = dlt * rsqrtf(var + NORM_EPS) * gki + bki;
          KI[(size_t)t * 64 + lane] = (bf16)(cvt_pk_bf16(y, 0.f) & 0xffffu);
          if (lane < 32) WI[(size_t)t * 32 + lane] = mrow[64 + lane] * 0.022097086912079608f;
          if (lane < 16) { const float gpre = mrow[96 + lane]; const float sc = SOFTCAP * tanhf(gpre * (1.0f / SOFTCAP));
              if (lane < 8) IG[(size_t)t * 8 + lane] = sc;
              else { const float ls = fminf(sc, 0.f) - log1pf(__expf(-fabsf(sc))); LF[(size_t)t * 8 + lane - 8] = ls; } } }
    }
    for (int it = gw; it < 8 * (T_SEQ / 32); it += NGW) {
        const int j = it & 7, t0 = (it >> 3) * 32, c = j * 512 + lane * 8;
        f32x4 w0[4], w1[4];
#pragma unroll
        for (int w = 0; w < 4; ++w) { w0[w] = *(const f32x4*)(conv_w + w * 4096 + c); w1[w] = *(const f32x4*)(conv_w + w * 4096 + c + 4); }
        const f32x4 b0 = *(const f32x4*)(conv_b + c), b1 = *(const f32x4*)(conv_b + c + 4);
        v4u rows[35];
#pragma unroll
        for (int r = 0; r < 35; ++r) { const int tt = t0 - 3 + r; rows[r] = (tt >= 0) ? *(const v4u*)(P + (size_t)tt * NP + PC_QK + c) : (v4u){0u, 0u, 0u, 0u}; }
#pragma unroll
        for (int r = 0; r < 32; ++r) { f32x4 s0 = b0, s1 = b1;
#pragma unroll
            for (int w = 0; w < 4; ++w) { f32x4 a0, a1; pg8::unpack8(rows[r + w], a0, a1); s0 += a0 * w0[w]; s1 += a1 * w1[w]; }
#pragma unroll
            for (int e = 0; e < 4; ++e) { s0[e] = silu_f(s0[e]); s1[e] = silu_f(s1[e]); }
            if (c < 2048) *(v4u*)(QM + (size_t)(t0 + r) * 2048 + c) = pg8::pack8(s0, s1);
            else *(v4u*)(KM + (size_t)(t0 + r) * 2048 + (c - 2048)) = pg8::pack8(s0 * 0.0625f, s1 * 0.0625f); }
    }
}

__device__ __forceinline__ void phase5(Frame& F) {
    const bf16* QA = (const bf16*)(F.ws + WS_QA); const bf16* KI = (const bf16*)(F.ws + WS_KI); const float* WI = (const float*)(F.ws + WS_WI); float* SC = (float*)(F.ws + WS_SC);
    const int gw = F.bid * NWAVES + F.wave, NGW = F.G * NWAVES, lane = F.lane, r = lane & 31, h = lane >> 5;
    for (int qi = gw; qi < T_SEQ; qi += NGW) {
        const int grp = qi / NGW, j = qi % NGW; int t;
        if (NGW * 4 == T_SEQ) t = (grp == 0) ? j : (grp == 1) ? (T_SEQ / 2 - 1 - j) : (grp == 2) ? (T_SEQ / 2 + j) : (T_SEQ - 1 - j); else t = qi;
        bf16x8 a[4]; float wv[16];
#pragma unroll
        for (int ks = 0; ks < 4; ++ks) a[ks] = *(const bf16x8*)(QA + (size_t)t * NQA + 16384 + r * 64 + ks * 16 + h * 8);
#pragma unroll
        for (int i = 0; i < 16; ++i) wv[i] = WI[(size_t)t * 32 + (i & 3) + 8 * (i >> 2) + 4 * h];
        const int nkb = t / 32 + 1;
        for (int kb = 0; kb < nkb; ++kb) {
            const bf16* kp = KI + (size_t)(kb * 32 + r) * 64 + h * 8;
            f32x16 acc;
#pragma unroll
            for (int i = 0; i < 16; ++i) acc[i] = 0.f;
#pragma unroll
            for (int ks = 0; ks < 4; ++ks) { const bf16x8 b = *(const bf16x8*)(kp + ks * 16); acc = __builtin_amdgcn_mfma_f32_32x32x16_bf16(a[ks], b, acc, 0, 0, 0); }
            float s = 0.f;
#pragma unroll
            for (int i = 0; i < 16; ++i) s += wv[i] * fmaxf(acc[i], 0.f);
            s += __shfl_xor(s, 32);
            if (lane < 32) SC[(size_t)t * T_SEQ + kb * 32 + lane] = s;
        }
    }
}

__device__ __forceinline__ unsigned f2key(float f) { const unsigned u = __float_as_uint(f); return (u & 0x80000000u) ? ~u : (u | 0x80000000u); }
__device__ __forceinline__ int select_topk(Frame& F, const float* row, int n, LAS unsigned* w, LAS int* idx) {
    LAS unsigned* hist = w; LAS unsigned* bmg = w + 256; LAS unsigned* bme = w + 512; LAS unsigned* scan = w + 768; LAS unsigned* ctl = w + 800;
    const int tid = F.tid;
    if (n <= TOPK) { if (tid < TOPK) idx[tid] = tid < n ? tid : 0; __syncthreads(); return n; }
    unsigned prefix = 0u, mask = 0u, kth = TOPK;
#pragma unroll 1
    for (int pass = 0; pass < 4; ++pass) {
        const int shift = 24 - 8 * pass;
        if (tid < 256) hist[tid] = 0u;
        __syncthreads();
        for (int i = tid; i < n; i += 512) { const unsigned k = f2key(row[i]); if ((k & mask) == prefix) __hip_atomic_fetch_add(&hist[(k >> shift) & 255u], 1u, __ATOMIC_RELAXED, __HIP_MEMORY_SCOPE_WORKGROUP); }
        __syncthreads();
        if (tid < 256) { unsigned above = 0u; for (int b = tid + 1; b < 256; ++b) above += hist[b];
            const unsigned mine = hist[tid]; if (above < kth && kth <= above + mine) { ctl[0] = (unsigned)tid; ctl[1] = kth - above; } }
        __syncthreads();
        prefix |= ctl[0] << shift; mask |= 0xffu << shift; kth = ctl[1];
        __syncthreads();
    }
    if (tid < 256) { bmg[tid] = 0u; bme[tid] = 0u; }
    __syncthreads();
    for (int i = tid; i < n; i += 512) { const unsigned k = f2key(row[i]); if (k > prefix) __hip_atomic_fetch_or(&bmg[i >> 5], 1u << (i & 31), __ATOMIC_RELAXED, __HIP_MEMORY_SCOPE_WORKGROUP); else if (k == prefix) __hip_atomic_fetch_or(&bme[i >> 5], 1u << (i & 31), __ATOMIC_RELAXED, __HIP_MEMORY_SCOPE_WORKGROUP); }
    __syncthreads();
    unsigned word = 0u, excl = 0u;
    if (tid < 256) {
        word = bme[tid]; const unsigned ce = __popc(word); unsigned incl = ce;
#pragma unroll
        for (int o = 1; o < 64; o <<= 1) { const unsigned v = __shfl_up(incl, o); if (F.lane >= o) incl += v; }
        if (F.lane == 63) scan[F.wave] = incl;
        excl = incl - ce;
    }
    __syncthreads();
    if (tid < 256) {
        unsigned rnk = excl; for (int wv = 0; wv < F.wave; ++wv) rnk += scan[wv];
        unsigned e = word, keep = 0u;
        while (e) { const unsigned b = e & (0u - e); if (rnk < kth) keep |= b; ++rnk; e ^= b; }
        word = bmg[tid] | keep;
        const unsigned cw = __popc(word); unsigned incl = cw;
#pragma unroll
        for (int o = 1; o < 64; o <<= 1) { const unsigned v = __shfl_up(incl, o); if (F.lane >= o) incl += v; }
        if (F.lane == 63) scan[16 + F.wave] = incl;
        excl = incl - cw;
    }
    __syncthreads();
    if (tid < 256) {
        unsigned pos = excl; for (int wv = 0; wv < F.wave; ++wv) pos += scan[16 + wv];
        unsigned e = word;
        while (e) { const int b = __ffs(e) - 1; if (pos < (unsigned)TOPK) idx[pos] = tid * 32 + b; ++pos; e &= e - 1u; }
    }
    __syncthreads();
    return TOPK;
}

__device__ __forceinline__ void phase6_simple(Frame& F) {
    const bf16* QA = (const bf16*)(F.ws + WS_QA); const bf16* CKV = (const bf16*)(F.ws + WS_CKV); const float* SC = (const float*)(F.ws + WS_SC); bf16* OLAT = (bf16*)(F.ws + WS_OLAT);
    LAS float* qab = (LAS float*)F.lds;
    LAS float* pl = (LAS float*)(F.lds + 65536);
    LAS int* idx = (LAS int*)(F.lds + 98304);
    LAS unsigned* selw = (LAS unsigned*)(F.lds + 98304 + 1024);
    const int tid = F.tid;
    for (int qn = F.bid; qn < T_SEQ; qn += F.G) {
        const int rnd = qn / F.G; const int t = (rnd & 1) ? (T_SEQ - 1 - (rnd >> 1) * F.G - F.bid) : ((rnd >> 1) * F.G + F.bid);
        const int cnt = select_topk(F, SC + (size_t)t * T_SEQ, t + 1, selw, idx);
        { const bf16* qrow = QA + (size_t)t * NQA;
#pragma unroll
          for (int i = 0; i < 4; ++i) { const int e = (tid + 512 * i) * 8; const v4u w = *(const v4u*)(qrow + e); f32x4 a0, a1; pg8::unpack8(w, a0, a1); *(LAS f32x4*)(qab + e) = a0; *(LAS f32x4*)(qab + e + 4) = a1; } }
        __syncthreads();
        { const int kk = tid & 255, hg = tid >> 8; const int key = idx[kk]; const bool valid = kk < cnt;
          float acc[16];
#pragma unroll
          for (int j = 0; j < 16; ++j) acc[j] = 0.f;
          const bf16* krow = CKV + (size_t)key * 512;
          for (int r8 = 0; r8 < 64; ++r8) { const v4u w = *(const v4u*)(krow + r8 * 8); f32x4 k0, k1; pg8::unpack8(w, k0, k1);
#pragma unroll
              for (int j = 0; j < 16; ++j) { const LAS float* qp = qab + (hg * 16 + j) * 512 + r8 * 8; const f32x4 q0 = *(const LAS f32x4*)qp, q1 = *(const LAS f32x4*)(qp + 4);
                  acc[j] += (q0[0] * k0[0] + q0[1] * k0[1]) + (q0[2] * k0[2] + q0[3] * k0[3]) + (q1[0] * k1[0] + q1[1] * k1[1]) + (q1[2] * k1[2] + q1[3] * k1[3]); } }
          const float dist = (float)(t - key);
#pragma unroll
          for (int j = 0; j < 16; ++j) { const int hh = hg * 16 + j; const float slope = exp2f(-8.0f * (float)(hh + 1) / 32.0f);
              pl[kk * 32 + hh] = valid ? (acc[j] * 0.08838834764831845f - slope * dist) : -INFINITY; } }
        __syncthreads();
        { for (int hq = 0; hq < 4; ++hq) { const int hh = F.wave * 4 + hq; float v[4]; float mx = -INFINITY;
#pragma unroll
              for (int i = 0; i < 4; ++i) { v[i] = pl[(F.lane + 64 * i) * 32 + hh]; mx = fmaxf(mx, v[i]); }
              mx = wave_max(mx); float sm = 0.f;
#pragma unroll
              for (int i = 0; i < 4; ++i) { v[i] = __expf(v[i] - mx); sm += v[i]; }
              sm = wave_sum(sm); const float inv = 1.0f / sm;
#pragma unroll
              for (int i = 0; i < 4; ++i) { const float p = v[i] * inv; pl[(F.lane + 64 * i) * 32 + hh] = bf_lo(cvt_pk_bf16(p, 0.f)); } } }
        __syncthreads();
        { float o[32];
#pragma unroll
          for (int j = 0; j < 32; ++j) o[j] = 0.f;
          for (int k = 0; k < cnt; ++k) { const float v = bf_lo((unsigned)CKV[(size_t)idx[k] * 512 + tid]);
#pragma unroll
              for (int q = 0; q < 8; ++q) { const f32x4 p4 = *(const LAS f32x4*)(pl + k * 32 + q * 4); o[q * 4 + 0] += p4[0] * v; o[q * 4 + 1] += p4[1] * v; o[q * 4 + 2] += p4[2] * v; o[q * 4 + 3] += p4[3] * v; } }
          bf16* orow = OLAT + (size_t)t * 16384 + tid;
#pragma unroll
          for (int j = 0; j < 32; ++j) orow[j * 512] = (bf16)(cvt_pk_bf16(o[j], 0.f) & 0xffffu); }
        __syncthreads();
    }
}

__device__ __forceinline__ void phase8_simple(Frame& F) {
    const bf16* QM = (const bf16*)(F.ws + WS_QM); const bf16* KM = (const bf16*)(F.ws + WS_KM); const bf16* P = (const bf16*)(F.ws + WS_P);
    const float* IG = (const float*)(F.ws + WS_IG); const float* LF = (const float*)(F.ws + WS_LF); float* HNUM = (float*)(F.ws + WS_HNUM); float* DEN = (float*)(F.ws + WS_DEN);
    LAS bf16* qs = (LAS bf16*)F.lds;
    LAS bf16* ks = (LAS bf16*)(F.lds + 32768);
    LAS float* vs = (LAS float*)(F.lds + 65536);
    LAS float* gs = (LAS float*)(F.lds + 65536 + 4096);
    LAS float* red = (LAS float*)(F.lds + 65536 + 8192);
    const int tid = F.tid, c = tid & 15, dg = tid >> 4;
    for (int blk = F.bid; blk < 256; blk += F.G) {
        const int h = blk >> 5, c0 = (blk & 31) * 16;
        float C[8], nn[8]; float m = 0.f;
#pragma unroll
        for (int j = 0; j < 8; ++j) { C[j] = 0.f; nn[j] = 0.f; }
        for (int ch = 0; ch < T_SEQ / 64; ++ch) {
            const int t0 = ch * 64;
            __syncthreads();
#pragma unroll
            for (int i = 0; i < 4; ++i) { const int e = tid + 512 * i, rr = e >> 5, cc = (e & 31) * 8;
                *(LAS v4u*)(qs + rr * 256 + cc) = *(const v4u*)(QM + (size_t)(t0 + rr) * 2048 + h * 256 + cc);
                *(LAS v4u*)(ks + rr * 256 + cc) = *(const v4u*)(KM + (size_t)(t0 + rr) * 2048 + h * 256 + cc); }
#pragma unroll
            for (int i = 0; i < 2; ++i) { const int e = tid + 512 * i, rr = e >> 4, cc = e & 15; vs[e] = bf_lo((unsigned)P[(size_t)(t0 + rr) * NP + PC_V + h * 512 + c0 + cc]); }
            if (tid < 64) { gs[tid * 2] = IG[(size_t)(t0 + tid) * 8 + h]; gs[tid * 2 + 1] = LF[(size_t)(t0 + tid) * 8 + h]; }
            __syncthreads();
            for (int s = 0; s < 64; ++s) {
                const float ig = gs[s * 2], lf = gs[s * 2 + 1];
                const float mn = fmaxf(lf + m, ig); const float fa = __expf(lf + m - mn), ia = __expf(ig - mn); m = mn;
                const v4u qw = *(const LAS v4u*)(qs + s * 256 + dg * 8), kw = *(const LAS v4u*)(ks + s * 256 + dg * 8);
                f32x4 q0, q1, k0, k1; pg8::unpack8(qw, q0, q1); pg8::unpack8(kw, k0, k1);
                const float kk[8] = {k0[0], k0[1], k0[2], k0[3], k1[0], k1[1], k1[2], k1[3]}; const float qq[8] = {q0[0], q0[1], q0[2], q0[3], q1[0], q1[1], q1[2], q1[3]};
                const float vv = vs[s * 16 + c] * ia; float pn = 0.f, pq = 0.f;
#pragma unroll
                for (int j = 0; j < 8; ++j) { C[j] = fa * C[j] + kk[j] * vv; nn[j] = fa * nn[j] + ia * kk[j]; pn += C[j] * qq[j]; pq += nn[j] * qq[j]; }
                pn += __shfl_xor(pn, 16); pn += __shfl_xor(pn, 32); pq += __shfl_xor(pq, 16); pq += __shfl_xor(pq, 32);
                LAS float* rb = red + (s & 1) * 160;
                if (F.lane < 16) { rb[F.wave * 20 + c] = pn; if (c == 0) rb[F.wave * 20 + 16] = pq; }
                __syncthreads();
                if (tid < 17) { float sm = 0.f;
#pragma unroll
                    for (int wv = 0; wv < 8; ++wv) sm += rb[wv * 20 + tid];
                    if (tid < 16) HNUM[(size_t)(t0 + s) * 4096 + h * 512 + c0 + tid] = sm;
                    else if (c0 == 0) DEN[(size_t)(t0 + s) * 8 + h] = fmaxf(fabsf(sm), __expf(-m)); }
            }
        }
    }
}

__device__ __forceinline__ void phase9(Frame& F) {
    const float* HNUM = (const float*)(F.ws + WS_HNUM); const float* DEN = (const float*)(F.ws + WS_DEN); const bf16* P = (const bf16*)(F.ws + WS_P); bf16* HG = (bf16*)(F.ws + WS_HG);
    const float* g_mh = F.p_I_GMH;
    const int gw = F.bid * NWAVES + F.wave, NGW = F.G * NWAVES, lane = F.lane;
    const int h = gw & 7;
    const f32x4 g0 = *(const f32x4*)(g_mh + h * 512 + lane * 8), g1 = *(const f32x4*)(g_mh + h * 512 + lane * 8 + 4);
#pragma unroll 4
    for (int it = gw; it < T_SEQ * MH; it += NGW) {
        const int t = it >> 3; const size_t off = (size_t)t * 4096 + h * 512 + lane * 8;
        const f32x4 a0 = *(const f32x4*)(HNUM + off), a1 = *(const f32x4*)(HNUM + off + 4);
        const float ss = wave_sum((a0[0] * a0[0] + a0[1] * a0[1]) + (a0[2] * a0[2] + a0[3] * a0[3]) + (a1[0] * a1[0] + a1[1] * a1[1]) + (a1[2] * a1[2] + a1[3] * a1[3]));
        const float d = DEN[(size_t)t * 8 + h];
        const float sc = rsqrtf(ss * (1.0f / 512.0f) + NORM_EPS * d * d);
        f32x4 o0, o1, z0, z1; pg8::unpack8(*(const v4u*)(P + (size_t)t * NP + PC_O + h * 512 + lane * 8), o0, o1); pg8::unpack8(*(const v4u*)(P + (size_t)t * NP + PC_ZM + h * 512 + lane * 8), z0, z1);
        { const f32x4 r0 = a0 * sc * g0 * o0 * z0 * 4.0f, r1 = a1 * sc * g1 * o1 * z1 * 4.0f; const float x[8] = {r0[0], r0[1], r0[2], r0[3], r1[0], r1[1], r1[2], r1[3]};
          *(v2u*)((unsigned char*)HG + off) = pack_fp8x8(x); }
    }
}

__device__ __forceinline__ void phase12(Frame& F) {
    const float* ln_g = F.p_I_LNG; const float* ln_b = F.p_I_LNB; const bf16* Y = (const bf16*)(F.ws + WS_TMP);
    const int gw = F.bid * NWAVES + F.wave, NGW = F.G * NWAVES, lane = F.lane;
    f32x4 gg[16], bb[16];
#pragma unroll
    for (int j = 0; j < 16; ++j) { const int c = (j >> 1) * 512 + lane * 8 + (j & 1) * 4; gg[j] = *(const f32x4*)(ln_g + c); bb[j] = *(const f32x4*)(ln_b + c); }
    for (int t = gw; t < T_SEQ; t += NGW) {
        const bf16* yrow = Y + (size_t)t * DM; float* row = F.out + (size_t)t * DM; f32x4 v[16]; float s = 0.f;
#pragma unroll
        for (int j = 0; j < 8; ++j) { pg8::unpack8(*(const v4u*)(yrow + j * 512 + lane * 8), v[2 * j], v[2 * j + 1]); }
#pragma unroll
        for (int j = 0; j < 16; ++j) s += (v[j][0] + v[j][1]) + (v[j][2] + v[j][3]);
        const float mu = wave_sum(s) * (1.0f / 4096.0f); float q = 0.f;
#pragma unroll
        for (int j = 0; j < 16; ++j) { v[j] = v[j] - mu; q += (v[j][0] * v[j][0] + v[j][1] * v[j][1]) + (v[j][2] * v[j][2] + v[j][3] * v[j][3]); }
        const float rstd = rsqrtf(wave_sum(q) * (1.0f / 4096.0f) + NORM_EPS);
#pragma unroll
        for (int j = 0; j < 16; ++j) { const int c = (j >> 1) * 512 + lane * 8 + (j & 1) * 4; *(f32x4*)(row + c) = v[j] * rstd * gg[j] + bb[j]; }
    }
}
__device__ __forceinline__ bf16x8 tr_pair(const LAS unsigned char* p0, const LAS unsigned char* p1) {
    const s16x4 a = __builtin_amdgcn_ds_read_tr16_b64_v4i16((LAS s16x4*)p0), b = __builtin_amdgcn_ds_read_tr16_b64_v4i16((LAS s16x4*)p1);
    return (bf16x8){a[0], a[1], a[2], a[3], b[0], b[1], b[2], b[3]};
}
#define P8_DPP(old, src, ctrl, rmask) __builtin_bit_cast(float, __builtin_amdgcn_update_dpp(__builtin_bit_cast(int, (float)(old)), __builtin_bit_cast(int, (float)(src)), (ctrl), (rmask), 0xf, false))
__device__ __forceinline__ float wave_scan_add(float v) {
    v += P8_DPP(0.f, v, 0x111, 0xf); v += P8_DPP(0.f, v, 0x112, 0xf); v += P8_DPP(0.f, v, 0x114, 0xf); v += P8_DPP(0.f, v, 0x118, 0xf);
    v += P8_DPP(0.f, v, 0x142, 0xa); v += P8_DPP(0.f, v, 0x143, 0xc); return v;
}
__device__ __forceinline__ float wave_scan_max(float v) {
    const float e = -INFINITY;
    v = fmaxf(v, P8_DPP(e, v, 0x111, 0xf)); v = fmaxf(v, P8_DPP(e, v, 0x112, 0xf)); v = fmaxf(v, P8_DPP(e, v, 0x114, 0xf)); v = fmaxf(v, P8_DPP(e, v, 0x118, 0xf));
    v = fmaxf(v, P8_DPP(e, v, 0x142, 0xa)); v = fmaxf(v, P8_DPP(e, v, 0x143, 0xc)); return v;
}
#define P8_DPPI(old, src, ctrl, rmask) __builtin_amdgcn_update_dpp((int)(old), (int)(src), (ctrl), (rmask), 0xf, false)
__device__ __forceinline__ unsigned wave_scan_add_u32(unsigned v) {
    v += (unsigned)P8_DPPI(0, v, 0x111, 0xf); v += (unsigned)P8_DPPI(0, v, 0x112, 0xf); v += (unsigned)P8_DPPI(0, v, 0x114, 0xf); v += (unsigned)P8_DPPI(0, v, 0x118, 0xf);
    v += (unsigned)P8_DPPI(0, v, 0x142, 0xa); v += (unsigned)P8_DPPI(0, v, 0x143, 0xc); return v;
}
__device__ __forceinline__ unsigned lane63_u32(unsigned v) { return (unsigned)__builtin_amdgcn_readlane((int)v, 63); }
__device__ __forceinline__ float row16_allmax(float v) {
    v = fmaxf(v, P8_DPP(v, v, 0x128, 0xf)); v = fmaxf(v, P8_DPP(v, v, 0x124, 0xf)); v = fmaxf(v, P8_DPP(v, v, 0x122, 0xf)); v = fmaxf(v, P8_DPP(v, v, 0x121, 0xf)); return v;
}
__device__ __forceinline__ float row16_allsum(float v) {
    v += P8_DPP(v, v, 0x128, 0xf); v += P8_DPP(v, v, 0x124, 0xf); v += P8_DPP(v, v, 0x122, 0xf); v += P8_DPP(v, v, 0x121, 0xf); return v;
}
__device__ __forceinline__ float xor32_allsum(float v) {
    float a = v, b = v;
    asm volatile("s_nop 1\n\tv_permlane32_swap_b32 %0, %1" : "+v"(a), "+v"(b));
    return a + b;
}
__device__ __forceinline__ void p8_gates(float ig, float lf, float& m_prev, LAS float* GA, int l) {
    const float b = wave_scan_add(lf);
    const float a = ig - b; const float cm = wave_scan_max(a);
    const float M = fmaxf(m_prev, cm);
    const float M63 = __builtin_bit_cast(float, __builtin_amdgcn_readlane(__builtin_bit_cast(int, M), 63)), g = __builtin_bit_cast(float, __builtin_amdgcn_readlane(__builtin_bit_cast(int, b), 63));
    GA[l] = a; GA[64 + l] = M; GA[128 + l] = __expf(m_prev - M); GA[192 + l] = __expf(-(b + M)); GA[256 + l] = __expf(a - M63);
    if (l == 0) GA[320] = __expf(m_prev - M63);
    m_prev = g + M63;
}
template <int VAR> __device__ __forceinline__ void phase8_fast(Frame& F) {
    const bf16* QM = (const bf16*)(F.ws + WS_QM); const bf16* KM = (const bf16*)(F.ws + WS_KM); const bf16* P = (const bf16*)(F.ws + WS_P);
    const float* IG = (const float*)(F.ws + WS_IG); const float* LF = (const float*)(F.ws + WS_LF); float* HNUM = (float*)(F.ws + (VAR ? WS_SC : WS_HNUM)); float* DEN = (float*)(F.ws + (VAR ? WS_SC + 192 * MiB : WS_DEN));
    constexpr int QRS = 528, SRS = 144;
    constexpr int O_QS = 0, O_KS = 33792, O_VS = 67584, O_VW = 69632, O_VS1 = 71680, O_VW1 = 73728, O_SS = 75776, O_CT0 = 84992, O_CT1 = 93440, O_GA = 101888, O_HQX = 104960;
    constexpr int GW = 4;
    LAS unsigned char* L = F.lds;
    const int tid = F.tid, w = F.wave, l = F.lane, quad = l >> 4, r16 = l & 15;
    for (int blk = F.bid; blk < 256; blk += F.G) {
        const int h = blk >> 5, c0 = (blk & 31) * 16; const int nt = (c0 == 0) ? 2 : 1;
        LDS_BARRIER();
        for (int i = tid; i < (2 * 8448) / 4; i += 512) ((LAS unsigned*)(L + O_CT0))[i] = 0u;
        for (int i = tid; i < 512; i += 512) { ((LAS unsigned*)(L + O_VS1))[i] = ((i & 7) == 0) ? 0x00003F80u : 0u; ((LAS unsigned*)(L + O_VW1))[i] = 0u; }
        f32x4 Cst[2][2];
#pragma unroll
        for (int a = 0; a < 2; ++a)
#pragma unroll
            for (int b = 0; b < 2; ++b) Cst[a][b] = (f32x4){0.f, 0.f, 0.f, 0.f};
        float m_prev = 0.f;
        const unsigned voff = (unsigned)((tid >> 5) * 4096 + (tid & 31) * 16), voffv = (unsigned)((tid >> 1) * (NP * 2) + (tid & 1) * 16);
        v4u pq[4], pk[4], pv = (v4u){0u, 0u, 0u, 0u}; float pgi = 0.f, pgf = 0.f;
        const __amdgpu_buffer_rsrc_t rQ = __builtin_amdgcn_make_buffer_rsrc((void*)(QM + h * 256), 0, T_SEQ * 4096, 0x00020000), rK = __builtin_amdgcn_make_buffer_rsrc((void*)(KM + h * 256), 0, T_SEQ * 4096, 0x00020000),
                                     rV = __builtin_amdgcn_make_buffer_rsrc((void*)(P + PC_V + h * 512 + c0), 0, (int)((size_t)T_SEQ * NP * 2 - (size_t)(PC_V + h * 512 + c0) * 2), 0x00020000);
        const __amdgpu_buffer_rsrc_t rH = __builtin_amdgcn_make_buffer_rsrc((void*)(HNUM + h * 512 + c0), 0, T_SEQ * 16384, 0x00020000), rD = __builtin_amdgcn_make_buffer_rsrc((void*)(DEN + h), 0, T_SEQ * 32, 0x00020000);
        const unsigned hoff = (unsigned)((((w & 3) * 16 + quad * 4) * 4096 + r16) * 4), doff = (unsigned)(((w & 3) * 16 + quad * 4) * 32);
#pragma unroll
        for (int i = 0; i < 4; ++i) { pq[i] = __builtin_bit_cast(v4u, __builtin_amdgcn_raw_buffer_load_b128(rQ, voff, i * 65536, 0)); pk[i] = __builtin_bit_cast(v4u, __builtin_amdgcn_raw_buffer_load_b128(rK, voff, i * 65536, 0)); }
        if (tid < 128) pv = __builtin_bit_cast(v4u, __builtin_amdgcn_raw_buffer_load_b128(rV, voffv, 0, 0));
        if (w == GW) { pgi = IG[(size_t)l * 8 + h]; pgf = LF[(size_t)l * 8 + h]; }
        if (w == GW) p8_gates(pgi, pgf, m_prev, (LAS float*)(L + O_GA), l);
        for (int ch = 0; ch < T_SEQ / 64; ++ch) {
          {
            const int t0 = ch * 64; const int s2 = ch & 1;
            LAS float* GA = (LAS float*)(L + O_GA + s2 * 1536);
#pragma unroll
            for (int i = 0; i < 4; ++i) { const int e = tid + 512 * i, rr = e >> 5, cc = e & 31; *(LAS v4u*)(L + O_QS + rr * QRS + cc * 16) = pq[i]; *(LAS v4u*)(L + O_KS + rr * QRS + cc * 16) = pk[i]; }
            if (tid < 128) *(LAS v4u*)(L + O_VS + (tid >> 1) * 32 + (tid & 1) * 16) = pv;
            LDS_BARRIER();
            if (VAR != 1 && ch + 1 < T_SEQ / 64) { const int t1 = t0 + 64;
#pragma unroll
                for (int i = 0; i < 4; ++i) { pq[i] = __builtin_bit_cast(v4u, __builtin_amdgcn_raw_buffer_load_b128(rQ, voff, t1 * 4096 + i * 65536, 0)); pk[i] = __builtin_bit_cast(v4u, __builtin_amdgcn_raw_buffer_load_b128(rK, voff, t1 * 4096 + i * 65536, 0)); }
                if (tid < 128) pv = __builtin_bit_cast(v4u, __builtin_amdgcn_raw_buffer_load_b128(rV, voffv, t1 * (NP * 2), 0));
                if (w == GW) { pgi = IG[(size_t)(t1 + l) * 8 + h]; pgf = LF[(size_t)(t1 + l) * 8 + h]; } }
            const int jt = w & 3, sp = w >> 2, j0 = jt * 16;
            if (tid < 128) { const int rr = tid >> 1; const float wg = GA[256 + rr]; const v4u vv = *(const LAS v4u*)(L + O_VS + rr * 32 + (tid & 1) * 16); f32x4 x0, x1; pg8::unpack8(vv, x0, x1);
                *(LAS v4u*)(L + O_VW + rr * 32 + (tid & 1) * 16) = pg8::pack8(x0 * wg, x1 * wg); }
            if (nt == 2 && tid >= 128 && tid < 192) { const int rr = tid - 128; *(LAS unsigned short*)(L + O_VW1 + rr * 32) = (unsigned short)(cvt_pk_bf16(GA[256 + rr], 0.f) & 0xffffu); }
            f32x4 sacc[2], hq[2];
            sacc[0] = (f32x4){0.f, 0.f, 0.f, 0.f}; sacc[1] = sacc[0]; hq[0] = sacc[0]; hq[1] = sacc[0];
#pragma unroll
            for (int kh = 0; kh < 2; ++kh) {
                bf16x8 aq[4], bk[2][4], bc[2][4];
#pragma unroll
                for (int k4 = 0; k4 < 4; ++k4) aq[k4] = *(const LAS bf16x8*)(L + O_QS + (j0 + r16) * QRS + ((kh * 4 + k4) * 32 + quad * 8) * 2);
#pragma unroll
                for (int si = 0; si < 2; ++si) { const int st = 2 * sp + si;
                    if (st <= jt) {
#pragma unroll
                        for (int k4 = 0; k4 < 4; ++k4) bk[si][k4] = *(const LAS bf16x8*)(L + O_KS + (st * 16 + r16) * QRS + ((kh * 4 + k4) * 32 + quad * 8) * 2); } }
                if (kh == sp) {
#pragma unroll
                    for (int k4 = 0; k4 < 4; ++k4) { bc[0][k4] = *(const LAS bf16x8*)(L + O_CT0 + r16 * QRS + ((kh * 4 + k4) * 32 + quad * 8) * 2);
                        if (nt == 2) bc[1][k4] = *(const LAS bf16x8*)(L + O_CT1 + r16 * QRS + ((kh * 4 + k4) * 32 + quad * 8) * 2); } }
                __builtin_amdgcn_sched_barrier(0);
#pragma unroll
                for (int k4 = 0; k4 < 4; ++k4) {
#pragma unroll
                    for (int si = 0; si < 2; ++si) { if (2 * sp + si <= jt) sacc[si] = __builtin_amdgcn_mfma_f32_16x16x32_bf16(aq[k4], bk[si][k4], sacc[si], 0, 0, 0); }
                    if (kh == sp) { hq[0] = __builtin_amdgcn_mfma_f32_16x16x32_bf16(aq[k4], bc[0][k4], hq[0], 0, 0, 0);
                        if (nt == 2) hq[1] = __builtin_amdgcn_mfma_f32_16x16x32_bf16(aq[k4], bc[1][k4], hq[1], 0, 0, 0); } }
                __builtin_amdgcn_sched_barrier(0);
            }
#pragma unroll
            for (int si = 0; si < 2; ++si) { const int st = 2 * sp + si, s0 = st * 16; f32x4 acc = sacc[si];
                if (st <= jt) { const int s = s0 + r16; const float as = GA[s];
#pragma unroll
                    for (int i = 0; i < 4; ++i) { const int j = j0 + quad * 4 + i; acc[i] = (s <= j) ? acc[i] * __expf(as - GA[64 + j]) : 0.f; } }
#pragma unroll
                for (int i = 0; i < 4; ++i) { const int j = j0 + quad * 4 + i; *(LAS unsigned short*)(L + O_SS + j * SRS + (s0 + r16) * 2) = (unsigned short)(cvt_pk_bf16(acc[i], 0.f) & 0xffffu); } }
            if (sp == 1) { *(LAS f32x4*)(L + O_HQX + ((jt * 2 + 0) * 64 + l) * 16) = hq[0]; if (nt == 2) *(LAS f32x4*)(L + O_HQX + ((jt * 2 + 1) * 64 + l) * 16) = hq[1]; }
            LDS_BARRIER();
            bf16x8 ak[2][2], bvw[2][2];
#pragma unroll
            for (int dt = 0; dt < 2; ++dt)
#pragma unroll
                for (int kk = 0; kk < 2; ++kk) { const LAS unsigned char* p0 = L + O_KS + (kk * 32 + 8 * quad + (r16 >> 2)) * QRS + ((2 * w + dt) * 16 + 4 * (r16 & 3)) * 2; ak[dt][kk] = tr_pair(p0, p0 + 4 * QRS); }
#pragma unroll
            for (int n = 0; n < 2; ++n) { if (n < nt) {
#pragma unroll
                for (int kk = 0; kk < 2; ++kk) { const LAS unsigned char* p0 = L + (n ? O_VW1 : O_VW) + (kk * 32 + 8 * quad + (r16 >> 2)) * 32 + (r16 & 3) * 8; bvw[n][kk] = tr_pair(p0, p0 + 4 * 32); } } }
            if (w < 4) {
                bf16x8 as2[2], bv[2][2]; f32x4 hx[2];
#pragma unroll
                for (int kk = 0; kk < 2; ++kk) as2[kk] = *(const LAS bf16x8*)(L + O_SS + (j0 + r16) * SRS + (kk * 32 + quad * 8) * 2);
#pragma unroll
                for (int n = 0; n < 2; ++n) { if (n < nt) { hx[n] = *(const LAS f32x4*)(L + O_HQX + ((jt * 2 + n) * 64 + l) * 16);
#pragma unroll
                    for (int kk = 0; kk < 2; ++kk) { const LAS unsigned char* p0 = L + (n ? O_VS1 : O_VS) + (kk * 32 + 8 * quad + (r16 >> 2)) * 32 + (r16 & 3) * 8; bv[n][kk] = tr_pair(p0, p0 + 4 * 32); } } }
#pragma unroll
                for (int n = 0; n < 2; ++n) { if (n < nt) {
                    f32x4 x = hq[n] + hx[n];
#pragma unroll
                    for (int i = 0; i < 4; ++i) x[i] *= GA[128 + j0 + quad * 4 + i];
#pragma unroll
                    for (int kk = 0; kk < 2; ++kk) x = __builtin_amdgcn_mfma_f32_16x16x32_bf16(as2[kk], bv[n][kk], x, 0, 0, 0);
                    if (n == 0) {
#pragma unroll
                        for (int i = 0; i < 4; ++i) __builtin_amdgcn_raw_buffer_store_b32(__float_as_uint(x[i]), rH, hoff, (t0 + i) * 16384, 0); }
                    else if (r16 == 0) {
#pragma unroll
                        for (int i = 0; i < 4; ++i) { const int j = j0 + quad * 4 + i; __builtin_amdgcn_raw_buffer_store_b32(__float_as_uint(fmaxf(fabsf(x[i]), GA[192 + j])), rD, doff, (t0 + i) * 32, 0); } } } }
            }
            { const float decay = GA[320];
#pragma unroll
              for (int dt = 0; dt < 2; ++dt) { const int d0 = (2 * w + dt) * 16;
#pragma unroll
                  for (int n = 0; n < 2; ++n) { if (n < nt) {
                      f32x4 c = Cst[dt][n] * decay;
#pragma unroll
                      for (int kk = 0; kk < 2; ++kk) c = __builtin_amdgcn_mfma_f32_16x16x32_bf16(ak[dt][kk], bvw[n][kk], c, 0, 0, 0);
                      Cst[dt][n] = c;
                      v2u o; o.x = cvt_pk_bf16(c[0], c[1]); o.y = cvt_pk_bf16(c[2], c[3]);
                      *(LAS v2u*)(L + (n ? O_CT1 : O_CT0) + r16 * QRS + (d0 + quad * 4) * 2) = o; } } } }
            if (w == GW && ch + 1 < T_SEQ / 64) p8_gates(pgi, pgf, m_prev, (LAS float*)(L + O_GA + (1 - s2) * 1536), l);
            LDS_BARRIER();
          }
        }
    }
}
__device__ __forceinline__ void mlstm_pre_item(Frame& F, int item) {
    const bf16* QM = (const bf16*)(F.ws + WS_QM); const bf16* KM = (const bf16*)(F.ws + WS_KM); const float* IG = (const float*)(F.ws + WS_IG); const float* LF = (const float*)(F.ws + WS_LF);
    bf16* SP = (bf16*)(F.ws + WS_SP); float* GAb = (float*)(F.ws + WS_GATES); float* GBb = GAb + 8 * T_SEQ; float* GCb = GBb + 8 * T_SEQ;
    LAS float* sc = (LAS float*)(F.lds + F.wave * 16384);
    const int h = item >> 7, ch = item & 127, t0 = ch * 64, l = F.lane, quad = l >> 4, r16 = l & 15;
    const float b = wave_scan_add(LF[(size_t)(t0 + l) * 8 + h]);
    const float a = IG[(size_t)(t0 + l) * 8 + h] - b; const float cm = wave_scan_max(a);
    GAb[(size_t)h * T_SEQ + t0 + l] = a; GBb[(size_t)h * T_SEQ + t0 + l] = b; GCb[(size_t)h * T_SEQ + t0 + l] = cm;
    sc[l] = a; sc[64 + l] = cm;
    LDS_WAIT(); asm volatile("" ::: "memory");
    bf16* sp = SP + (size_t)item * 4096;
#pragma unroll 1
    for (int jt = 0; jt < 4; ++jt) {
        bf16x8 aq[8];
#pragma unroll
        for (int kk = 0; kk < 8; ++kk) aq[kk] = *(const bf16x8*)(QM + (size_t)(t0 + jt * 16 + r16) * 2048 + h * 256 + kk * 32 + quad * 8);
#pragma unroll 1
        for (int st = 0; st < 4; ++st) {
            f32x4 acc = (f32x4){0.f, 0.f, 0.f, 0.f};
            if (st <= jt) {
                bf16x8 bk[8];
#pragma unroll
                for (int kk = 0; kk < 8; ++kk) bk[kk] = *(const bf16x8*)(KM + (size_t)(t0 + st * 16 + r16) * 2048 + h * 256 + kk * 32 + quad * 8);
#pragma unroll
                for (int kk = 0; kk < 8; ++kk) acc = __builtin_amdgcn_mfma_f32_16x16x32_bf16(aq[kk], bk[kk], acc, 0, 0, 0);
                const int s = st * 16 + r16; const float as = sc[s];
#pragma unroll
                for (int i = 0; i < 4; ++i) { const int j = jt * 16 + quad * 4 + i; acc[i] = (s <= j) ? acc[i] * __expf(as - sc[64 + j]) : 0.f; }
            }
#pragma unroll
            for (int i = 0; i < 4; ++i) sp[(jt * 16 + quad * 4 + i) * 64 + st * 16 + r16] = (bf16)(cvt_pk_bf16(acc[i], 0.f) & 0xffffu);
        }
    }
}

template <int VAR> __device__ __forceinline__ void phase8_v2(Frame& F) {
    const bf16* QM = (const bf16*)(F.ws + WS_QM); const bf16* KM = (const bf16*)(F.ws + WS_KM); const bf16* P = (const bf16*)(F.ws + WS_P); const bf16* SP = (const bf16*)(F.ws + WS_SP);
    const float* GAb = (const float*)(F.ws + WS_GATES); const float* GBb = GAb + 8 * T_SEQ; const float* GCb = GBb + 8 * T_SEQ;
    float* HNUM = (float*)(F.ws + (VAR ? WS_SC : WS_HNUM)); float* DEN = (float*)(F.ws + (VAR ? WS_SC + 192 * MiB : WS_DEN));
    constexpr int QRS = 528;
    constexpr int O_KS = 0, O_VS = 33792  , O_VW = 37888, O_VS1 = 39936, O_VW1 = 41984, O_CT = 44032  , O_HQX = 77824  , O_QS = 94208;
    LAS unsigned char* L = F.lds;
    const int tid = F.tid, w = F.wave, l = F.lane, quad = l >> 4, r16 = l & 15;
    const int jt = w & 3, sp_ = w >> 2, j0 = jt * 16;
    for (int blk = F.bid; blk < 256; blk += F.G) {
        const int h = blk >> 5, c0 = (blk & 31) * 16; const int nt = (c0 == 0) ? 2 : 1;
        LDS_BARRIER();
        for (int i = tid; i < (4 * 8448) / 4; i += 512) ((LAS unsigned*)(L + O_CT))[i] = 0u;
        for (int i = tid; i < 512; i += 512) { ((LAS unsigned*)(L + O_VS1))[i] = ((i & 7) == 0) ? 0x00003F80u : 0u; ((LAS unsigned*)(L + O_VW1))[i] = 0u; }
        f32x4 Cst[2][2];
#pragma unroll
        for (int a = 0; a < 2; ++a)
#pragma unroll
            for (int b = 0; b < 2; ++b) Cst[a][b] = (f32x4){0.f, 0.f, 0.f, 0.f};
        float m_prev = 0.f;
        const __amdgpu_buffer_rsrc_t rK = __builtin_amdgcn_make_buffer_rsrc((void*)(KM + h * 256), 0, T_SEQ * 4096, 0x00020000), rQ = __builtin_amdgcn_make_buffer_rsrc((void*)(QM + h * 256), 0, T_SEQ * 4096, 0x00020000),
                                     rV = __builtin_amdgcn_make_buffer_rsrc((void*)(P + PC_V + h * 512 + c0), 0, (int)((size_t)T_SEQ * NP * 2 - (size_t)(PC_V + h * 512 + c0) * 2), 0x00020000),
                                     rS = __builtin_amdgcn_make_buffer_rsrc((void*)(SP + (size_t)h * 128 * 4096), 0, 128 * 8192, 0x00020000),
                                     rH = __builtin_amdgcn_make_buffer_rsrc((void*)(HNUM + h * 512 + c0), 0, T_SEQ * 16384, 0x00020000), rD = __builtin_amdgcn_make_buffer_rsrc((void*)(DEN + h), 0, T_SEQ * 32, 0x00020000);
        const unsigned voffk = (unsigned)((tid >> 5) * 4096 + (tid & 31) * 16), voffv = (unsigned)((tid >> 1) * (NP * 2) + (tid & 1) * 16);
        const unsigned voffq = (unsigned)((j0 + r16) * 4096 + (sp_ * 128 + quad * 8) * 2), voffs = (unsigned)((j0 + r16) * 128 + quad * 16);
        const unsigned hoff = (unsigned)(((j0 + quad * 4) * 4096 + r16) * 4), doff = (unsigned)((j0 + quad * 4) * 32);
        const float* ga = GAb + (size_t)h * T_SEQ; const float* gb = GBb + (size_t)h * T_SEQ; const float* gc = GCb + (size_t)h * T_SEQ;
        const int vrow = (tid < 128) ? (tid >> 1) : ((tid - 128) & 63);
        v4u pk[2][4], pv[2]; bf16x8 pq[2][4], ps[2][2]; f32x4 pcm[2], pb[2]; float pa[2], pg[2], pamax[2];
#pragma unroll
        for (int z = 0; z < 2; ++z) { pv[z] = (v4u){0u, 0u, 0u, 0u}; pcm[z] = (f32x4){0.f, 0.f, 0.f, 0.f}; pb[z] = pcm[z]; ps[z][0] = (bf16x8){0, 0, 0, 0, 0, 0, 0, 0}; ps[z][1] = ps[z][0]; }
#define P8V2_FETCH(Z, T1) do { \
            _Pragma("unroll") for (int i = 0; i < 4; ++i) pk[Z][i] = __builtin_bit_cast(v4u, __builtin_amdgcn_raw_buffer_load_b128(rK, voffk, (T1) * 4096 + i * 65536, 0)); \
            if (tid < 128) pv[Z] = __builtin_bit_cast(v4u, __builtin_amdgcn_raw_buffer_load_b128(rV, voffv, (T1) * (NP * 2), 0)); \
            _Pragma("unroll") for (int i = 0; i < 4; ++i) pq[Z][i] = __builtin_bit_cast(bf16x8, __builtin_amdgcn_raw_buffer_load_b128(rQ, voffk, (T1) * 4096 + i * 65536, 0)); \
            if (w < 4) { _Pragma("unroll") for (int kk = 0; kk < 2; ++kk) ps[Z][kk] = __builtin_bit_cast(bf16x8, __builtin_amdgcn_raw_buffer_load_b128(rS, voffs, ((T1) >> 6) * 8192 + kk * 64, 0)); \
                pcm[Z] = *(const f32x4*)(gc + (T1) + j0 + quad * 4); pb[Z] = *(const f32x4*)(gb + (T1) + j0 + quad * 4); } \
            pa[Z] = ga[(T1) + vrow]; pg[Z] = gb[(T1) + 63]; pamax[Z] = gc[(T1) + 63]; } while (0)
        P8V2_FETCH(0, 0); P8V2_FETCH(1, 64);
        for (int ch2 = 0; ch2 < T_SEQ / 64; ch2 += 2) {
#pragma unroll
          for (int z = 0; z < 2; ++z) {
            const int ch = ch2 + z, t0 = ch * 64, cur = z, nxt = z ^ 1;
            const float M63 = fmaxf(m_prev, pamax[z]), decay = __expf(m_prev - M63), wg = __expf(pa[z] - M63);
            float rj[4], inj[4], enj[4];
#pragma unroll
            for (int i = 0; i < 4; ++i) { const float Mj = fmaxf(m_prev, pcm[z][i]); rj[i] = __expf(pcm[z][i] - Mj); inj[i] = __expf(m_prev - Mj); enj[i] = __expf(-(pb[z][i] + Mj)); }
            m_prev = pg[z] + M63;
#pragma unroll
            for (int i = 0; i < 4; ++i) { const int e = tid + 512 * i, rr = e >> 5, cc = e & 31; *(LAS v4u*)(L + O_KS + rr * QRS + cc * 16) = pk[z][i]; *(LAS bf16x8*)(L + O_QS + rr * QRS + cc * 16) = pq[z][i]; }
            if (tid < 128) { *(LAS v4u*)(L + O_VS + cur * 2048 + (tid >> 1) * 32 + (tid & 1) * 16) = pv[z]; f32x4 x0, x1; pg8::unpack8(pv[z], x0, x1); *(LAS v4u*)(L + O_VW + (tid >> 1) * 32 + (tid & 1) * 16) = pg8::pack8(x0 * wg, x1 * wg); }
            else if (nt == 2 && tid < 192) *(LAS unsigned short*)(L + O_VW1 + (tid - 128) * 32) = (unsigned short)(cvt_pk_bf16(wg, 0.f) & 0xffffu);
            bf16x8 aq[4], as2[2];
            as2[0] = ps[z][0]; as2[1] = ps[z][1];
            LDS_BARRIER();
#pragma unroll
            for (int k4 = 0; k4 < 4; ++k4) aq[k4] = *(const LAS bf16x8*)(L + O_QS + (j0 + r16) * QRS + ((sp_ * 4 + k4) * 32 + quad * 8) * 2);
            if (VAR != 1 && ch + 2 < T_SEQ / 64) P8V2_FETCH(z, t0 + 128);
            f32x4 hq[2];
            hq[0] = (f32x4){0.f, 0.f, 0.f, 0.f}; hq[1] = hq[0];
            { bf16x8 bc[2][4];
#pragma unroll
              for (int k4 = 0; k4 < 4; ++k4) { bc[0][k4] = *(const LAS bf16x8*)(L + O_CT + (cur * 2 + 0) * 8448 + r16 * QRS + ((sp_ * 4 + k4) * 32 + quad * 8) * 2);
                  if (nt == 2) bc[1][k4] = *(const LAS bf16x8*)(L + O_CT + (cur * 2 + 1) * 8448 + r16 * QRS + ((sp_ * 4 + k4) * 32 + quad * 8) * 2); }
#pragma unroll
              for (int k4 = 0; k4 < 4; ++k4) { hq[0] = __builtin_amdgcn_mfma_f32_16x16x32_bf16(aq[k4], bc[0][k4], hq[0], 0, 0, 0);
                  if (nt == 2) hq[1] = __builtin_amdgcn_mfma_f32_16x16x32_bf16(aq[k4], bc[1][k4], hq[1], 0, 0, 0); } }
            if (sp_ == 1) { *(LAS f32x4*)(L + O_HQX + cur * 8192 + ((jt * 2 + 0) * 64 + l) * 16) = hq[0]; if (nt == 2) *(LAS f32x4*)(L + O_HQX + cur * 8192 + ((jt * 2 + 1) * 64 + l) * 16) = hq[1]; }
            { bf16x8 ak[2][2], bvw[2][2];
#pragma unroll
              for (int dt = 0; dt < 2; ++dt)
#pragma unroll
                  for (int kk = 0; kk < 2; ++kk) { const LAS unsigned char* p0 = L + O_KS + (kk * 32 + 8 * quad + (r16 >> 2)) * QRS + ((2 * w + dt) * 16 + 4 * (r16 & 3)) * 2; ak[dt][kk] = tr_pair(p0, p0 + 4 * QRS); }
#pragma unroll
              for (int n = 0; n < 2; ++n) { if (n < nt) {
#pragma unroll
                  for (int kk = 0; kk < 2; ++kk) { const LAS unsigned char* p0 = L + (n ? O_VW1 : O_VW) + (kk * 32 + 8 * quad + (r16 >> 2)) * 32 + (r16 & 3) * 8; bvw[n][kk] = tr_pair(p0, p0 + 4 * 32); } } }
#pragma unroll
              for (int dt = 0; dt < 2; ++dt) { const int d0 = (2 * w + dt) * 16;
#pragma unroll
                  for (int n = 0; n < 2; ++n) { if (n < nt) {
                      f32x4 c = Cst[dt][n] * decay;
#pragma unroll
                      for (int kk = 0; kk < 2; ++kk) c = __builtin_amdgcn_mfma_f32_16x16x32_bf16(ak[dt][kk], bvw[n][kk], c, 0, 0, 0);
                      Cst[dt][n] = c;
                      v2u o; o.x = cvt_pk_bf16(c[0], c[1]); o.y = cvt_pk_bf16(c[2], c[3]);
                      *(LAS v2u*)(L + O_CT + (nxt * 2 + n) * 8448 + r16 * QRS + (d0 + quad * 4) * 2) = o; } } } }
            LDS_BARRIER();
            if (w < 4) {
#pragma unroll
                for (int n = 0; n < 2; ++n) { if (n < nt) {
                    const f32x4 hx = *(const LAS f32x4*)(L + O_HQX + cur * 8192 + ((jt * 2 + n) * 64 + l) * 16);
                    f32x4 x = (f32x4){0.f, 0.f, 0.f, 0.f};
                    const LAS unsigned char* vb = n ? (L + O_VS1) : (L + O_VS + cur * 2048);
#pragma unroll
                    for (int kk = 0; kk < 2; ++kk) { const LAS unsigned char* p0 = vb + (kk * 32 + 8 * quad + (r16 >> 2)) * 32 + (r16 & 3) * 8; x = __builtin_amdgcn_mfma_f32_16x16x32_bf16(as2[kk], tr_pair(p0, p0 + 4 * 32), x, 0, 0, 0); }
#pragma unroll
                    for (int i = 0; i < 4; ++i) x[i] = x[i] * rj[i] + inj[i] * (hq[n][i] + hx[i]);
                    if (n == 0) {
#pragma unroll
                        for (int i = 0; i < 4; ++i) __builtin_amdgcn_raw_buffer_store_b32(__float_as_uint(x[i]), rH, hoff, (t0 + i) * 16384, 0); }
                    else if (r16 == 0) {
#pragma unroll
                        for (int i = 0; i < 4; ++i) __builtin_amdgcn_raw_buffer_store_b32(__float_as_uint(fmaxf(fabsf(x[i]), enj[i])), rD, doff, (t0 + i) * 32, 0); } } }
            }
          }
        }
#undef P8V2_FETCH
    }
}
__device__ __forceinline__ void phase8_v3(Frame& F, int blk) {
    const bf16* QM = (const bf16*)(F.ws + WS_QM); const bf16* KM = (const bf16*)(F.ws + WS_KM); const bf16* P = (const bf16*)(F.ws + WS_P); const bf16* SP = (const bf16*)(F.ws + WS_SP);
    const float* GAb = (const float*)(F.ws + WS_GATES); const float* GBb = GAb + 8 * T_SEQ; const float* GCb = GBb + 8 * T_SEQ;
    float* HNUM = (float*)(F.ws + WS_HNUM); float* DEN = (float*)(F.ws + WS_DEN);
    constexpr int QRS = 528;
    constexpr int O_KS = 0, O_VS = 33792  , O_VW = 41984  , O_VS1 = 46080  , O_VW1 = 48128  , O_CT = 50176  , O_HQX = 100864  ;
    static_assert(O_HQX + 2 * 12288 <= RING_BYTES, "mLSTM v3 LDS map");
    LAS unsigned char* L = F.lds;
    const int tid = F.tid, w = F.wave, l = F.lane, quad = l >> 4, r16 = l & 15;
    const int jt = w & 3, sp_ = w >> 2, j0 = jt * 16;
    const int h = blk >> 4, c0 = (blk & 15) * 32; const int nt = (c0 == 0) ? 3 : 2;
    LDS_BARRIER();
    for (int i = tid; i < (6 * 8448) / 4; i += 512) ((LAS unsigned*)(L + O_CT))[i] = 0u;
    { const int i = tid; ((LAS unsigned*)(L + O_VS1))[i] = ((i & 7) == 0) ? 0x00003F80u : 0u; ((LAS unsigned*)(L + O_VW1))[i] = 0u; }
    f32x4 Cst[2][3];
#pragma unroll
    for (int a = 0; a < 2; ++a)
#pragma unroll
        for (int b = 0; b < 3; ++b) Cst[a][b] = (f32x4){0.f, 0.f, 0.f, 0.f};
    float m_prev = 0.f;
    const __amdgpu_buffer_rsrc_t rK = __builtin_amdgcn_make_buffer_rsrc((void*)(KM + h * 256), 0, T_SEQ * 4096, 0x00020000), rQ = __builtin_amdgcn_make_buffer_rsrc((void*)(QM + h * 256), 0, T_SEQ * 4096, 0x00020000),
                                 rV = __builtin_amdgcn_make_buffer_rsrc((void*)(P + PC_V + h * 512 + c0), 0, (int)((size_t)T_SEQ * NP * 2 - (size_t)(PC_V + h * 512 + c0) * 2), 0x00020000),
                                 rS = __builtin_amdgcn_make_buffer_rsrc((void*)(SP + (size_t)h * 128 * 4096), 0, 128 * 8192, 0x00020000),
                                 rH = __builtin_amdgcn_make_buffer_rsrc((void*)(HNUM + h * 512 + c0), 0, T_SEQ * 16384, 0x00020000), rD = __builtin_amdgcn_make_buffer_rsrc((void*)(DEN + h), 0, T_SEQ * 32, 0x00020000);
    const unsigned voffk = (unsigned)((tid >> 5) * 4096 + (tid & 31) * 16), voffv = (unsigned)((tid >> 2) * (NP * 2) + (tid & 3) * 16);
    const unsigned voffq = (unsigned)((j0 + r16) * 4096 + (sp_ * 128 + quad * 8) * 2), voffs = (unsigned)((j0 + r16) * 128 + quad * 16);
    const unsigned hoff = (unsigned)(((j0 + quad * 4) * 4096 + r16) * 4), doff = (unsigned)((j0 + quad * 4) * 32);
    const float* ga = GAb + (size_t)h * T_SEQ; const float* gb = GBb + (size_t)h * T_SEQ; const float* gc = GCb + (size_t)h * T_SEQ;
    const int vrow = (tid < 256) ? (tid >> 2) : ((tid - 256) & 63);
    v4u pk[4], pv = (v4u){0u, 0u, 0u, 0u}; bf16x8 pq[4], ps[2]; f32x4 pcm = (f32x4){0.f, 0.f, 0.f, 0.f}, pb = pcm; float pa = 0.f, pg = 0.f, pamax = 0.f;
    ps[0] = (bf16x8){0, 0, 0, 0, 0, 0, 0, 0}; ps[1] = ps[0];
#define P8V3_FETCH(T1) do { \
        _Pragma("unroll") for (int i = 0; i < 4; ++i) pk[i] = __builtin_bit_cast(v4u, __builtin_amdgcn_raw_buffer_load_b128(rK, voffk, (T1) * 4096 + i * 65536, 0)); \
        if (tid < 256) pv = __builtin_bit_cast(v4u, __builtin_amdgcn_raw_buffer_load_b128(rV, voffv, (T1) * (NP * 2), 0)); \
        _Pragma("unroll") for (int k4 = 0; k4 < 4; ++k4) pq[k4] = __builtin_bit_cast(bf16x8, __builtin_amdgcn_raw_buffer_load_b128(rQ, voffq, (T1) * 4096 + k4 * 64, 0)); \
        if (w < 4) { _Pragma("unroll") for (int kk = 0; kk < 2; ++kk) ps[kk] = __builtin_bit_cast(bf16x8, __builtin_amdgcn_raw_buffer_load_b128(rS, voffs, ((T1) >> 6) * 8192 + kk * 64, 0)); \
            pcm = *(const f32x4*)(gc + (T1) + j0 + quad * 4); pb = *(const f32x4*)(gb + (T1) + j0 + quad * 4); } \
        pa = ga[(T1) + vrow]; pg = gb[(T1) + 63]; pamax = gc[(T1) + 63]; } while (0)
    P8V3_FETCH(0);
    for (int ch = 0; ch < T_SEQ / 64; ++ch) {
        const int t0 = ch * 64, cur = ch & 1, nxt = cur ^ 1;
        const float M63 = fmaxf(m_prev, pamax), decay = __expf(m_prev - M63), wg = __expf(pa - M63);
        float rj[4], inj[4], enj[4];
#pragma unroll
        for (int i = 0; i < 4; ++i) { rj[i] = 1.f; inj[i] = 1.f; enj[i] = 1.f; }
        if (w < 4) {
#pragma unroll
            for (int i = 0; i < 4; ++i) { const float Mj = fmaxf(m_prev, pcm[i]); rj[i] = __expf(pcm[i] - Mj); inj[i] = __expf(m_prev - Mj); if (nt == 3) enj[i] = __expf(-(pb[i] + Mj)); } }
        m_prev = pg + M63;
#pragma unroll
        for (int i = 0; i < 4; ++i) { const int e = tid + 512 * i, rr = e >> 5, cc = e & 31; *(LAS v4u*)(L + O_KS + rr * QRS + cc * 16) = pk[i]; }
        if (tid < 256) { *(LAS v4u*)(L + O_VS + cur * 4096 + (tid >> 2) * 64 + (tid & 3) * 16) = pv; f32x4 x0, x1; pg8::unpack8(pv, x0, x1); *(LAS v4u*)(L + O_VW + (tid >> 2) * 64 + (tid & 3) * 16) = pg8::pack8(x0 * wg, x1 * wg); }
        else if (nt == 3 && tid < 320) *(LAS unsigned short*)(L + O_VW1 + (tid - 256) * 32) = (unsigned short)(cvt_pk_bf16(wg, 0.f) & 0xffffu);
        bf16x8 aq[4], as2[2];
#pragma unroll
        for (int k4 = 0; k4 < 4; ++k4) aq[k4] = pq[k4];
        as2[0] = ps[0]; as2[1] = ps[1];
        LDS_BARRIER();
        if (ch + 1 < T_SEQ / 64) P8V3_FETCH(t0 + 64);
        f32x4 hq[3];
        hq[0] = (f32x4){0.f, 0.f, 0.f, 0.f}; hq[1] = hq[0]; hq[2] = hq[0];
#pragma unroll
        for (int n = 0; n < 3; ++n) { if (n < nt) { bf16x8 bc[4];
#pragma unroll
            for (int k4 = 0; k4 < 4; ++k4) bc[k4] = *(const LAS bf16x8*)(L + O_CT + (cur * 3 + n) * 8448 + r16 * QRS + ((sp_ * 4 + k4) * 32 + quad * 8) * 2);
#pragma unroll
            for (int k4 = 0; k4 < 4; ++k4) hq[n] = __builtin_amdgcn_mfma_f32_16x16x32_bf16(aq[k4], bc[k4], hq[n], 0, 0, 0);
            if (sp_ == 1) *(LAS f32x4*)(L + O_HQX + cur * 12288 + ((jt * 3 + n) * 64 + l) * 16) = hq[n]; } }
        { bf16x8 ak[2][2];
#pragma unroll
          for (int dt = 0; dt < 2; ++dt)
#pragma unroll
              for (int kk = 0; kk < 2; ++kk) { const LAS unsigned char* p0 = L + O_KS + (kk * 32 + 8 * quad + (r16 >> 2)) * QRS + ((2 * w + dt) * 16 + 4 * (r16 & 3)) * 2; ak[dt][kk] = tr_pair(p0, p0 + 4 * QRS); }
#pragma unroll
          for (int n = 0; n < 3; ++n) { if (n < nt) { bf16x8 bvw[2];
#pragma unroll
              for (int kk = 0; kk < 2; ++kk) { const LAS unsigned char* p0 = (n == 2) ? (L + O_VW1 + (kk * 32 + 8 * quad + (r16 >> 2)) * 32 + (r16 & 3) * 8) : (L + O_VW + (kk * 32 + 8 * quad + (r16 >> 2)) * 64 + (n * 16 + 4 * (r16 & 3)) * 2);
                  bvw[kk] = tr_pair(p0, p0 + 4 * ((n == 2) ? 32 : 64)); }
#pragma unroll
              for (int dt = 0; dt < 2; ++dt) { const int d0 = (2 * w + dt) * 16;
                  f32x4 c = Cst[dt][n] * decay;
#pragma unroll
                  for (int kk = 0; kk < 2; ++kk) c = __builtin_amdgcn_mfma_f32_16x16x32_bf16(ak[dt][kk], bvw[kk], c, 0, 0, 0);
                  Cst[dt][n] = c;
                  v2u o; o.x = cvt_pk_bf16(c[0], c[1]); o.y = cvt_pk_bf16(c[2], c[3]);
                  *(LAS v2u*)(L + O_CT + (nxt * 3 + n) * 8448 + r16 * QRS + (d0 + quad * 4) * 2) = o; } } } }
        LDS_BARRIER();
        if (w < 4) {
#pragma unroll
            for (int n = 0; n < 3; ++n) { if (n < nt) {
                const f32x4 hx = *(const LAS f32x4*)(L + O_HQX + cur * 12288 + ((jt * 3 + n) * 64 + l) * 16);
                f32x4 x = (f32x4){0.f, 0.f, 0.f, 0.f};
#pragma unroll
                for (int kk = 0; kk < 2; ++kk) { const LAS unsigned char* p0 = (n == 2) ? (L + O_VS1 + (kk * 32 + 8 * quad + (r16 >> 2)) * 32 + (r16 & 3) * 8) : (L + O_VS + cur * 4096 + (kk * 32 + 8 * quad + (r16 >> 2)) * 64 + (n * 16 + 4 * (r16 & 3)) * 2);
                    x = __builtin_amdgcn_mfma_f32_16x16x32_bf16(as2[kk], tr_pair(p0, p0 + 4 * ((n == 2) ? 32 : 64)), x, 0, 0, 0); }
#pragma unroll
                for (int i = 0; i < 4; ++i) x[i] = x[i] * rj[i] + inj[i] * (hq[n][i] + hx[i]);
                if (n < 2) {
#pragma unroll
                    for (int i = 0; i < 4; ++i) __builtin_amdgcn_raw_buffer_store_b32(__float_as_uint(x[i]), rH, hoff, (t0 + i) * 16384 + n * 64, 0); }
                else if (r16 == 0) {
#pragma unroll
                    for (int i = 0; i < 4; ++i) __builtin_amdgcn_raw_buffer_store_b32(__float_as_uint(fmaxf(fabsf(x[i]), enj[i])), rD, doff, (t0 + i) * 32, 0); } } }
        }
    }
#undef P8V3_FETCH
    LDS_BARRIER();
}
__device__ __forceinline__ void phase8_v4(Frame& F, int blk) {
    const bf16* QM = (const bf16*)(F.ws + WS_QM); const bf16* KM = (const bf16*)(F.ws + WS_KM); const bf16* P = (const bf16*)(F.ws + WS_P); const bf16* SP = (const bf16*)(F.ws + WS_SP);
    const float* GAb = (const float*)(F.ws + WS_GATES); const float* GBb = GAb + 8 * T_SEQ; const float* GCb = GBb + 8 * T_SEQ;
    float* HNUM = (float*)(F.ws + WS_HNUM); float* DEN = (float*)(F.ws + WS_DEN);
    constexpr int QRS = 528, VRS = 144, NTM = 5;
    constexpr int O_KS = 0, O_VS = 33792  , O_VW = O_VS + 2 * 64 * VRS, O_VS1 = O_VW + 64 * VRS  , O_VW1 = O_VS1 + 2048  , O_CT = O_VW1 + 2048  , O_HQX = O_CT + NTM * 8448  ;
    static_assert(O_HQX + 4 * NTM * 1024 <= RING_BYTES, "mLSTM v4 LDS map");
    LAS unsigned char* L = F.lds;
    const int tid = F.tid, w = F.wave, l = F.lane, quad = l >> 4, r16 = l & 15;
    const int jt = w & 3, sp_ = w >> 2, j0 = jt * 16;
    const int h = blk >> 3, c0 = (blk & 7) * 64; const int nt = (c0 == 0) ? 5 : 4;
    LDS_BARRIER();
    for (int i = tid; i < (NTM * 8448) / 4; i += 512) ((LAS unsigned*)(L + O_CT))[i] = 0u;
    { const int i = tid; ((LAS unsigned*)(L + O_VS1))[i] = ((i & 7) == 0) ? 0x00003F80u : 0u; ((LAS unsigned*)(L + O_VW1))[i] = 0u; }
    f32x4 Cst[2][NTM];
#pragma unroll
    for (int a = 0; a < 2; ++a)
#pragma unroll
        for (int b = 0; b < NTM; ++b) Cst[a][b] = (f32x4){0.f, 0.f, 0.f, 0.f};
    float m_prev = 0.f;
    const __amdgpu_buffer_rsrc_t rK = __builtin_amdgcn_make_buffer_rsrc((void*)(KM + h * 256), 0, T_SEQ * 4096, 0x00020000), rQ = __builtin_amdgcn_make_buffer_rsrc((void*)(QM + h * 256), 0, T_SEQ * 4096, 0x00020000),
                                 rV = __builtin_amdgcn_make_buffer_rsrc((void*)(P + PC_V + h * 512 + c0), 0, (int)((size_t)T_SEQ * NP * 2 - (size_t)(PC_V + h * 512 + c0) * 2), 0x00020000),
                                 rS = __builtin_amdgcn_make_buffer_rsrc((void*)(SP + (size_t)h * 128 * 4096), 0, 128 * 8192, 0x00020000),
                                 rH = __builtin_amdgcn_make_buffer_rsrc((void*)(HNUM + h * 512 + c0), 0, T_SEQ * 16384, 0x00020000), rD = __builtin_amdgcn_make_buffer_rsrc((void*)(DEN + h), 0, T_SEQ * 32, 0x00020000);
    const unsigned voffk = (unsigned)((tid >> 5) * 4096 + (tid & 31) * 16), voffv = (unsigned)((tid >> 3) * (NP * 2) + (tid & 7) * 16);
    const unsigned voffq = (unsigned)((j0 + r16) * 4096 + (sp_ * 128 + quad * 8) * 2), voffs = (unsigned)((j0 + r16) * 128 + quad * 16);
    const unsigned hoff = (unsigned)(((j0 + quad * 4) * 4096 + r16) * 4), doff = (unsigned)((j0 + quad * 4) * 32);
    const float* ga = GAb + (size_t)h * T_SEQ; const float* gb = GBb + (size_t)h * T_SEQ; const float* gc = GCb + (size_t)h * T_SEQ;
    const int vrow = tid >> 3;
    const unsigned lvs = (unsigned)((tid >> 3) * VRS + (tid & 7) * 16);
    v4u pk[4], pv; bf16x8 pq[4], ps[2]; f32x4 pcm, pb; float pa = 0.f, pg = 0.f, pamax = 0.f;
#define P8V4_FETCH(T1) do { \
        _Pragma("unroll") for (int i = 0; i < 4; ++i) pk[i] = __builtin_bit_cast(v4u, __builtin_amdgcn_raw_buffer_load_b128(rK, voffk, (T1) * 4096 + i * 65536, 0)); \
        pv = __builtin_bit_cast(v4u, __builtin_amdgcn_raw_buffer_load_b128(rV, voffv, (T1) * (NP * 2), 0)); \
        _Pragma("unroll") for (int k4 = 0; k4 < 4; ++k4) pq[k4] = __builtin_bit_cast(bf16x8, __builtin_amdgcn_raw_buffer_load_b128(rQ, voffq, (T1) * 4096 + k4 * 64, 0)); \
        _Pragma("unroll") for (int kk = 0; kk < 2; ++kk) ps[kk] = __builtin_bit_cast(bf16x8, __builtin_amdgcn_raw_buffer_load_b128(rS, voffs, ((T1) >> 6) * 8192 + kk * 64, 0)); \
        pcm = *(const f32x4*)(gc + (T1) + j0 + quad * 4); pb = *(const f32x4*)(gb + (T1) + j0 + quad * 4); \
        pa = ga[(T1) + vrow]; pg = gb[(T1) + 63]; pamax = gc[(T1) + 63]; } while (0)
#define P8V4_MINE(n) (((n) == 4) ? (sp_ == 0) : (((n) >> 1) == sp_))
    P8V4_FETCH(0);
    for (int ch = 0; ch < T_SEQ / 64; ++ch) {
        const int t0 = ch * 64, cur = ch & 1;
        const float M63 = fmaxf(m_prev, pamax), decay = __expf(m_prev - M63), wg = __expf(pa - M63);
        float rj[4], inj[4], enj[4];
#pragma unroll
        for (int i = 0; i < 4; ++i) { const float Mj = fmaxf(m_prev, pcm[i]); rj[i] = __expf(pcm[i] - Mj); inj[i] = __expf(m_prev - Mj); enj[i] = (nt == 5 && sp_ == 0) ? __expf(-(pb[i] + Mj)) : 1.f; }
        m_prev = pg + M63;
#pragma unroll
        for (int i = 0; i < 4; ++i) { const int e = tid + 512 * i, rr = e >> 5, cc = e & 31; *(LAS v4u*)(L + O_KS + rr * QRS + cc * 16) = pk[i]; }
        { *(LAS v4u*)(L + O_VS + cur * (64 * VRS) + lvs) = pv; f32x4 x0, x1; pg8::unpack8(pv, x0, x1); *(LAS v4u*)(L + O_VW + lvs) = pg8::pack8(x0 * wg, x1 * wg); }
        if (nt == 5 && (tid & 7) == 0) *(LAS unsigned short*)(L + O_VW1 + (tid >> 3) * 32) = (unsigned short)(cvt_pk_bf16(wg, 0.f) & 0xffffu);
        bf16x8 aq[4], as2[2];
#pragma unroll
        for (int k4 = 0; k4 < 4; ++k4) aq[k4] = pq[k4];
        as2[0] = ps[0]; as2[1] = ps[1];
        if (ch + 1 < T_SEQ / 64) P8V4_FETCH(t0 + 64);
        LDS_BARRIER();
        f32x4 hq[NTM];
#pragma unroll
        for (int n = 0; n < NTM; ++n) hq[n] = (f32x4){0.f, 0.f, 0.f, 0.f};
#pragma unroll
        for (int n = 0; n < NTM; ++n) { if (n < nt) { bf16x8 bc[4];
#pragma unroll
            for (int k4 = 0; k4 < 4; ++k4) bc[k4] = *(const LAS bf16x8*)(L + O_CT + n * 8448 + r16 * QRS + ((sp_ * 4 + k4) * 32 + quad * 8) * 2);
#pragma unroll
            for (int k4 = 0; k4 < 4; ++k4) hq[n] = __builtin_amdgcn_mfma_f32_16x16x32_bf16(aq[k4], bc[k4], hq[n], 0, 0, 0);
            if (!P8V4_MINE(n)) *(LAS f32x4*)(L + O_HQX + ((jt * NTM + n) * 64 + l) * 16) = hq[n]; } }
        { bf16x8 ak[2][2];
#pragma unroll
          for (int dt = 0; dt < 2; ++dt)
#pragma unroll
              for (int kk = 0; kk < 2; ++kk) { const LAS unsigned char* p0 = L + O_KS + (kk * 32 + 8 * quad + (r16 >> 2)) * QRS + ((2 * w + dt) * 16 + 4 * (r16 & 3)) * 2; ak[dt][kk] = tr_pair(p0, p0 + 4 * QRS); }
#pragma unroll
          for (int n = 0; n < NTM; ++n) { if (n < nt) { bf16x8 bvw[2];
#pragma unroll
              for (int kk = 0; kk < 2; ++kk) { const LAS unsigned char* p0 = (n == 4) ? (L + O_VW1 + (kk * 32 + 8 * quad + (r16 >> 2)) * 32 + (r16 & 3) * 8) : (L + O_VW + (kk * 32 + 8 * quad + (r16 >> 2)) * VRS + (n * 16 + 4 * (r16 & 3)) * 2);
                  bvw[kk] = tr_pair(p0, p0 + 4 * ((n == 4) ? 32 : VRS)); }
#pragma unroll
              for (int dt = 0; dt < 2; ++dt) { f32x4 c = Cst[dt][n] * decay;
#pragma unroll
                  for (int kk = 0; kk < 2; ++kk) c = __builtin_amdgcn_mfma_f32_16x16x32_bf16(ak[dt][kk], bvw[kk], c, 0, 0, 0);
                  Cst[dt][n] = c; } } } }
        f32x4 xs[NTM];
#pragma unroll
        for (int n = 0; n < NTM; ++n) { xs[n] = (f32x4){0.f, 0.f, 0.f, 0.f}; if (n < nt && P8V4_MINE(n)) {
#pragma unroll
            for (int kk = 0; kk < 2; ++kk) { const LAS unsigned char* p0 = (n == 4) ? (L + O_VS1 + (kk * 32 + 8 * quad + (r16 >> 2)) * 32 + (r16 & 3) * 8) : (L + O_VS + cur * (64 * VRS) + (kk * 32 + 8 * quad + (r16 >> 2)) * VRS + (n * 16 + 4 * (r16 & 3)) * 2);
                xs[n] = __builtin_amdgcn_mfma_f32_16x16x32_bf16(as2[kk], tr_pair(p0, p0 + 4 * ((n == 4) ? 32 : VRS)), xs[n], 0, 0, 0); } } }
        LDS_BARRIER();
#pragma unroll
        for (int n = 0; n < NTM; ++n) { if (n < nt) {
#pragma unroll
            for (int dt = 0; dt < 2; ++dt) { const int d0 = (2 * w + dt) * 16; const f32x4 c = Cst[dt][n];
                v2u o; o.x = cvt_pk_bf16(c[0], c[1]); o.y = cvt_pk_bf16(c[2], c[3]);
                *(LAS v2u*)(L + O_CT + n * 8448 + r16 * QRS + (d0 + quad * 4) * 2) = o; } } }
#pragma unroll
        for (int n = 0; n < NTM; ++n) { if (n < nt && P8V4_MINE(n)) {
            const f32x4 hx = *(const LAS f32x4*)(L + O_HQX + ((jt * NTM + n) * 64 + l) * 16);
            f32x4 x = xs[n];
#pragma unroll
            for (int i = 0; i < 4; ++i) x[i] = x[i] * rj[i] + inj[i] * (hq[n][i] + hx[i]);
            if (n < 4) {
#pragma unroll
                for (int i = 0; i < 4; ++i) __builtin_amdgcn_raw_buffer_store_b32(__float_as_uint(x[i]), rH, hoff, (t0 + i) * 16384 + n * 64, 0); }
            else if (r16 == 0) {
#pragma unroll
                for (int i = 0; i < 4; ++i) __builtin_amdgcn_raw_buffer_store_b32(__float_as_uint(fmaxf(fabsf(x[i]), enj[i])), rD, doff, (t0 + i) * 32, 0); } } }
    }
#undef P8V4_FETCH
#undef P8V4_MINE
    LDS_BARRIER();
}
template <int VAR> __device__ __forceinline__ void phase5_fast(Frame& F) {
    const bf16* QA = (const bf16*)(F.ws + WS_QA); const bf16* KI = (const bf16*)(F.ws + WS_KI); const float* WI = (const float*)(F.ws + WS_WI); float* SC = (float*)(F.ws + (VAR ? WS_OLAT : WS_SC));
    constexpr int KRS = 144, KBUF = 128 * KRS;
    LAS unsigned char* L = F.lds;
    const int tid = F.tid, w = F.wave, lane = F.lane, r32 = lane & 31, hh = lane >> 5;
    const int pr0 = tid >> 3, pc0 = tid & 7;
    for (int pair = F.bid; pair < 256; pair += F.G) {
#pragma unroll 1
        for (int half = 0; half < 2; ++half) {
            const int ti = half ? (511 - pair) : pair, t0 = ti * 16;
            const int nkt = (t0 + 15) / 128 + 1;
            bf16x8 aq[2][4]; float wv[2][16];
#pragma unroll
            for (int q = 0; q < 2; ++q) { const int t = t0 + 2 * w + q;
#pragma unroll
                for (int ks = 0; ks < 4; ++ks) aq[q][ks] = *(const bf16x8*)(QA + (size_t)t * NQA + 16384 + r32 * 64 + ks * 16 + hh * 8);
#pragma unroll
                for (int i = 0; i < 16; ++i) wv[q][i] = WI[(size_t)t * 32 + (i & 3) + 8 * (i >> 2) + 4 * hh]; }
            LDS_BARRIER();
            { const v4u k0 = *(const v4u*)(KI + (size_t)pr0 * 64 + pc0 * 8), k1 = *(const v4u*)(KI + (size_t)(pr0 + 64) * 64 + pc0 * 8);
              *(LAS v4u*)(L + pr0 * KRS + pc0 * 16) = k0; *(LAS v4u*)(L + (pr0 + 64) * KRS + pc0 * 16) = k1; }
            LDS_BARRIER();
            v4u c0 = (v4u){0u, 0u, 0u, 0u}, c1 = c0;
            if (1 < nkt) { c0 = *(const v4u*)(KI + (size_t)(128 + pr0) * 64 + pc0 * 8); c1 = *(const v4u*)(KI + (size_t)(128 + pr0 + 64) * 64 + pc0 * 8); }
            for (int kt = 0; kt < nkt; ++kt) {
                const LAS unsigned char* kb_ = L + (kt & 1) * KBUF;
                v4u n0 = (v4u){0u, 0u, 0u, 0u}, n1 = n0;
                if (kt + 2 < nkt) { n0 = *(const v4u*)(KI + (size_t)((kt + 2) * 128 + pr0) * 64 + pc0 * 8); n1 = *(const v4u*)(KI + (size_t)((kt + 2) * 128 + pr0 + 64) * 64 + pc0 * 8); }
                if (kt * 128 + 127 <= t0 + 2 * w) {
#pragma unroll
                    for (int kp = 0; kp < 2; ++kp) {
                        bf16x8 bk[2][4];
#pragma unroll
                        for (int b2 = 0; b2 < 2; ++b2)
#pragma unroll
                            for (int ks = 0; ks < 4; ++ks) bk[b2][ks] = *(const LAS bf16x8*)(kb_ + ((kp * 2 + b2) * 32 + r32) * KRS + ks * 32 + hh * 16);
                        f32x16 acc[2][2];
#pragma unroll
                        for (int q = 0; q < 2; ++q)
#pragma unroll
                            for (int b2 = 0; b2 < 2; ++b2)
#pragma unroll
                                for (int i = 0; i < 16; ++i) acc[q][b2][i] = 0.f;
#pragma unroll
                        for (int ks = 0; ks < 4; ++ks)
#pragma unroll
                            for (int q = 0; q < 2; ++q)
#pragma unroll
                                for (int b2 = 0; b2 < 2; ++b2) { if (VAR == 4) {
                                    f32x4 t0 = (f32x4){acc[q][b2][0], acc[q][b2][1], acc[q][b2][2], acc[q][b2][3]}, t1 = (f32x4){acc[q][b2][4], acc[q][b2][5], acc[q][b2][6], acc[q][b2][7]};
                                    t0 = __builtin_amdgcn_mfma_f32_16x16x32_bf16(aq[q][ks], bk[b2][ks], t0, 0, 0, 0); t1 = __builtin_amdgcn_mfma_f32_16x16x32_bf16(aq[q][ks], bk[b2][ks], t1, 0, 0, 0);
                                    acc[q][b2][0] = t0[0]; acc[q][b2][1] = t0[1]; acc[q][b2][2] = t0[2]; acc[q][b2][3] = t0[3]; acc[q][b2][4] = t1[0]; acc[q][b2][5] = t1[1]; acc[q][b2][6] = t1[2]; acc[q][b2][7] = t1[3]; }
                                  else if (VAR != 2) acc[q][b2] = __builtin_amdgcn_mfma_f32_32x32x16_bf16(aq[q][ks], bk[b2][ks], acc[q][b2], 0, 0, 0); else acc[q][b2][ks] += __builtin_bit_cast(float, (int)bk[b2][ks][0]); }
#pragma unroll
                        for (int b2 = 0; b2 < 2; ++b2) { float sq[2];
#pragma unroll
                            for (int q = 0; q < 2; ++q) { float s = 0.f;
#pragma unroll
                                for (int i = 0; i < 16; ++i) { if (VAR != 1 || i == 0) s += wv[q][i] * __builtin_amdgcn_fmed3f(acc[q][b2][i], 0.f, __builtin_inff()); }
                                sq[q] = s; }
                            float a_ = sq[0], b_ = sq[1];
                            asm volatile("s_nop 1\n\tv_permlane32_swap_b32 %0, %1" : "+v"(a_), "+v"(b_));
                            const float tot = a_ + b_;
                            if (VAR != 3 || tot == 12345.f) SC[(size_t)(t0 + 2 * w + (lane >> 5)) * T_SEQ + kt * 128 + (kp * 2 + b2) * 32 + (lane & 31)] = tot; }
                    }
                } else {
#pragma unroll
                for (int kb4 = 0; kb4 < 4; ++kb4) {
                    const int key0 = kt * 128 + kb4 * 32;
                    if (key0 <= t0 + 2 * w + 1) {
                        bf16x8 bk[4];
#pragma unroll
                        for (int ks = 0; ks < 4; ++ks) bk[ks] = *(const LAS bf16x8*)(kb_ + (kb4 * 32 + r32) * KRS + ks * 32 + hh * 16);
#pragma unroll
                        for (int q = 0; q < 2; ++q) { const int t = t0 + 2 * w + q;
                            if (key0 <= t) {
                                f32x16 acc;
#pragma unroll
                                for (int i = 0; i < 16; ++i) acc[i] = 0.f;
#pragma unroll
                                for (int ks = 0; ks < 4; ++ks) acc = __builtin_amdgcn_mfma_f32_32x32x16_bf16(aq[q][ks], bk[ks], acc, 0, 0, 0);
                                float s = 0.f;
#pragma unroll
                                for (int i = 0; i < 16; ++i) s += wv[q][i] * __builtin_amdgcn_fmed3f(acc[i], 0.f, __builtin_inff());
                                s = xor32_allsum(s);
                                if (lane < 32) SC[(size_t)t * T_SEQ + key0 + lane] = s; } } } }
                }
                if (kt + 1 < nkt) { LAS unsigned char* nb = L + ((kt + 1) & 1) * KBUF; *(LAS v4u*)(nb + pr0 * KRS + pc0 * 16) = c0; *(LAS v4u*)(nb + (pr0 + 64) * KRS + pc0 * 16) = c1; }
                c0 = n0; c1 = n1;
                LDS_BARRIER();
            }
        }
    }
}
__device__ __forceinline__ float xor16_allsum(float v) {
    float a = v, b = v;
    asm volatile("s_nop 1\n\tv_permlane16_swap_b32 %0, %1" : "+v"(a), "+v"(b));
    return a + b;
}
struct IdxQ { bf16x8 a[2][2]; float w[8]; };
__device__ __forceinline__ void idx_load_q(IdxQ& q, const bf16* QA, const float* WI, int t, int quad, int r16) {
#pragma unroll
    for (int mt = 0; mt < 2; ++mt) {
#pragma unroll
        for (int ks = 0; ks < 2; ++ks) q.a[mt][ks] = *(const bf16x8*)(QA + (size_t)t * NQA + 16384 + (mt * 16 + r16) * 64 + ks * 32 + quad * 8);
        const f32x4 w4 = *(const f32x4*)(WI + (size_t)t * 32 + mt * 16 + quad * 4);
        q.w[mt * 4] = w4[0]; q.w[mt * 4 + 1] = w4[1]; q.w[mt * 4 + 2] = w4[2]; q.w[mt * 4 + 3] = w4[3]; }
}
__device__ __forceinline__ float idx_unit(const IdxQ& q, const bf16x8 (&bk)[2][2], int quad) {
    f32x4 acc[2][2];
#pragma unroll
    for (int mt = 0; mt < 2; ++mt)
#pragma unroll
        for (int n2 = 0; n2 < 2; ++n2) { acc[mt][n2] = __builtin_amdgcn_mfma_f32_16x16x32_bf16(q.a[mt][0], bk[n2][0], (f32x4){0.f, 0.f, 0.f, 0.f}, 0, 0, 0);
            acc[mt][n2] = __builtin_amdgcn_mfma_f32_16x16x32_bf16(q.a[mt][1], bk[n2][1], acc[mt][n2], 0, 0, 0); }
    float s[2];
#pragma unroll
    for (int n2 = 0; n2 < 2; ++n2) { float x = 0.f;
#pragma unroll
        for (int mt = 0; mt < 2; ++mt)
#pragma unroll
            for (int i = 0; i < 4; ++i) x += q.w[mt * 4 + i] * __builtin_amdgcn_fmed3f(acc[mt][n2][i], 0.f, __builtin_inff());
        s[n2] = x; }
    const float s0 = xor32_allsum(xor16_allsum(s[0])), s1 = xor32_allsum(xor16_allsum(s[1]));
    return (quad & 1) ? s1 : s0;
}
template <int VAR> __device__ __forceinline__ void phase5_v2(Frame& F) {
    const bf16* QA = (const bf16*)(F.ws + WS_QA); const bf16* KI = (const bf16*)(F.ws + WS_KI); const float* WI = (const float*)(F.ws + WS_WI); float* SC = (float*)(F.ws + (VAR ? WS_OLAT : WS_SC));
    constexpr int KRS = 144, KBUF = 128 * KRS;
    LAS unsigned char* L = F.lds;
    const int tid = F.tid, w = F.wave, lane = F.lane, quad = lane >> 4, r16 = lane & 15;
    const int pr0 = tid >> 3, pc0 = tid & 7;
    for (int pair = F.bid; pair < 256; pair += F.G) {
#pragma unroll 1
        for (int half = 0; half < 2; ++half) {
            const int ti = half ? (511 - pair) : pair, t0 = ti * 16;
            const int nkt = (t0 + 15) / 128 + 1;
            IdxQ q0, q1;
            idx_load_q(q0, QA, WI, t0 + 2 * w, quad, r16); idx_load_q(q1, QA, WI, t0 + 2 * w + 1, quad, r16);
            LDS_BARRIER();
            { const v4u k0 = *(const v4u*)(KI + (size_t)pr0 * 64 + pc0 * 8), k1 = *(const v4u*)(KI + (size_t)(pr0 + 64) * 64 + pc0 * 8);
              *(LAS v4u*)(L + pr0 * KRS + pc0 * 16) = k0; *(LAS v4u*)(L + (pr0 + 64) * KRS + pc0 * 16) = k1; }
            LDS_BARRIER();
            v4u c0 = (v4u){0u, 0u, 0u, 0u}, c1 = c0;
            if (1 < nkt) { c0 = *(const v4u*)(KI + (size_t)(128 + pr0) * 64 + pc0 * 8); c1 = *(const v4u*)(KI + (size_t)(128 + pr0 + 64) * 64 + pc0 * 8); }
            for (int kt = 0; kt < nkt; ++kt) {
                const LAS unsigned char* kb_ = L + (kt & 1) * KBUF;
                v4u n0 = (v4u){0u, 0u, 0u, 0u}, n1 = n0;
                if (kt + 2 < nkt) { n0 = *(const v4u*)(KI + (size_t)((kt + 2) * 128 + pr0) * 64 + pc0 * 8); n1 = *(const v4u*)(KI + (size_t)((kt + 2) * 128 + pr0 + 64) * 64 + pc0 * 8); }
                const bool full = (kt * 128 + 127 <= t0 + 2 * w);
#pragma unroll
                for (int kb4 = 0; kb4 < 4; ++kb4) {
                    const int key0 = kt * 128 + kb4 * 32;
                    if (full || key0 <= t0 + 2 * w + 1) {
                        bf16x8 bk[2][2];
#pragma unroll
                        for (int n2 = 0; n2 < 2; ++n2)
#pragma unroll
                            for (int ks = 0; ks < 2; ++ks) bk[n2][ks] = *(const LAS bf16x8*)(kb_ + (kb4 * 32 + n2 * 16 + r16) * KRS + ks * 64 + quad * 16);
                        if (full || key0 <= t0 + 2 * w) { const float s = idx_unit(q0, bk, quad); if (lane < 32) SC[(size_t)(t0 + 2 * w) * T_SEQ + key0 + lane] = s; }
                        { const float s = idx_unit(q1, bk, quad); if (lane < 32) SC[(size_t)(t0 + 2 * w + 1) * T_SEQ + key0 + lane] = s; }
                    }
                }
                if (kt + 1 < nkt) { LAS unsigned char* nb = L + ((kt + 1) & 1) * KBUF; *(LAS v4u*)(nb + pr0 * KRS + pc0 * 16) = c0; *(LAS v4u*)(nb + (pr0 + 64) * KRS + pc0 * 16) = c1; }
                c0 = n0; c1 = n1;
                LDS_BARRIER();
            }
        }
    }
}
template <int NB>
__device__ __forceinline__ unsigned p6_find_bin(const LAS unsigned* hist, unsigned& kth, unsigned& cnt, int lane) {
    unsigned hb[NB]; unsigned tot = 0u;
#pragma unroll
    for (int q = 0; q < NB / 4; ++q) { const v4u h4 = *(const LAS v4u*)(hist + lane * NB + q * 4); hb[q * 4] = h4.x; hb[q * 4 + 1] = h4.y; hb[q * 4 + 2] = h4.z; hb[q * 4 + 3] = h4.w; tot += h4.x + h4.y + h4.z + h4.w; }
    const unsigned inc_ = wave_scan_add_u32(tot);
    unsigned above = lane63_u32(inc_) - inc_;
    unsigned fbin = 0u, fk = 0u, fc = 0u; bool found = false;
#pragma unroll
    for (int b = NB - 1; b >= 0; --b) { if (!found && above < kth && kth <= above + hb[b]) { found = true; fbin = (unsigned)(lane * NB + b); fk = kth - above; fc = hb[b]; } above += hb[b]; }
    const unsigned long long fm = __ballot(found); const int src = (int)__ffsll((long long)fm) - 1;
    kth = (unsigned)__builtin_amdgcn_readlane((int)fk, src); cnt = (unsigned)__builtin_amdgcn_readlane((int)fc, src);
    return (unsigned)__builtin_amdgcn_readlane((int)fbin, src);
}
__device__ __forceinline__ void phase6a_select(Frame& F) {
    const float* SC = (const float*)(F.ws + WS_SC); int* IDX = (int*)(F.ws + WS_IDX); int* CNT = (int*)(F.ws + WS_CNT);
    LAS unsigned* hist = (LAS unsigned*)(F.lds + F.wave * 16384);
    LAS unsigned* cand = hist + 2048;
    constexpr unsigned CAP = 2048u;
    const int gw = F.bid * NWAVES + F.wave, NGW = F.G * NWAVES, lane = F.lane;
    const unsigned long long lt_mask = (1ull << lane) - 1ull;
    for (int qi = gw; qi < T_SEQ; qi += NGW) {
        const int grp = qi / NGW, jj = qi % NGW; int t;
        if (NGW * 4 == T_SEQ) t = (grp == 0) ? jj : (grp == 1) ? (T_SEQ / 2 - 1 - jj) : (grp == 2) ? (T_SEQ / 2 + jj) : (T_SEQ - 1 - jj); else t = qi;
        const int n = t + 1; int* out = IDX + (size_t)t * TOPK;
        if (lane == 0) CNT[t] = n < TOPK ? n : TOPK;
        if (n <= TOPK) {
#pragma unroll
            for (int e = 0; e < 4; ++e) { const int i = lane + 64 * e; out[i] = i < n ? i : 0; }
            continue;
        }
        const float* row = SC + (size_t)t * T_SEQ;
        unsigned kth = TOPK, cnt1 = 0u, cnt2 = 0u;
#pragma unroll
        for (int q = 0; q < 8; ++q) *(LAS v4u*)(hist + q * 256 + lane * 4) = (v4u){0u, 0u, 0u, 0u};
        f32x4 vn[4];
#pragma unroll
        for (int u = 0; u < 4; ++u) vn[u] = *(const f32x4*)(row + u * 256 + lane * 4);
        for (int base = 0; base < n; base += 1024) {
            f32x4 v[4];
#pragma unroll
            for (int u = 0; u < 4; ++u) v[u] = vn[u];
            if (base + 1024 < n) {
#pragma unroll
                for (int u = 0; u < 4; ++u) vn[u] = *(const f32x4*)(row + base + 1024 + u * 256 + lane * 4); }
#pragma unroll
            for (int u = 0; u < 4; ++u)
#pragma unroll
                for (int e = 0; e < 4; ++e) { const unsigned k = f2key(v[u][e]); if (base + u * 256 + lane * 4 + e < n) __hip_atomic_fetch_add(&hist[k >> 21], 1u, __ATOMIC_RELAXED, __HIP_MEMORY_SCOPE_WORKGROUP); }
        }
        const unsigned bin1 = p6_find_bin<32>(hist, kth, cnt1, lane);
#pragma unroll
        for (int q = 0; q < 8; ++q) *(LAS v4u*)(hist + q * 256 + lane * 4) = (v4u){0u, 0u, 0u, 0u};
        const bool fits = cnt1 <= CAP; unsigned nc = 0u;
#pragma unroll
        for (int u = 0; u < 4; ++u) vn[u] = *(const f32x4*)(row + u * 256 + lane * 4);
        for (int base = 0; base < n; base += 1024) {
            f32x4 v[4];
#pragma unroll
            for (int u = 0; u < 4; ++u) v[u] = vn[u];
            if (base + 1024 < n) {
#pragma unroll
                for (int u = 0; u < 4; ++u) vn[u] = *(const f32x4*)(row + base + 1024 + u * 256 + lane * 4); }
#pragma unroll
            for (int u = 0; u < 4; ++u)
#pragma unroll
                for (int e = 0; e < 4; ++e) { const unsigned k = f2key(v[u][e]); const bool m = (base + u * 256 + lane * 4 + e < n) && (k >> 21) == bin1;
                    if (m) __hip_atomic_fetch_add(&hist[(k >> 10) & 2047u], 1u, __ATOMIC_RELAXED, __HIP_MEMORY_SCOPE_WORKGROUP);
                    const unsigned long long mm = __ballot(m);
                    if (fits) { if (m) cand[nc + (unsigned)__popcll(mm & lt_mask)] = k; }
                    nc += (unsigned)__popcll(mm); }
        }
        const unsigned bin2 = p6_find_bin<32>(hist, kth, cnt2, lane);
        const unsigned pre22 = (bin1 << 11) | bin2;
#pragma unroll
        for (int q = 0; q < 4; ++q) *(LAS v4u*)(hist + q * 256 + lane * 4) = (v4u){0u, 0u, 0u, 0u};
        if (fits) { for (unsigned i = (unsigned)lane; i < cnt1; i += 64u) { const unsigned k = cand[i]; if ((k >> 10) == pre22) __hip_atomic_fetch_add(&hist[k & 1023u], 1u, __ATOMIC_RELAXED, __HIP_MEMORY_SCOPE_WORKGROUP); } }
        else { for (int i = lane; i < n; i += 64) { const unsigned k = f2key(row[i]); if ((k >> 10) == pre22) __hip_atomic_fetch_add(&hist[k & 1023u], 1u, __ATOMIC_RELAXED, __HIP_MEMORY_SCOPE_WORKGROUP); } }
        unsigned cnt3 = 0u;
        const unsigned bin3 = p6_find_bin<16>(hist, kth, cnt3, lane);
        const unsigned prefix = (pre22 << 10) | bin3;
        unsigned run = 0u, ties = 0u;
#pragma unroll
        for (int u = 0; u < 4; ++u) vn[u] = *(const f32x4*)(row + u * 256 + lane * 4);
        for (int base = 0; base < n; base += 1024) {
            f32x4 v[4];
#pragma unroll
            for (int u = 0; u < 4; ++u) v[u] = vn[u];
            if (base + 1024 < n) {
#pragma unroll
                for (int u = 0; u < 4; ++u) vn[u] = *(const f32x4*)(row + base + 1024 + u * 256 + lane * 4); }
#pragma unroll
            for (int u = 0; u < 4; ++u) {
                unsigned gtm = 0u, eqm = 0u;
#pragma unroll
                for (int e = 0; e < 4; ++e) { const unsigned k = f2key(v[u][e]); const bool in = base + u * 256 + lane * 4 + e < n; if (in && k > prefix) gtm |= 1u << e; if (in && k == prefix) eqm |= 1u << e; }
                const unsigned ce = (unsigned)__popc(eqm); unsigned selm = gtm;
                if (__ballot(ce != 0u)) {
                    const unsigned inc = wave_scan_add_u32(ce);
                    unsigned rk = ties + inc - ce;
#pragma unroll
                    for (int e = 0; e < 4; ++e) { if ((eqm >> e) & 1u) { if (rk < kth) selm |= 1u << e; ++rk; } }
                    ties += lane63_u32(inc);
                }
                const unsigned cs = (unsigned)__popc(selm); const unsigned inc2 = wave_scan_add_u32(cs);
                unsigned pos = run + inc2 - cs;
#pragma unroll
                for (int e = 0; e < 4; ++e) { if ((selm >> e) & 1u) { if (pos < (unsigned)TOPK) out[pos] = base + u * 256 + lane * 4 + e; ++pos; } }
                run += lane63_u32(inc2);
            }
        }
    }
}

__device__ __forceinline__ float p6_swap_max32(float v) { float a = v, b = v; asm volatile("s_nop 1\n\tv_permlane32_swap_b32 %0, %1\n\ts_nop 1" : "+v"(a), "+v"(b)); return fmaxf(a, b); }
__device__ __forceinline__ float p6_swap_max16(float v) { float a = v, b = v; asm volatile("s_nop 1\n\tv_permlane16_swap_b32 %0, %1\n\ts_nop 1" : "+v"(a), "+v"(b)); return fmaxf(a, b); }
__device__ __forceinline__ float p6_swap_sum32(float v) { float a = v, b = v; asm volatile("s_nop 1\n\tv_permlane32_swap_b32 %0, %1\n\ts_nop 1" : "+v"(a), "+v"(b)); return a + b; }
__device__ __forceinline__ float p6_swap_sum16(float v) { float a = v, b = v; asm volatile("s_nop 1\n\tv_permlane16_swap_b32 %0, %1\n\ts_nop 1" : "+v"(a), "+v"(b)); return a + b; }
__device__ __forceinline__ int p6_query_of(int qn, int G, int bid) { const int rnd = qn / G; return (rnd & 1) ? (T_SEQ - 1 - (rnd >> 1) * G - bid) : ((rnd >> 1) * G + bid); }
template <int VAR> __device__ __forceinline__ void phase6b_attn(Frame& F, int kstart, int kcount, int kstride, int extra = -1) {
    const bf16* QA = (const bf16*)(F.ws + WS_QA); const bf16* CKV = (const bf16*)(F.ws + WS_CKV); const int* IDX = (const int*)(F.ws + WS_IDX); const int* CNT = (const int*)(F.ws + WS_CNT); bf16* OLAT = (bf16*)(F.ws + (VAR ? WS_SC : WS_OLAT));
    constexpr int KRS = 1040, PRS = 144;
    constexpr int O_KV = 0, O_IDX = 66560, O_DIST = 68608, O_AL = 70656, O_LINV = 70784, O_P = 70912, O_EX = 75520, O_OT = 70912;
    LAS unsigned char* L = F.lds;
    LAS float* lal = (LAS float*)(L + O_AL); LAS float* linv = (LAS float*)(L + O_LINV);
    const int tid = F.tid, w = F.wave, l = F.lane, quad = l >> 4, r16 = l & 15, r32 = l & 31, hh = l >> 5;
    const int mt = w & 1, kq = w >> 1;
    const float slope = exp2f(-0.25f * (float)(mt * 16 + r16 + 1));
    const int ktotal = kcount + (extra >= 0 ? 1 : 0);
    if (ktotal <= 0) return;
    const __amdgpu_buffer_rsrc_t rKV = __builtin_amdgcn_make_buffer_rsrc((void*)CKV, 0, T_SEQ * 1024, 0x00020000);
    int t = T_SEQ - 1 - ((kcount > 0) ? kstart : extra); int cnt = CNT[t];
    LDS_BARRIER();
    if (tid < 256) { const int id = IDX[(size_t)t * TOPK + tid]; ((LAS int*)(L + O_IDX))[tid] = id; ((LAS float*)(L + O_DIST))[tid] = (float)(t - id); }
    bf16x8 aq[4];
#pragma unroll
    for (int ks = 0; ks < 4; ++ks) aq[ks] = *(const bf16x8*)(QA + (size_t)t * NQA + (mt * 16 + r16) * 512 + kq * 128 + ks * 32 + quad * 8);
    LDS_BARRIER();
    v4u st[8];
#pragma unroll
    for (int j = 0; j < 8; ++j) { const int id = ((LAS int*)(L + O_IDX))[w * 8 + j]; st[j] = __builtin_bit_cast(v4u, __builtin_amdgcn_raw_buffer_load_b128(rKV, (unsigned)(l * 16), __builtin_amdgcn_readfirstlane(id) * 1024, 0)); }
    int buf = 0;
    for (int qi = 0; qi < ktotal; ++qi) {
        const int nch = (cnt + 63) >> 6;
        LAS int* lidx = (LAS int*)(L + O_IDX + buf * 1024); LAS float* ldist = (LAS float*)(L + O_DIST + buf * 1024);
        LAS int* nidx = (LAS int*)(L + O_IDX + (buf ^ 1) * 1024); LAS float* ndist = (LAS float*)(L + O_DIST + (buf ^ 1) * 1024);
        const bool has_next = qi + 1 < ktotal; const int tn = has_next ? (T_SEQ - 1 - ((qi + 1 < kcount) ? (kstart + (qi + 1) * kstride) : extra)) : t;
        int cnt_n = cnt, nid = 0;
        if (has_next) { cnt_n = CNT[tn]; if (tid < 256) nid = IDX[(size_t)tn * TOPK + tid]; }
        f32x16 oacc[2];
#pragma unroll
        for (int c = 0; c < 2; ++c)
#pragma unroll
            for (int i = 0; i < 16; ++i) oacc[c][i] = 0.f;
        float m_i = -INFINITY, l_i = 0.f;
        for (int c = 0; c < nch; ++c) {
            if (VAR != 5 && VAR != 6) {
#pragma unroll
            for (int j = 0; j < 8; ++j) *(LAS v4u*)(L + O_KV + (w * 8 + j) * KRS + l * 16) = st[j]; }
            if (c == nch - 1 && has_next && tid < 256) { nidx[tid] = nid; ndist[tid] = (float)(tn - nid); }
            LDS_BARRIER();
            {
                const bool last = (c == nch - 1);
                if (VAR != 1 && (!last || has_next)) { const LAS int* srcidx = last ? nidx : (lidx + (c + 1) * 64);
#pragma unroll
                    for (int j = 0; j < 8; ++j) { const int id = srcidx[w * 8 + j]; st[j] = __builtin_bit_cast(v4u, __builtin_amdgcn_raw_buffer_load_b128(rKV, (unsigned)(l * 16), __builtin_amdgcn_readfirstlane(id) * 1024, 0)); } }
 }
            f32x4 lg[4];
#pragma unroll
            for (int nt = 0; nt < 4; ++nt) lg[nt] = (f32x4){0.f, 0.f, 0.f, 0.f};
            if (VAR != 3 && VAR != 5 && VAR != 7) {
#pragma unroll
            for (int kb2 = 0; kb2 < 2; ++kb2) { bf16x8 bk[4][2];
#pragma unroll
                for (int nt = 0; nt < 4; ++nt)
#pragma unroll
                    for (int k1 = 0; k1 < 2; ++k1) bk[nt][k1] = *(const LAS bf16x8*)(L + O_KV + (nt * 16 + r16) * KRS + (kq * 128 + (kb2 * 2 + k1) * 32 + quad * 8) * 2);
                __builtin_amdgcn_sched_barrier(0);
#pragma unroll
                for (int k1 = 0; k1 < 2; ++k1)
#pragma unroll
                    for (int nt = 0; nt < 4; ++nt) lg[nt] = __builtin_amdgcn_mfma_f32_16x16x32_bf16(bk[nt][k1], aq[kb2 * 2 + k1], lg[nt], 0, 0, 0);
                __builtin_amdgcn_sched_barrier(0); }
            if (kq > 0) {
#pragma unroll
                for (int nt = 0; nt < 4; ++nt) *(LAS f32x4*)(L + O_EX + ((((kq - 1) * 2 + mt) * 4 + nt) * 64 + l) * 16) = lg[nt]; }
            }
            LDS_BARRIER();
            if (c == nch - 1 && has_next) {
#pragma unroll
                for (int ks = 0; ks < 4; ++ks) aq[ks] = *(const bf16x8*)(QA + (size_t)tn * NQA + (mt * 16 + r16) * 512 + kq * 128 + ks * 32 + quad * 8); }
            if (VAR != 2 && VAR != 5 && w < 2) {
                float pmax = -INFINITY;
#pragma unroll
                for (int nh = 0; nh < 2; ++nh) { f32x4 ex[2][3]; f32x4 d4[2];
#pragma unroll
                    for (int n2 = 0; n2 < 2; ++n2) {
#pragma unroll
                        for (int k2 = 0; k2 < 3; ++k2) ex[n2][k2] = *(const LAS f32x4*)(L + O_EX + (((k2 * 2 + mt) * 4 + nh * 2 + n2) * 64 + l) * 16);
                        d4[n2] = *(const LAS f32x4*)(ldist + c * 64 + (nh * 2 + n2) * 16 + quad * 4); }
                    __builtin_amdgcn_sched_barrier(0);
#pragma unroll
                    for (int n2 = 0; n2 < 2; ++n2) { const int nt = nh * 2 + n2;
                        lg[nt] += ex[n2][0] + ex[n2][1] + ex[n2][2];
                        const int slot0 = c * 64 + nt * 16 + quad * 4;
#pragma unroll
                        for (int i = 0; i < 4; ++i) {
                            const float v = (slot0 + i < cnt) ? (lg[nt][i] * 0.08838834764831845f - slope * d4[n2][i]) : -INFINITY; lg[nt][i] = v; pmax = fmaxf(pmax, v); } }
                    __builtin_amdgcn_sched_barrier(0); }
                pmax = p6_swap_max32(p6_swap_max16(pmax));
                const float mn = fmaxf(m_i, pmax), alpha = __expf(m_i - mn); m_i = mn;
                float rs = 0.f;
#pragma unroll
                for (int nt = 0; nt < 4; ++nt) { float pe[4];
#pragma unroll
                    for (int i = 0; i < 4; ++i) pe[i] = __expf(lg[nt][i] - mn);
                    v2u pw; pw.x = cvt_pk_bf16(pe[0], pe[1]); pw.y = cvt_pk_bf16(pe[2], pe[3]);
                    rs += (bf_lo(pw.x) + bf_hi(pw.x)) + (bf_lo(pw.y) + bf_hi(pw.y));
                    *(LAS v2u*)(L + O_P + (mt * 16 + r16) * PRS + (nt * 16 + quad * 4) * 2) = pw; }
                rs = p6_swap_sum32(p6_swap_sum16(rs));
                l_i = l_i * alpha + rs;
                if (quad == 0) { lal[mt * 16 + r16] = alpha; if (c == nch - 1) linv[mt * 16 + r16] = __builtin_amdgcn_rcpf(l_i); }
            }
            LDS_BARRIER();
            { float al[16];
#pragma unroll
              for (int g = 0; g < 4; ++g) { const f32x4 a4 = *(const LAS f32x4*)(lal + 8 * g + 4 * hh); al[4 * g] = a4[0]; al[4 * g + 1] = a4[1]; al[4 * g + 2] = a4[2]; al[4 * g + 3] = a4[3]; }
#pragma unroll
              for (int cc = 0; cc < 2; ++cc)
#pragma unroll
                  for (int i = 0; i < 16; ++i) oacc[cc][i] *= al[i]; }
            if (VAR != 4 && VAR != 5 && VAR != 7) {
#pragma unroll
            for (int kb2 = 0; kb2 < 2; ++kb2) { bf16x8 ap[2], bv[2][2];
#pragma unroll
                for (int k1 = 0; k1 < 2; ++k1) { const int ks = kb2 * 2 + k1; ap[k1] = *(const LAS bf16x8*)(L + O_P + r32 * PRS + (ks * 16 + hh * 8) * 2);
#pragma unroll
                    for (int cc = 0; cc < 2; ++cc) { const LAS unsigned char* p0 = L + O_KV + (ks * 16 + 8 * hh + ((l & 15) >> 2)) * KRS + (w * 64 + cc * 32 + 16 * ((l >> 4) & 1) + 4 * (l & 3)) * 2; bv[k1][cc] = tr_pair(p0, p0 + 4 * KRS); } }
                __builtin_amdgcn_sched_barrier(0);
#pragma unroll
                for (int k1 = 0; k1 < 2; ++k1)
#pragma unroll
                    for (int cc = 0; cc < 2; ++cc) oacc[cc] = __builtin_amdgcn_mfma_f32_32x32x16_bf16(ap[k1], bv[k1][cc], oacc[cc], 0, 0, 0);
                __builtin_amdgcn_sched_barrier(0); }
            }
            LDS_BARRIER();
        }
        { float li[16];
#pragma unroll
          for (int g = 0; g < 4; ++g) { const f32x4 a4 = *(const LAS f32x4*)(linv + 8 * g + 4 * hh); li[4 * g] = a4[0]; li[4 * g + 1] = a4[1]; li[4 * g + 2] = a4[2]; li[4 * g + 3] = a4[3]; }
#pragma unroll
          for (int cc = 0; cc < 2; ++cc)
#pragma unroll
              for (int i = 0; i < 16; ++i) { const int head = (i & 3) + 8 * (i >> 2) + 4 * hh;
                  *(LAS unsigned short*)(L + O_OT + head * KRS + (w * 64 + cc * 32 + r32) * 2) = (unsigned short)(cvt_pk_bf16(oacc[cc][i] * li[i], 0.f) & 0xffffu); } }
        LDS_BARRIER();
#pragma unroll
        for (int i = 0; i < 4; ++i) { const int pc = tid + 512 * i, head = pc >> 6, ch16 = pc & 63;
            *(v4u*)(OLAT + (size_t)t * 16384 + head * 512 + ch16 * 8) = *(const LAS v4u*)(L + O_OT + head * KRS + ch16 * 16); }
        t = tn; cnt = cnt_n; buf ^= 1;
    }
}
template <int VAR> __device__ __forceinline__ void phase6b_attn4(Frame& F, int kstart, int kcount, int kstride) {
    constexpr int extra = -1;
    const bf16* QA = (const bf16*)(F.ws + WS_QA); const bf16* CKV = (const bf16*)(F.ws + WS_CKV); const int* IDX = (const int*)(F.ws + WS_IDX); const int* CNT = (const int*)(F.ws + WS_CNT); bf16* OLAT = (bf16*)(F.ws + (VAR ? WS_SC : WS_OLAT));
    constexpr int KRS = 1040, PRS = 144;
    constexpr int O_KV = 0, O_IDX = 66560, O_DIST = 68608, O_AL = 70656, O_LINV = 70784, O_P = 70912, O_EX = 75520, O_OT = 70912;
    LAS unsigned char* L = F.lds;
    LAS float* lal = (LAS float*)(L + O_AL); LAS float* linv = (LAS float*)(L + O_LINV);
    const int tid = F.tid, w = F.wave, l = F.lane, quad = l >> 4, r16 = l & 15, r32 = l & 31, hh = l >> 5;
    const int mt = w & 1, kq = w >> 1;
    const float slope = exp2f(-0.25f * (float)(mt * 16 + r16 + 1));
    const int ktotal = kcount + (extra >= 0 ? 1 : 0);
    if (ktotal <= 0) return;
    const __amdgpu_buffer_rsrc_t rKV = __builtin_amdgcn_make_buffer_rsrc((void*)CKV, 0, T_SEQ * 1024, 0x00020000);
    int t = T_SEQ - 1 - ((kcount > 0) ? kstart : extra); int cnt = CNT[t];
    LDS_BARRIER();
    if (tid < 256) { const int id = IDX[(size_t)t * TOPK + tid]; ((LAS int*)(L + O_IDX))[tid] = id; ((LAS float*)(L + O_DIST))[tid] = (float)(t - id); }
    bf16x8 aq[4];
#pragma unroll
    for (int ks = 0; ks < 4; ++ks) aq[ks] = *(const bf16x8*)(QA + (size_t)t * NQA + (mt * 16 + r16) * 512 + kq * 128 + ks * 32 + quad * 8);
    LDS_BARRIER();
    v4u st[2][8];
#pragma unroll
    for (int s2 = 0; s2 < 2; ++s2)
#pragma unroll
        for (int j = 0; j < 8; ++j) { const int id = ((LAS int*)(L + O_IDX))[s2 * 64 + w * 8 + j]; st[s2][j] = __builtin_bit_cast(v4u, __builtin_amdgcn_raw_buffer_load_b128(rKV, (unsigned)(l * 16), __builtin_amdgcn_readfirstlane(id) * 1024, 0)); }
    int buf = 0;
    for (int qi = 0; qi < ktotal; ++qi) {
        constexpr int nch = 4;
        LAS int* lidx = (LAS int*)(L + O_IDX + buf * 1024); LAS float* ldist = (LAS float*)(L + O_DIST + buf * 1024);
        LAS int* nidx = (LAS int*)(L + O_IDX + (buf ^ 1) * 1024); LAS float* ndist = (LAS float*)(L + O_DIST + (buf ^ 1) * 1024);
        const bool has_next = qi + 1 < ktotal; const int tn = has_next ? (T_SEQ - 1 - ((qi + 1 < kcount) ? (kstart + (qi + 1) * kstride) : extra)) : t;
        int cnt_n = cnt, nid = 0;
        if (has_next) { cnt_n = CNT[tn]; if (tid < 256) nid = IDX[(size_t)tn * TOPK + tid]; }
        f32x16 oacc[2];
#pragma unroll
        for (int c = 0; c < 2; ++c)
#pragma unroll
            for (int i = 0; i < 16; ++i) oacc[c][i] = 0.f;
        float m_i = -INFINITY, l_i = 0.f;
#pragma unroll
        for (int c = 0; c < 4; ++c) {
            if (VAR != 5 && VAR != 6) {
#pragma unroll
            for (int j = 0; j < 8; ++j) *(LAS v4u*)(L + O_KV + (w * 8 + j) * KRS + l * 16) = st[c & 1][j]; }
            if (c == 2 && has_next && tid < 256) { nidx[tid] = nid; ndist[tid] = (float)(tn - nid); }
            LDS_BARRIER();
            {
                const bool nextq = (c >= 2);
                if (VAR != 1 && (!nextq || has_next)) { const LAS int* srcidx = nextq ? (nidx + (c - 2) * 64) : (lidx + (c + 2) * 64);
#pragma unroll
                    for (int j = 0; j < 8; ++j) { const int id = srcidx[w * 8 + j]; st[c & 1][j] = __builtin_bit_cast(v4u, __builtin_amdgcn_raw_buffer_load_b128(rKV, (unsigned)(l * 16), __builtin_amdgcn_readfirstlane(id) * 1024, 0)); } } }
            f32x4 lg[4];
#pragma unroll
            for (int nt = 0; nt < 4; ++nt) lg[nt] = (f32x4){0.f, 0.f, 0.f, 0.f};
            if (VAR != 3 && VAR != 5 && VAR != 7) {
#pragma unroll
            for (int kb2 = 0; kb2 < 2; ++kb2) { bf16x8 bk[4][2];
#pragma unroll
                for (int nt = 0; nt < 4; ++nt)
#pragma unroll
                    for (int k1 = 0; k1 < 2; ++k1) bk[nt][k1] = *(const LAS bf16x8*)(L + O_KV + (nt * 16 + r16) * KRS + (kq * 128 + (kb2 * 2 + k1) * 32 + quad * 8) * 2);
                __builtin_amdgcn_sched_barrier(0);
#pragma unroll
                for (int k1 = 0; k1 < 2; ++k1)
#pragma unroll
                    for (int nt = 0; nt < 4; ++nt) lg[nt] = __builtin_amdgcn_mfma_f32_16x16x32_bf16(bk[nt][k1], aq[kb2 * 2 + k1], lg[nt], 0, 0, 0);
                __builtin_amdgcn_sched_barrier(0); }
            if (kq > 0) {
#pragma unroll
                for (int nt = 0; nt < 4; ++nt) *(LAS f32x4*)(L + O_EX + ((((kq - 1) * 2 + mt) * 4 + nt) * 64 + l) * 16) = lg[nt]; }
            }
            LDS_BARRIER();
            if (c == nch - 1 && has_next) {
#pragma unroll
                for (int ks = 0; ks < 4; ++ks) aq[ks] = *(const bf16x8*)(QA + (size_t)tn * NQA + (mt * 16 + r16) * 512 + kq * 128 + ks * 32 + quad * 8); }
            if (VAR != 2 && VAR != 5 && w < 2) {
                float pmax = -INFINITY;
#pragma unroll
                for (int nh = 0; nh < 2; ++nh) { f32x4 ex[2][3]; f32x4 d4[2];
#pragma unroll
                    for (int n2 = 0; n2 < 2; ++n2) {
#pragma unroll
                        for (int k2 = 0; k2 < 3; ++k2) ex[n2][k2] = *(const LAS f32x4*)(L + O_EX + (((k2 * 2 + mt) * 4 + nh * 2 + n2) * 64 + l) * 16);
                        d4[n2] = *(const LAS f32x4*)(ldist + c * 64 + (nh * 2 + n2) * 16 + quad * 4); }
                    __builtin_amdgcn_sched_barrier(0);
#pragma unroll
                    for (int n2 = 0; n2 < 2; ++n2) { const int nt = nh * 2 + n2;
                        lg[nt] += ex[n2][0] + ex[n2][1] + ex[n2][2];
                        const int slot0 = c * 64 + nt * 16 + quad * 4;
#pragma unroll
                        for (int i = 0; i < 4; ++i) {
                            const float v = (slot0 + i < cnt) ? (lg[nt][i] * 0.08838834764831845f - slope * d4[n2][i]) : -INFINITY; lg[nt][i] = v; pmax = fmaxf(pmax, v); } }
                    __builtin_amdgcn_sched_barrier(0); }
                pmax = p6_swap_max32(p6_swap_max16(pmax));
                const float mn = fmaxf(m_i, pmax), alpha = __expf(m_i - mn); m_i = mn;
                float rs = 0.f;
#pragma unroll
                for (int nt = 0; nt < 4; ++nt) { float pe[4];
#pragma unroll
                    for (int i = 0; i < 4; ++i) pe[i] = __expf(lg[nt][i] - mn);
                    v2u pw; pw.x = cvt_pk_bf16(pe[0], pe[1]); pw.y = cvt_pk_bf16(pe[2], pe[3]);
                    rs += (bf_lo(pw.x) + bf_hi(pw.x)) + (bf_lo(pw.y) + bf_hi(pw.y));
                    *(LAS v2u*)(L + O_P + (mt * 16 + r16) * PRS + (nt * 16 + quad * 4) * 2) = pw; }
                rs = p6_swap_sum32(p6_swap_sum16(rs));
                l_i = l_i * alpha + rs;
                if (quad == 0) { lal[mt * 16 + r16] = alpha; if (c == nch - 1) linv[mt * 16 + r16] = __builtin_amdgcn_rcpf(l_i); }
            }
            LDS_BARRIER();
            { float al[16];
#pragma unroll
              for (int g = 0; g < 4; ++g) { const f32x4 a4 = *(const LAS f32x4*)(lal + 8 * g + 4 * hh); al[4 * g] = a4[0]; al[4 * g + 1] = a4[1]; al[4 * g + 2] = a4[2]; al[4 * g + 3] = a4[3]; }
#pragma unroll
              for (int cc = 0; cc < 2; ++cc)
#pragma unroll
                  for (int i = 0; i < 16; ++i) oacc[cc][i] *= al[i]; }
            if (VAR != 4 && VAR != 5 && VAR != 7) {
#pragma unroll
            for (int kb2 = 0; kb2 < 2; ++kb2) { bf16x8 ap[2], bv[2][2];
#pragma unroll
                for (int k1 = 0; k1 < 2; ++k1) { const int ks = kb2 * 2 + k1; ap[k1] = *(const LAS bf16x8*)(L + O_P + r32 * PRS + (ks * 16 + hh * 8) * 2);
#pragma unroll
                    for (int cc = 0; cc < 2; ++cc) { const LAS unsigned char* p0 = L + O_KV + (ks * 16 + 8 * hh + ((l & 15) >> 2)) * KRS + (w * 64 + cc * 32 + 16 * ((l >> 4) & 1) + 4 * (l & 3)) * 2; bv[k1][cc] = tr_pair(p0, p0 + 4 * KRS); } }
                __builtin_amdgcn_sched_barrier(0);
#pragma unroll
                for (int k1 = 0; k1 < 2; ++k1)
#pragma unroll
                    for (int cc = 0; cc < 2; ++cc) oacc[cc] = __builtin_amdgcn_mfma_f32_32x32x16_bf16(ap[k1], bv[k1][cc], oacc[cc], 0, 0, 0);
                __builtin_amdgcn_sched_barrier(0); }
            }
            LDS_BARRIER();
        }
        { float li[16];
#pragma unroll
          for (int g = 0; g < 4; ++g) { const f32x4 a4 = *(const LAS f32x4*)(linv + 8 * g + 4 * hh); li[4 * g] = a4[0]; li[4 * g + 1] = a4[1]; li[4 * g + 2] = a4[2]; li[4 * g + 3] = a4[3]; }
#pragma unroll
          for (int cc = 0; cc < 2; ++cc)
#pragma unroll
              for (int i = 0; i < 16; ++i) { const int head = (i & 3) + 8 * (i >> 2) + 4 * hh;
                  *(LAS unsigned short*)(L + O_OT + head * KRS + (w * 64 + cc * 32 + r32) * 2) = (unsigned short)(cvt_pk_bf16(oacc[cc][i] * li[i], 0.f) & 0xffffu); } }
        LDS_BARRIER();
#pragma unroll
        for (int i = 0; i < 4; ++i) { const int pc = tid + 512 * i, head = pc >> 6, ch16 = pc & 63;
            *(v4u*)(OLAT + (size_t)t * 16384 + head * 512 + ch16 * 8) = *(const LAS v4u*)(L + O_OT + head * KRS + ch16 * 16); }
        t = tn; cnt = cnt_n; buf ^= 1;
    }
}
template <int VAR> __device__ __forceinline__ void phase6c_attn(Frame& F, int kstart, int kcount, int kstride) {
    const bf16* QA = (const bf16*)(F.ws + WS_QA); const bf16* CKV = (const bf16*)(F.ws + WS_CKV); const int* IDX = (const int*)(F.ws + WS_IDX); const int* CNT = (const int*)(F.ws + WS_CNT); bf16* OLAT = (bf16*)(F.ws + (VAR ? WS_SC : WS_OLAT));
    constexpr int KRS = 1040, PRS = 144;
    constexpr int O_KV = 0, O_IDX = 66560, O_DIST = 68608, O_AL = 70656, O_MX = 70784  , O_LP = 71296  , O_P = 71808, O_OT = 71808;
    LAS unsigned char* L = F.lds;
    LAS float* lal = (LAS float*)(L + O_AL); LAS float* lmx = (LAS float*)(L + O_MX); LAS float* llp = (LAS float*)(L + O_LP);
    const int tid = F.tid, w = F.wave, l = F.lane, quad = l >> 4, r16 = l & 15, r32 = l & 31, hh = l >> 5;
    const int mt = w & 1, nq = w >> 1;
    float slope4[4];
#pragma unroll
    for (int i = 0; i < 4; ++i) slope4[i] = exp2f(-0.25f * (float)(mt * 16 + quad * 4 + i + 1));
    if (kcount <= 0) return;
    const __amdgpu_buffer_rsrc_t rKV = __builtin_amdgcn_make_buffer_rsrc((void*)CKV, 0, T_SEQ * 1024, 0x00020000);
    int t = T_SEQ - 1 - kstart; int cnt = CNT[t];
    LDS_BARRIER();
    if (tid < 256) { const int id = IDX[(size_t)t * TOPK + tid]; ((LAS int*)(L + O_IDX))[tid] = id; ((LAS float*)(L + O_DIST))[tid] = (float)(t - id); }
    bf16x8 aq[16];
#pragma unroll
    for (int ks = 0; ks < 16; ++ks) aq[ks] = *(const bf16x8*)(QA + (size_t)t * NQA + (mt * 16 + r16) * 512 + ks * 32 + quad * 8);
    LDS_BARRIER();
    v4u st[8];
#pragma unroll
    for (int j = 0; j < 8; ++j) { const int id = ((LAS int*)(L + O_IDX))[w * 8 + j]; st[j] = __builtin_bit_cast(v4u, __builtin_amdgcn_raw_buffer_load_b128(rKV, (unsigned)(l * 16), __builtin_amdgcn_readfirstlane(id) * 1024, 0)); }
    int buf = 0;
    for (int qi = 0; qi < kcount; ++qi) {
        const int nch = (cnt + 63) >> 6;
        LAS int* lidx = (LAS int*)(L + O_IDX + buf * 1024); LAS float* ldist = (LAS float*)(L + O_DIST + buf * 1024);
        LAS int* nidx = (LAS int*)(L + O_IDX + (buf ^ 1) * 1024); LAS float* ndist = (LAS float*)(L + O_DIST + (buf ^ 1) * 1024);
        const bool has_next = qi + 1 < kcount; const int tn = has_next ? (T_SEQ - 1 - (kstart + (qi + 1) * kstride)) : t;
        int cnt_n = cnt, nid = 0;
        if (has_next) { cnt_n = CNT[tn]; if (tid < 256) nid = IDX[(size_t)tn * TOPK + tid]; }
        f32x16 oacc[2];
#pragma unroll
        for (int c = 0; c < 2; ++c)
#pragma unroll
            for (int i = 0; i < 16; ++i) oacc[c][i] = 0.f;
        float m_i[4] = {-INFINITY, -INFINITY, -INFINITY, -INFINITY}, l_i[4] = {0.f, 0.f, 0.f, 0.f};
        for (int c = 0; c < nch; ++c) {
            if (VAR != 5 && VAR != 6) {
#pragma unroll
            for (int j = 0; j < 8; ++j) *(LAS v4u*)(L + O_KV + (w * 8 + j) * KRS + l * 16) = st[j]; }
            if (c == nch - 1 && has_next && tid < 256) { nidx[tid] = nid; ndist[tid] = (float)(tn - nid); }
            LDS_BARRIER();
            f32x4 lg = (f32x4){0.f, 0.f, 0.f, 0.f};
            { f32x4 lg2 = lg;
#pragma unroll
              for (int kb = 0; kb < 2; ++kb) { bf16x8 bk[8];
#pragma unroll
                  for (int k1 = 0; k1 < 8; ++k1) bk[k1] = *(const LAS bf16x8*)(L + O_KV + (nq * 16 + r16) * KRS + ((kb * 8 + k1) * 32 + quad * 8) * 2);
                  __builtin_amdgcn_sched_barrier(0);
#pragma unroll
                  for (int k1 = 0; k1 < 8; k1 += 2) { lg = __builtin_amdgcn_mfma_f32_16x16x32_bf16(aq[kb * 8 + k1], bk[k1], lg, 0, 0, 0); lg2 = __builtin_amdgcn_mfma_f32_16x16x32_bf16(aq[kb * 8 + k1 + 1], bk[k1 + 1], lg2, 0, 0, 0); }
                  __builtin_amdgcn_sched_barrier(0); }
              lg += lg2; }
            { const int slot = c * 64 + nq * 16 + r16; const float dist = ldist[slot]; const bool valid = slot < cnt;
#pragma unroll
              for (int i = 0; i < 4; ++i) { const float v = valid ? (lg[i] * 0.08838834764831845f - slope4[i] * dist) : -INFINITY; lg[i] = v;
                  float mx = v; mx = fmaxf(mx, __shfl_xor(mx, 1)); mx = fmaxf(mx, __shfl_xor(mx, 2)); mx = fmaxf(mx, __shfl_xor(mx, 4)); mx = fmaxf(mx, __shfl_xor(mx, 8));
                  if (r16 == 0) lmx[nq * 32 + mt * 16 + quad * 4 + i] = mx; } }
            LDS_BARRIER();
            {
                const bool last = (c == nch - 1);
                if (VAR != 1 && (!last || has_next)) { const LAS int* srcidx = last ? nidx : (lidx + (c + 1) * 64);
#pragma unroll
                    for (int j = 0; j < 8; ++j) { const int id = srcidx[w * 8 + j]; st[j] = __builtin_bit_cast(v4u, __builtin_amdgcn_raw_buffer_load_b128(rKV, (unsigned)(l * 16), __builtin_amdgcn_readfirstlane(id) * 1024, 0)); } }
                if (last && has_next) {
#pragma unroll
                    for (int ks = 0; ks < 16; ++ks) aq[ks] = *(const bf16x8*)(QA + (size_t)tn * NQA + (mt * 16 + r16) * 512 + ks * 32 + quad * 8); } }
            {
                const f32x4 m0 = *(const LAS f32x4*)(lmx + 0 * 32 + mt * 16 + quad * 4), m1 = *(const LAS f32x4*)(lmx + 1 * 32 + mt * 16 + quad * 4), m2 = *(const LAS f32x4*)(lmx + 2 * 32 + mt * 16 + quad * 4), m3 = *(const LAS f32x4*)(lmx + 3 * 32 + mt * 16 + quad * 4);
#pragma unroll
                for (int i = 0; i < 4; ++i) { const float cm = fmaxf(fmaxf(m0[i], m1[i]), fmaxf(m2[i], m3[i]));
                    const float mn = fmaxf(m_i[i], cm); const float alpha = __expf(m_i[i] - mn); m_i[i] = mn;
                    const float p = __expf(lg[i] - mn); const unsigned pb = cvt_pk_bf16(p, 0.f) & 0xffffu;
                    *(LAS unsigned short*)(L + O_P + (mt * 16 + quad * 4 + i) * PRS + (nq * 16 + r16) * 2) = (unsigned short)pb;
                    float s = bf_lo(pb); s += __shfl_xor(s, 1); s += __shfl_xor(s, 2); s += __shfl_xor(s, 4); s += __shfl_xor(s, 8);
                    l_i[i] = l_i[i] * alpha + s;
                    if (r16 == 0) { if (nq == 0) lal[mt * 16 + quad * 4 + i] = alpha; if (c == nch - 1) llp[nq * 32 + mt * 16 + quad * 4 + i] = l_i[i]; } }
            }
            LDS_BARRIER();
            { float al[16];
#pragma unroll
              for (int g = 0; g < 4; ++g) { const f32x4 a4 = *(const LAS f32x4*)(lal + 8 * g + 4 * hh); al[4 * g] = a4[0]; al[4 * g + 1] = a4[1]; al[4 * g + 2] = a4[2]; al[4 * g + 3] = a4[3]; }
#pragma unroll
              for (int cc = 0; cc < 2; ++cc)
#pragma unroll
                  for (int i = 0; i < 16; ++i) oacc[cc][i] *= al[i]; }
            if (VAR != 4 && VAR != 5 && VAR != 7) {
#pragma unroll
            for (int kb2 = 0; kb2 < 2; ++kb2) { bf16x8 ap[2], bv[2][2];
#pragma unroll
                for (int k1 = 0; k1 < 2; ++k1) { const int ks = kb2 * 2 + k1; ap[k1] = *(const LAS bf16x8*)(L + O_P + r32 * PRS + (ks * 16 + hh * 8) * 2);
#pragma unroll
                    for (int cc = 0; cc < 2; ++cc) { const LAS unsigned char* p0 = L + O_KV + (ks * 16 + 8 * hh + ((l & 15) >> 2)) * KRS + (w * 64 + cc * 32 + 16 * ((l >> 4) & 1) + 4 * (l & 3)) * 2; bv[k1][cc] = tr_pair(p0, p0 + 4 * KRS); } }
                __builtin_amdgcn_sched_barrier(0);
#pragma unroll
                for (int k1 = 0; k1 < 2; ++k1)
#pragma unroll
                    for (int cc = 0; cc < 2; ++cc) oacc[cc] = __builtin_amdgcn_mfma_f32_32x32x16_bf16(ap[k1], bv[k1][cc], oacc[cc], 0, 0, 0);
                __builtin_amdgcn_sched_barrier(0); }
            }
            LDS_BARRIER();
        }
        { float li[16];
#pragma unroll
          for (int g = 0; g < 4; ++g) { const f32x4 a4 = *(const LAS f32x4*)(llp + 8 * g + 4 * hh) + *(const LAS f32x4*)(llp + 32 + 8 * g + 4 * hh) + *(const LAS f32x4*)(llp + 64 + 8 * g + 4 * hh) + *(const LAS f32x4*)(llp + 96 + 8 * g + 4 * hh);
              li[4 * g] = __builtin_amdgcn_rcpf(a4[0]); li[4 * g + 1] = __builtin_amdgcn_rcpf(a4[1]); li[4 * g + 2] = __builtin_amdgcn_rcpf(a4[2]); li[4 * g + 3] = __builtin_amdgcn_rcpf(a4[3]); }
#pragma unroll
          for (int cc = 0; cc < 2; ++cc)
#pragma unroll
              for (int i = 0; i < 16; ++i) { const int head = (i & 3) + 8 * (i >> 2) + 4 * hh;
                  *(LAS unsigned short*)(L + O_OT + head * KRS + (w * 64 + cc * 32 + r32) * 2) = (unsigned short)(cvt_pk_bf16(oacc[cc][i] * li[i], 0.f) & 0xffffu); } }
        LDS_BARRIER();
#pragma unroll
        for (int i = 0; i < 4; ++i) { const int pc = tid + 512 * i, head = pc >> 6, ch16 = pc & 63;
            *(v4u*)(OLAT + (size_t)t * 16384 + head * 512 + ch16 * 8) = *(const LAS v4u*)(L + O_OT + head * KRS + ch16 * 16); }
        t = tn; cnt = cnt_n; buf ^= 1;
    }
}
__device__ __forceinline__ void phase6d_attn(Frame& F, int kstart, int kcount, int kstride) {
    const bf16* QA = (const bf16*)(F.ws + WS_QA); const bf16* CKV = (const bf16*)(F.ws + WS_CKV); const int* IDX = (const int*)(F.ws + WS_IDX); const int* CNT = (const int*)(F.ws + WS_CNT); bf16* OLAT = (bf16*)(F.ws + WS_OLAT);
    constexpr int KRS = 1040, PRS = 80;
    constexpr int G_KV = 0, G_IDX = 33280  , G_DIST = 35328  , G_AL = 37376, G_LINV = 37504, G_P = 37632  , G_EX = 40192  , GSZ = 44288;
    static_assert(2 * GSZ <= RING_BYTES, "attention LDS map");
    const int tid = F.tid, w = F.wave, l = F.lane, quad = l >> 4, r16 = l & 15, r32 = l & 31, hh = l >> 5;
    const int g = w >> 2, wl = w & 3, mt = wl & 1, kh = wl >> 1, gt = tid & 255;
    LAS unsigned char* L = F.lds + g * GSZ;
    LAS float* lal = (LAS float*)(L + G_AL); LAS float* linv = (LAS float*)(L + G_LINV);
    float slope4[4];
#pragma unroll
    for (int i = 0; i < 4; ++i) slope4[i] = exp2f(-0.25f * (float)(mt * 16 + quad * 4 + i + 1));
    if (kcount <= 0) return;
    const __amdgpu_buffer_rsrc_t rKV = __builtin_amdgcn_make_buffer_rsrc((void*)CKV, 0, T_SEQ * 1024, 0x00020000);
    const int npair = (kcount + 1) >> 1;
#define P6D_TICKET(p) (kstart + (((2 * (p) + g) < kcount) ? (2 * (p) + g) : (kcount - 1)) * kstride)
    int t = T_SEQ - 1 - P6D_TICKET(0);
    int cntA = CNT[T_SEQ - 1 - (kstart)], cntB = CNT[T_SEQ - 1 - (kstart + ((1 < kcount) ? 1 : 0) * kstride)];
    int cnt = g ? cntB : cntA;
    LDS_BARRIER();
    { const int id = IDX[(size_t)t * TOPK + gt]; ((LAS int*)(L + G_IDX))[gt] = id; ((LAS float*)(L + G_DIST))[gt] = (float)(t - id); }
    bf16x8 aq[8];
#pragma unroll
    for (int ks = 0; ks < 8; ++ks) aq[ks] = *(const bf16x8*)(QA + (size_t)t * NQA + (mt * 16 + r16) * 512 + kh * 256 + ks * 32 + quad * 8);
    LDS_BARRIER();
    v4u st[8];
#pragma unroll
    for (int j = 0; j < 8; ++j) { const int id = ((LAS int*)(L + G_IDX))[wl * 8 + j]; st[j] = __builtin_bit_cast(v4u, __builtin_amdgcn_raw_buffer_load_b128(rKV, (unsigned)(l * 16), __builtin_amdgcn_readfirstlane(id) * 1024, 0)); }
    int buf = 0;
    for (int p = 0; p < npair; ++p) {
        const int nch = (((cntA > cntB) ? cntA : cntB) + 31) >> 5;
        LAS int* lidx = (LAS int*)(L + G_IDX + buf * 1024); LAS float* ldist = (LAS float*)(L + G_DIST + buf * 1024);
        LAS int* nidx = (LAS int*)(L + G_IDX + (buf ^ 1) * 1024); LAS float* ndist = (LAS float*)(L + G_DIST + (buf ^ 1) * 1024);
        const bool has_next = p + 1 < npair; const int tn = has_next ? (T_SEQ - 1 - P6D_TICKET(p + 1)) : t;
        int cntA_n = cntA, cntB_n = cntB, nid = 0;
        if (has_next) { const int ka = kstart + (2 * (p + 1)) * kstride, kb = kstart + (((2 * (p + 1) + 1) < kcount) ? (2 * (p + 1) + 1) : (kcount - 1)) * kstride;
            cntA_n = CNT[T_SEQ - 1 - ka]; cntB_n = CNT[T_SEQ - 1 - kb]; nid = IDX[(size_t)tn * TOPK + gt]; }
        f32x16 oacc[4];
#pragma unroll
        for (int c = 0; c < 4; ++c)
#pragma unroll
            for (int i = 0; i < 16; ++i) oacc[c][i] = 0.f;
        float m_i[4] = {-INFINITY, -INFINITY, -INFINITY, -INFINITY}, l_i[4] = {0.f, 0.f, 0.f, 0.f};
        for (int c = 0; c < nch; ++c) {
#pragma unroll
            for (int j = 0; j < 8; ++j) *(LAS v4u*)(L + G_KV + (wl * 8 + j) * KRS + l * 16) = st[j];
            if (c == nch - 1 && has_next) { nidx[gt] = nid; ndist[gt] = (float)(tn - nid); }
            LDS_BARRIER();
            f32x4 lg[2];
            lg[0] = (f32x4){0.f, 0.f, 0.f, 0.f}; lg[1] = lg[0];
#pragma unroll
            for (int kb2 = 0; kb2 < 2; ++kb2) { bf16x8 bk[2][4];
#pragma unroll
                for (int nt = 0; nt < 2; ++nt)
#pragma unroll
                    for (int k1 = 0; k1 < 4; ++k1) bk[nt][k1] = *(const LAS bf16x8*)(L + G_KV + (nt * 16 + r16) * KRS + (kh * 256 + (kb2 * 4 + k1) * 32 + quad * 8) * 2);
                __builtin_amdgcn_sched_barrier(0);
#pragma unroll
                for (int k1 = 0; k1 < 4; ++k1)
#pragma unroll
                    for (int nt = 0; nt < 2; ++nt) lg[nt] = __builtin_amdgcn_mfma_f32_16x16x32_bf16(aq[kb2 * 4 + k1], bk[nt][k1], lg[nt], 0, 0, 0);
                __builtin_amdgcn_sched_barrier(0); }
            if (kh == 1) {
#pragma unroll
                for (int nt = 0; nt < 2; ++nt) *(LAS f32x4*)(L + G_EX + ((mt * 2 + nt) * 64 + l) * 16) = lg[nt]; }
            LDS_BARRIER();
            {
                const bool last = (c == nch - 1);
                if (!last || has_next) { const LAS int* srcidx = last ? nidx : (lidx + (c + 1) * 32);
#pragma unroll
                    for (int j = 0; j < 8; ++j) { const int id = srcidx[wl * 8 + j]; st[j] = __builtin_bit_cast(v4u, __builtin_amdgcn_raw_buffer_load_b128(rKV, (unsigned)(l * 16), __builtin_amdgcn_readfirstlane(id) * 1024, 0)); } }
                if (last && has_next) {
#pragma unroll
                    for (int ks = 0; ks < 8; ++ks) aq[ks] = *(const bf16x8*)(QA + (size_t)tn * NQA + (mt * 16 + r16) * 512 + kh * 256 + ks * 32 + quad * 8); } }
            if (kh == 0) {
                float pmax[4] = {-INFINITY, -INFINITY, -INFINITY, -INFINITY};
#pragma unroll
                for (int nt = 0; nt < 2; ++nt) {
                    lg[nt] += *(const LAS f32x4*)(L + G_EX + ((mt * 2 + nt) * 64 + l) * 16);
                    const int slot = c * 32 + nt * 16 + r16; const float dist = ldist[slot]; const bool valid = slot < cnt;
#pragma unroll
                    for (int i = 0; i < 4; ++i) { const float v = valid ? (lg[nt][i] * 0.08838834764831845f - slope4[i] * dist) : -INFINITY; lg[nt][i] = v; pmax[i] = fmaxf(pmax[i], v); } }
                float alpha[4], rs[4];
#pragma unroll
                for (int i = 0; i < 4; ++i) { const float mx = row16_allmax(pmax[i]);
                    const float mn = fmaxf(m_i[i], mx); alpha[i] = (mn == -INFINITY) ? 1.0f : __expf(m_i[i] - mn); m_i[i] = mn; rs[i] = 0.f; }
#pragma unroll
                for (int nt = 0; nt < 2; ++nt)
#pragma unroll
                    for (int i = 0; i < 4; ++i) { const float pv_ = (m_i[i] == -INFINITY) ? 0.f : __expf(lg[nt][i] - m_i[i]); const unsigned pb = cvt_pk_bf16(pv_, 0.f) & 0xffffu; rs[i] += bf_lo(pb);
                        *(LAS unsigned short*)(L + G_P + (mt * 16 + quad * 4 + i) * PRS + (nt * 16 + r16) * 2) = (unsigned short)pb; }
#pragma unroll
                for (int i = 0; i < 4; ++i) { const float s = row16_allsum(rs[i]);
                    l_i[i] = l_i[i] * alpha[i] + s;
                    if (r16 == 0) { lal[mt * 16 + quad * 4 + i] = alpha[i]; if (c == nch - 1) linv[mt * 16 + quad * 4 + i] = __builtin_amdgcn_rcpf(l_i[i]); } }
            }
            LDS_BARRIER();
            { float al[16];
#pragma unroll
              for (int q4 = 0; q4 < 4; ++q4) { const f32x4 a4 = *(const LAS f32x4*)(lal + 8 * q4 + 4 * hh); al[4 * q4] = a4[0]; al[4 * q4 + 1] = a4[1]; al[4 * q4 + 2] = a4[2]; al[4 * q4 + 3] = a4[3]; }
#pragma unroll
              for (int cc = 0; cc < 4; ++cc)
#pragma unroll
                  for (int i = 0; i < 16; ++i) oacc[cc][i] *= al[i]; }
#pragma unroll
            for (int ks = 0; ks < 2; ++ks) { bf16x8 bv[4];
                const bf16x8 ap = *(const LAS bf16x8*)(L + G_P + r32 * PRS + (ks * 16 + hh * 8) * 2);
#pragma unroll
                for (int cc = 0; cc < 4; ++cc) { const LAS unsigned char* p0 = L + G_KV + (ks * 16 + 8 * hh + ((l & 15) >> 2)) * KRS + (wl * 128 + cc * 32 + 16 * ((l >> 4) & 1) + 4 * (l & 3)) * 2; bv[cc] = tr_pair(p0, p0 + 4 * KRS); }
                __builtin_amdgcn_sched_barrier(0);
#pragma unroll
                for (int cc = 0; cc < 4; ++cc) oacc[cc] = __builtin_amdgcn_mfma_f32_32x32x16_bf16(ap, bv[cc], oacc[cc], 0, 0, 0);
                __builtin_amdgcn_sched_barrier(0); }
            LDS_BARRIER();
        }
        { float li[16];
#pragma unroll
          for (int q4 = 0; q4 < 4; ++q4) { const f32x4 a4 = *(const LAS f32x4*)(linv + 8 * q4 + 4 * hh); li[4 * q4] = a4[0]; li[4 * q4 + 1] = a4[1]; li[4 * q4 + 2] = a4[2]; li[4 * q4 + 3] = a4[3]; }
#pragma unroll
          for (int cc = 0; cc < 4; ++cc)
#pragma unroll
              for (int i = 0; i < 16; ++i) { const int head = (i & 3) + 8 * (i >> 2) + 4 * hh;
                  *(LAS unsigned short*)(L + G_KV + head * KRS + (wl * 128 + cc * 32 + r32) * 2) = (unsigned short)(cvt_pk_bf16(oacc[cc][i] * li[i], 0.f) & 0xffffu); } }
        LDS_BARRIER();
#pragma unroll
        for (int i = 0; i < 8; ++i) { const int pc = gt + 256 * i, head = pc >> 6, ch16 = pc & 63;
            *(v4u*)(OLAT + (size_t)t * 16384 + head * 512 + ch16 * 8) = *(const LAS v4u*)(L + G_KV + head * KRS + ch16 * 16); }
        LDS_BARRIER();
        t = tn; cntA = cntA_n; cntB = cntB_n; cnt = g ? cntB : cntA; buf ^= 1;
    }
#undef P6D_TICKET
}
constexpr int N_PHASES = 14;
constexpr int CW_BAR = 4096;
__global__ void __launch_bounds__(NWAVES * 64, 2) hybrid_fwd(Args args) {
    extern __shared__ __attribute__((aligned(16))) unsigned char lds[];
    Frame F;
    F.lds = (LAS unsigned char*)lds;
    F.tid = threadIdx.x; F.lane = F.tid & 63; F.wave = __builtin_amdgcn_readfirstlane(F.tid >> 6);
    F.G = gridDim.x; F.bid = blockIdx.x;
    F.p_I_X = args.in[0]; F.p_I_C = args.in[1]; F.p_I_WADA = args.in[2]; F.p_I_BADA = args.in[3]; F.p_I_WIN = args.in[4]; F.p_I_BIN = args.in[5]; F.p_I_GQ = args.in[6]; F.p_I_GKV = args.in[7]; F.p_I_WUQ = args.in[8]; F.p_I_WIQ = args.in[9]; F.p_I_WUK = args.in[10]; F.p_I_WUV = args.in[11]; F.p_I_GKIDX = args.in[12]; F.p_I_BKIDX = args.in[13]; F.p_I_CONVW = args.in[14]; F.p_I_CONVB = args.in[15]; F.p_I_GMH = args.in[16]; F.p_I_WAO = args.in[17]; F.p_I_WMO = args.in[18]; F.p_I_WOUT = args.in[19]; F.p_I_LNG = args.in[20]; F.p_I_LNB = args.in[21];
    F.out = args.out; F.ws = args.ws;
    volatile LAS unsigned* MISCW = (volatile LAS unsigned*)(F.lds + MISC_OFF);
    for (int u = F.tid; u < (LDS_BYTES - LDSCTL_OFF) / 4; u += NWAVES * 64) ((LAS unsigned*)(F.lds + LDSCTL_OFF))[u] = 0u;
    __syncthreads();
    const int lo = args.ph_lo, hi = args.ph_hi;
    XcdBarrier bar; bar.bar = (unsigned*)(args.ws + WS_CTL) + CW_BAR + args.li * XCD_BAR_WORDS; bar.x = 0; bar.st = nullptr;
    if (hi - lo > 1) bar = xcd_barrier_post((unsigned*)(args.ws + WS_CTL) + CW_BAR + args.li * XCD_BAR_WORDS, MISCW + 8);
#ifndef PROBE_DUP_MASK
#define PROBE_DUP_MASK 0
#endif
#define DUP(k) ((PROBE_DUP_MASK >> (k)) & 1)
#ifndef PROBE_VAR
#define PROBE_VAR 0
#endif
#ifndef MK_ATT_NB
#define MK_ATT_NB 42
#endif
#ifndef MK_ATT_S0
#define MK_ATT_S0 4
#endif
#define IN(k) (lo <= (k) && (k) < hi)
#define FRESH() do { int t_ = threadIdx.x; asm volatile("" : "+v"(t_)); F.tid = t_; F.lane = t_ & 63; F.wave = __builtin_amdgcn_readfirstlane(t_ >> 6); } while (0)
#define SEAM(k) do { if (IN(k) && IN((k) + 1)) xcd_barrier(bar); } while (0)

    if (IN(0)) { FRESH(); phase0(F); if (DUP(0)) { __syncthreads(); phase0(F); } SEAM(0); }
    if (IN(1)) { FRESH(); phase1(F); if (DUP(1)) { __syncthreads(); phase1(F); } SEAM(1); }
    if (IN(2)) {
        { pg8::Gemm g{(const bf16*)(F.ws + WS_U), (const bf16*)(F.ws + WS_WINT), T_SEQ, 1792, 4096, 4096, 4096, 0};
          pg8::StaticOrder S; S.init(T_SEQ, 1792, F.G, F.bid);
          pg8::EpiProj E{(bf16*)(F.ws + WS_P), (float*)(F.ws + WS_MISC), (const float*)(F.ws + WS_MOD) + 16384, 0};
          pg8::gemm_phase<pg8::EpiProj, pg8::StaticOrder, PG8_ALIGN, PG8_SP2, false>(F.lds + RING_OFF, g, S, E); }
        { pg8::Gemm g{(const bf16*)(F.ws + WS_U8), (const bf16*)(F.ws + WS_WINT8), T_SEQ, NP - 1792, 2048, 2048, 2048, 0, 0x79797979u};
          pg8::StaticOrder S; S.init(T_SEQ, NP - 1792, F.G, F.bid);
          pg8::EpiProj E{(bf16*)(F.ws + WS_P), (float*)(F.ws + WS_MISC), (const float*)(F.ws + WS_MOD) + 16384, 7};
          pg8::gemm_phase<pg8::EpiProj, pg8::StaticOrder, PG8_ALIGN, PG8_SP2, true>(F.lds + RING_OFF, g, S, E); }
        SEAM(2);
    }
    if (IN(3)) { FRESH(); phase3(F); if (DUP(3)) { __syncthreads(); phase3(F); } SEAM(3); }
    if (IN(4)) {
        { pg8::Gemm g{(const bf16*)(F.ws + WS_CQ8), (const bf16*)(F.ws + WS_WQT), T_SEQ, 16384, 512, 512, 512, 0, 0x79797979u, 0x7F7F7F7Fu};
          pg8::StaticOrder S; S.init(T_SEQ, 16384, F.G, F.bid);
          pg8::EpiPlain E{(bf16*)(F.ws + WS_QA), NQA};
          pg8::gemm_phase<pg8::EpiPlain, pg8::StaticOrder, PG8_ALIGN, PG8_SP2, true>(F.lds + RING_OFF, g, S, E); }
        { pg8::Gemm g{(const bf16*)(F.ws + WS_CQ), (const bf16*)(F.ws + WS_WIQT), T_SEQ, 2048, 1024, 1024, 1024, 0};
          pg8::StaticOrder S; S.init(T_SEQ, 2048, F.G, F.bid);
          pg8::EpiPlain E{(bf16*)(F.ws + WS_QA) + 16384, NQA};
          pg8::gemm_phase<pg8::EpiPlain, pg8::StaticOrder, PG8_ALIGN, PG8_SP2, false>(F.lds + RING_OFF, g, S, E); }
        SEAM(4);
    }
    if (IN(5)) { FRESH(); phase5_fast<0>(F); if (DUP(5)) { __syncthreads(); phase5_fast<PROBE_VAR>(F); } SEAM(5); }
    if (IN(6)) { FRESH(); { const int gwi = F.bid * NWAVES + F.wave; for (int it = gwi; it < 1024; it += F.G * NWAVES) mlstm_pre_item(F, it); } LDS_BARRIER(); phase6a_select(F); if (DUP(6)) { __syncthreads(); phase6a_select(F); } SEAM(6); }
    if (IN(7)) {
        FRESH();
        constexpr int ATT_NB = MK_ATT_NB;
        if (F.G == 256) {
            constexpr int ATT_MB = (T_SEQ - 192 * ATT_NB) / 64; static_assert(192 * ATT_NB + 64 * ATT_MB == T_SEQ && ATT_MB >= 0, "ticket split");
            if (F.bid < 64) { phase8_v4(F, F.bid); FRESH(); }
            else { constexpr int ATT_N4 = (ATT_NB < 41) ? ATT_NB : 41; static_assert(192 * ATT_N4 <= T_SEQ - TOPK, "the two-chunks-ahead form needs full 256-key rows");
                phase6b_attn4<0>(F, F.bid - 64, ATT_N4, 192);
                if (ATT_NB > ATT_N4) { FRESH(); phase6b_attn<0>(F, F.bid - 64 + 192 * ATT_N4, ATT_NB - ATT_N4, 192, (F.bid - 64 < 64 * ATT_MB) ? 192 * ATT_NB + (F.bid - 64) : -1); } }
            if (DUP(7)) { __syncthreads(); if (F.bid >= 64) phase6b_attn<PROBE_VAR>(F, F.bid - 64, ATT_NB, 192); }
        } else {
            for (int b = F.bid; b < 64; b += F.G) { phase8_v4(F, b); FRESH(); }
            phase6b_attn<0>(F, F.bid, (T_SEQ - F.bid + F.G - 1) / F.G, F.G);
        }
        SEAM(7);
    }
    if (IN(8)) {
        pg8::Gemm g{(const bf16*)(F.ws + WS_OLAT), (const bf16*)(F.ws + WS_WUVT), T_SEQ, 4096, 1024, 16384, 1024, 1024};
        pg8::StaticOrder S; S.init(T_SEQ, 4096, F.G, F.bid);
        pg8::EpiGate<0, true> E{(void*)(F.ws + WS_OG), 4096, (const bf16*)(F.ws + WS_P) + PC_ZA, NP, nullptr, 16.0f};
        pg8::gemm_phase<pg8::EpiGate<0, true>, pg8::StaticOrder, PG8_ALIGN, PG8_SP2>(F.lds + RING_OFF, g, S, E);
    }
    if (IN(10)) { FRESH(); phase9(F); if (DUP(10)) { __syncthreads(); phase9(F); } SEAM(10); }
    if (IN(11)) {
        { pg8::Gemm g{(const bf16*)(F.ws + WS_OG), (const bf16*)(F.ws + WS_WAOT), T_SEQ, 4096, 2048, 2048, 2048, 0, 0x79797979u, 0x7B7B7B7Bu};
          pg8::StaticOrder S; S.init(T_SEQ, 4096, F.G, F.bid);
          pg8::EpiGate<0, false> E{(void*)(F.ws + WS_TMP), 4096, (const bf16*)(F.ws + WS_P) + PC_GA, NP, nullptr, 1.0f};
          pg8::gemm_phase<pg8::EpiGate<0, false>, pg8::StaticOrder, PG8_ALIGN, PG8_SP2, true>(F.lds + RING_OFF, g, S, E); }
        VM_WAIT(); __syncthreads();
        { pg8::Gemm g{(const bf16*)(F.ws + WS_HG), (const bf16*)(F.ws + WS_WMOT), T_SEQ, 4096, 2048, 2048, 2048, 0, 0x79797979u, 0x7D7D7D7Du};
          pg8::StaticOrder S; S.init(T_SEQ, 4096, F.G, F.bid);
          pg8::EpiGate<1, true> E{(void*)(F.ws + WS_MERGED), 4096, (const bf16*)(F.ws + WS_P) + PC_GM, NP, (const bf16*)(F.ws + WS_TMP), 8.0f};
          pg8::gemm_phase<pg8::EpiGate<1, true>, pg8::StaticOrder, PG8_ALIGN, PG8_SP2, true>(F.lds + RING_OFF, g, S, E); }
        SEAM(11);
    }
    if (IN(12)) {
        pg8::Gemm g{(const bf16*)(F.ws + WS_MERGED), (const bf16*)(F.ws + WS_WOT), T_SEQ, 4096, 2048, 2048, 2048, 0, 0x79797979u, 0x7C7C7C7Cu};
        pg8::StaticOrder S; S.init(T_SEQ, 4096, F.G, F.bid);
        pg8::EpiOut E{(bf16*)(F.ws + WS_TMP), F.p_I_X, (const float*)(F.ws + WS_MOD) + 8192, DN_ALPHA};
        pg8::gemm_phase<pg8::EpiOut, pg8::StaticOrder, PG8_ALIGN, PG8_SP2, true>(F.lds + RING_OFF, g, S, E);
        SEAM(12);
    }
    if (IN(13)) { FRESH(); phase12(F); }
#undef IN
#undef SEAM
}

#ifndef MK_PER_PHASE
#define MK_PER_PHASE 0
#endif
extern "C" void kernel_launch(void* const* d_in, const int* in_sizes, int n_in, void* d_out, int out_size, void* d_ws, size_t ws_size, hipStream_t stream) {
    static int grid = 0;
    if (grid == 0) {
        if (n_in != 22 || out_size != T_SEQ * DM || ws_size < WS_END) { fprintf(stderr, "kernel_launch: unexpected shapes (n_in %d out %d ws %zu need %zu)\n", n_in, out_size, ws_size, (size_t)WS_END); grid = -1; return; }
        int dev = 0, cus = 0, per_cu = 0;
        if (hipGetDevice(&dev) != hipSuccess || hipDeviceGetAttribute(&cus, hipDeviceAttributeMultiprocessorCount, dev) != hipSuccess) { grid = -1; return; }
        if (hipFuncSetAttribute((const void*)hybrid_fwd, hipFuncAttributeMaxDynamicSharedMemorySize, LDS_BYTES) != hipSuccess) { fprintf(stderr, "kernel_launch: hipFuncSetAttribute failed\n"); grid = -1; return; }
        if (hipOccupancyMaxActiveBlocksPerMultiprocessor(&per_cu, (const void*)hybrid_fwd, NWAVES * 64, LDS_BYTES) != hipSuccess || per_cu < 1) fprintf(stderr, "kernel_launch: occupancy query reports %d\n", per_cu);
        (void)hipGetLastError();
        grid = cus;
    }
    if (grid < 0) return;
    if (hipMemsetAsync((char*)d_ws + WS_CTL, 0, CTL_ZERO_BYTES, stream) != hipSuccess) return;
    Args a{};
    for (int i = 0; i < 22; ++i) a.in[i] = (const float*)d_in[i];
    a.out = (float*)d_out; a.ws = (unsigned char*)d_ws; a.pad = 0;
#if MK_PER_PHASE
    for (int p = 0; p < N_PHASES; ++p) { a.ph_lo = p; a.ph_hi = p + 1; a.li = 0; hipLaunchKernelGGL(hybrid_fwd, dim3(grid), dim3(NWAVES * 64), LDS_BYTES, stream, a); }
#else
    a.ph_lo = 0; a.ph_hi = N_PHASES; a.li = 0;
    hipLaunchKernelGGL(hybrid_fwd, dim3(grid), dim3(NWAVES * 64), LDS_BYTES, stream, a);
#endif
}
```
